# Optimizing an MI355X kernel written in HIP

```python
import math
import jax
import jax.numpy as jnp
from jax import lax
import numpy as np

D_MODEL = 1024
BATCH = 8
SEQ = 2048
DEPTH = 2

HEAD_DIM = 64
N_HEADS = D_MODEL // HEAD_DIM
MOBA_HEADS = N_HEADS // 2
DIL_HEADS = N_HEADS - MOBA_HEADS
MOBA_BLOCK = 256
MOBA_TOPK = 3
MOBA_QCHUNK = 16
DIL_PAIRS = ((128, 1), (512, 4), (2048, 16))
DIL_BLOCK = 128
NSA_HEADS = N_HEADS
NSA_GROUPS = 4
NSA_HPG = NSA_HEADS // NSA_GROUPS
NSA_CMP_LEN = 32
NSA_CMP_STRIDE = 16
NSA_CMP_HIDDEN = 2 * HEAD_DIM
NSA_SEL_BLOCK = 64
NSA_SEL_TOPN = 16
NSA_WINDOW = 512
NSA_WIN_BLOCK = 128
NSA_QCHUNK = 32
NSA_FORCE = 1.0e6
REL_BUCKETS = 32
REL_MAX_DIST = 2048
FFN_HIDDEN = -((-8 * D_MODEL) // (3 * 256)) * 256
PLE_DIM = 256
N_EVEN = (DEPTH + 1) // 2
N_ODD = DEPTH // 2
RMS_EPS = 1e-6
ATTN_SCALE = HEAD_DIM ** -0.5
F32 = jnp.float32

kernel_name = 'hybrid_moba_dilated_nsa_block'


def _rms(x, g):
    xf = x.astype(F32)
    y = xf * lax.rsqrt(jnp.mean(xf * xf, axis=-1, keepdims=True) + RMS_EPS)
    return (y * g.astype(F32)).astype(x.dtype)


def _heads(t, n):
    B, S, _ = t.shape
    return t.reshape(B, S, n, HEAD_DIM).transpose(0, 2, 1, 3)


def _rel_bucket(dist):
    n = jnp.maximum(dist, 0)
    exact = REL_BUCKETS // 2
    nf = jnp.maximum(n, 1).astype(F32)
    large = exact + (jnp.log(nf / exact) / math.log(REL_MAX_DIST / exact) * (REL_BUCKETS - exact)).astype(jnp.int32)
    return jnp.where(n < exact, n, jnp.minimum(large, REL_BUCKETS - 1))


def _masked_softmax(s, mask):
    s = jnp.where(mask, s.astype(F32), -jnp.inf)
    m = jnp.max(s, axis=-1, keepdims=True)
    m = jnp.where(jnp.isfinite(m), m, 0.0)
    e = jnp.exp(s - m)
    l = jnp.sum(e, axis=-1, keepdims=True)
    p = e / jnp.where(l > 0, l, 1.0)
    return p, (m + jnp.log(l))[..., 0]


def _moba(q, k, v, tab):
    B, H, S, hd = q.shape
    nb = -(-S // MOBA_BLOCK)
    padw = ((0, 0), (0, 0), (0, nb * MOBA_BLOCK - S), (0, 0))
    kb = jnp.pad(k, padw).reshape(B, H, nb, MOBA_BLOCK, hd)
    vb = jnp.pad(v, padw).reshape(B, H, nb, MOBA_BLOCK, hd)
    kmean = jnp.mean(kb.astype(F32), axis=3)
    own = jnp.arange(S) // MOBA_BLOCK
    gate = jnp.einsum('bhsd,bhnd->bhsn', q.astype(F32), kmean)
    gate = jnp.where(jnp.arange(nb)[None, :] < own[:, None], gate, -jnp.inf)
    n_sel = min(MOBA_TOPK, nb)
    _, sel = lax.top_k(gate, n_sel)
    sel_ok = sel < own[:, None]
    nc = S // MOBA_QCHUNK

    def to_chunks(t):
        return jnp.moveaxis(t.reshape(B, H, nc, MOBA_QCHUNK, *t.shape[3:]), 2, 0)

    b_ix = jnp.arange(B)[:, None, None, None]
    h_ix = jnp.arange(H)[None, :, None, None]
    a_blk = jnp.arange(MOBA_BLOCK)

    def chunk(args):
        c, qc, sc, okc = args
        t = c * MOBA_QCHUNK + jnp.arange(MOBA_QCHUNK)
        j = (c * MOBA_QCHUNK) // MOBA_BLOCK
        k_own = lax.dynamic_index_in_dim(kb, j, axis=2, keepdims=False)
        v_own = lax.dynamic_index_in_dim(vb, j, axis=2, keepdims=False)
        d_own = t[:, None] - (j * MOBA_BLOCK + a_blk)[None, :]
        s_own = jnp.einsum('bhqd,bhkd->bhqk', qc, k_own).astype(F32) * ATTN_SCALE + tab[:, _rel_bucket(d_own)].astype(F32)
        m_own = jnp.broadcast_to(d_own >= 0, s_own.shape)
        k_sel = kb[b_ix, h_ix, sc].reshape(B, H, MOBA_QCHUNK, n_sel * MOBA_BLOCK, hd)
        v_sel = vb[b_ix, h_ix, sc].reshape(B, H, MOBA_QCHUNK, n_sel * MOBA_BLOCK, hd)
        kpos = (sc[..., None] * MOBA_BLOCK + a_blk).reshape(B, H, MOBA_QCHUNK, n_sel * MOBA_BLOCK)
        s_sel = jnp.einsum('bhqd,bhqkd->bhqk', qc, k_sel).astype(F32) * ATTN_SCALE + tab[h_ix, _rel_bucket(t[:, None] - kpos)].astype(F32)
        m_sel = jnp.repeat(okc, MOBA_BLOCK, axis=-1)
        pr, _ = _masked_softmax(jnp.concatenate([s_own, s_sel], axis=-1), jnp.concatenate([m_own, m_sel], axis=-1))
        p_own = pr[..., :MOBA_BLOCK].astype(v.dtype)
        p_sel = pr[..., MOBA_BLOCK:].astype(v.dtype)
        return jnp.einsum('bhqk,bhkd->bhqd', p_own, v_own) + jnp.einsum('bhqk,bhqkd->bhqd', p_sel, v_sel)

    out = lax.map(chunk, (jnp.arange(nc), to_chunks(q), to_chunks(sel), to_chunks(sel_ok)))
    return jnp.moveaxis(out, 0, 2).reshape(B, H, S, hd)


def _stride_split(t, dil, L):
    B, H, S, hd = t.shape
    t = jnp.pad(t, ((0, 0), (0, 0), (0, L * dil - S), (0, 0)))
    return t.reshape(B, H, L, dil, hd).transpose(0, 1, 3, 2, 4)


def _band(t):
    prev = jnp.pad(t, ((0, 0), (0, 0), (0, 0), (1, 0), (0, 0), (0, 0)))[:, :, :, :-1]
    return jnp.concatenate([prev, t], axis=4)


def _dilated(q, k, v, tab):
    B, H, S, hd = q.shape
    blk = DIL_BLOCK
    outs, lses = [], []
    for window, dil in DIL_PAIRS:
        steps = window // dil
        L = -(-S // (dil * blk)) * blk
        nbk = L // blk
        qs = _stride_split(q, dil, L).reshape(B, H, dil, nbk, blk, hd)
        ks = _stride_split(k, dil, L).reshape(B, H, dil, nbk, blk, hd)
        vs = _stride_split(v, dil, L).reshape(B, H, dil, nbk, blk, hd)
        step = jnp.arange(blk)[:, None] + blk - jnp.arange(2 * blk)[None, :]
        key_ok = (jnp.arange(nbk)[:, None] * blk - blk + jnp.arange(2 * blk)[None, :]) >= 0
        mask = ((step >= 0) & (step <= steps))[None] & key_ok[:, None, :]
        bias = tab[:, _rel_bucket(step * dil)].astype(F32)
        s = jnp.einsum('bhrjqd,bhrjkd->bhrjqk', qs, _band(ks)).astype(F32) * ATTN_SCALE + bias[None, :, None, None]
        pr, lse = _masked_softmax(s, mask)
        o = jnp.einsum('bhrjqk,bhrjkd->bhrjqd', pr.astype(v.dtype), _band(vs))
        outs.append(o.reshape(B, H, dil, L, hd).transpose(0, 1, 3, 2, 4).reshape(B, H, L * dil, hd)[:, :, :S])
        lses.append(lse.reshape(B, H, dil, L).transpose(0, 1, 3, 2).reshape(B, H, L * dil)[:, :, :S])
    w = jax.nn.softmax(jnp.stack(lses), axis=0)
    o = jnp.einsum('nbhs,nbhsd->bhsd', w, jnp.stack(outs).astype(F32))
    return o.astype(q.dtype)


def _compress(t, pos_emb, w1, b1, w2, b2):
    B, G, S, hd = t.shape
    nc = (S - NSA_CMP_LEN) // NSA_CMP_STRIDE + 1
    idx = jnp.arange(nc)[:, None] * NSA_CMP_STRIDE + jnp.arange(NSA_CMP_LEN)[None, :]
    blocks = (t[:, :, idx] + pos_emb).reshape(B, G, nc, NSA_CMP_LEN * hd)
    return jax.nn.gelu(blocks @ w1 + b1) @ w2 + b2


def _nsa(q, kc, vc, ks, vs, kw, vw, gates, tab):
    B, H, S, hd = q.shape
    G, hpg = NSA_GROUPS, NSA_HPG
    qg = q.reshape(B, G, hpg, S, hd)
    tabg = tab.reshape(G, hpg, REL_BUCKETS)
    t = jnp.arange(S)
    nc = kc.shape[2]
    dc = t[:, None] - (jnp.arange(nc) * NSA_CMP_STRIDE + NSA_CMP_LEN - 1)[None, :]
    s = jnp.einsum('bghsd,bgcd->bghsc', qg, kc).astype(F32) * ATTN_SCALE + tabg[:, :, _rel_bucket(dc)].astype(F32)
    p_cmp, _ = _masked_softmax(s, dc >= 0)
    o_cmp = jnp.einsum('bghsc,bgcd->bghsd', p_cmp.astype(vc.dtype), vc)
    n_sel = -(-S // NSA_SEL_BLOCK)
    cstart = jnp.arange(nc) * NSA_CMP_STRIDE
    sstart = jnp.arange(n_sel) * NSA_SEL_BLOCK
    overlap = jnp.maximum(jnp.minimum(cstart[:, None] + NSA_CMP_LEN, sstart[None, :] + NSA_SEL_BLOCK) - jnp.maximum(cstart[:, None], sstart[None, :]), 0).astype(F32)
    imp = jnp.einsum('bghsc,cn->bgsn', p_cmp, overlap)
    cur = (t // NSA_SEL_BLOCK)[:, None]
    blk_id = jnp.arange(n_sel)[None, :]
    forced = (blk_id == 0) | (blk_id == cur) | (blk_id == cur - 1)
    imp = jnp.where(blk_id <= cur, imp + jnp.where(forced, NSA_FORCE, 0.0), -jnp.inf)
    n_top = min(NSA_SEL_TOPN, n_sel)
    _, sel = lax.top_k(imp, n_top)
    padw = ((0, 0), (0, 0), (0, n_sel * NSA_SEL_BLOCK - S), (0, 0))
    ksb = jnp.pad(ks, padw).reshape(B, G, n_sel, NSA_SEL_BLOCK, hd)
    vsb = jnp.pad(vs, padw).reshape(B, G, n_sel, NSA_SEL_BLOCK, hd)
    nq = S // NSA_QCHUNK
    b_ix = jnp.arange(B)[:, None, None, None]
    g_ix = jnp.arange(G)[None, :, None, None]
    h_ix = jnp.arange(hpg)[None, None, :, None, None]
    a_blk = jnp.arange(NSA_SEL_BLOCK)

    def sel_chunk(args):
        c, qc, sc = args
        tq = c * NSA_QCHUNK + jnp.arange(NSA_QCHUNK)
        kk = ksb[b_ix, g_ix, sc].reshape(B, G, NSA_QCHUNK, n_top * NSA_SEL_BLOCK, hd)
        vv = vsb[b_ix, g_ix, sc].reshape(B, G, NSA_QCHUNK, n_top * NSA_SEL_BLOCK, hd)
        kpos = (sc[..., None] * NSA_SEL_BLOCK + a_blk).reshape(B, G, NSA_QCHUNK, n_top * NSA_SEL_BLOCK)
        dist = tq[:, None] - kpos
        bias = tabg[g_ix[..., None], h_ix, _rel_bucket(dist)[:, :, None]].astype(F32)
        s = jnp.einsum('bghqd,bgqkd->bghqk', qc, kk).astype(F32) * ATTN_SCALE + bias
        pr, _ = _masked_softmax(s, (dist >= 0)[:, :, None])
        return jnp.einsum('bghqk,bgqkd->bghqd', pr.astype(vv.dtype), vv)

    qch = jnp.moveaxis(qg.reshape(B, G, hpg, nq, NSA_QCHUNK, hd), 3, 0)
    sch = jnp.moveaxis(sel.reshape(B, G, nq, NSA_QCHUNK, n_top), 2, 0)
    o_slc = jnp.moveaxis(lax.map(sel_chunk, (jnp.arange(nq), qch, sch)), 0, 3).reshape(B, G, hpg, S, hd)
    nw = S // NSA_WIN_BLOCK
    span = NSA_WINDOW + NSA_WIN_BLOCK
    kwp = jnp.pad(kw, ((0, 0), (0, 0), (NSA_WINDOW, 0), (0, 0)))
    vwp = jnp.pad(vw, ((0, 0), (0, 0), (NSA_WINDOW, 0), (0, 0)))
    kidx = jnp.arange(span)[None, :]
    dw = jnp.arange(NSA_WIN_BLOCK)[:, None] + NSA_WINDOW - kidx
    bias_w = tabg[:, :, _rel_bucket(dw)].astype(F32)

    def win_block(args):
        j, qb = args
        kb_ = lax.dynamic_slice_in_dim(kwp, j * NSA_WIN_BLOCK, span, axis=2)
        vb_ = lax.dynamic_slice_in_dim(vwp, j * NSA_WIN_BLOCK, span, axis=2)
        ok = (dw >= 0) & (dw < NSA_WINDOW) & (j * NSA_WIN_BLOCK - NSA_WINDOW + kidx >= 0)
        s = jnp.einsum('bghqd,bgkd->bghqk', qb, kb_).astype(F32) * ATTN_SCALE + bias_w
        pr, _ = _masked_softmax(s, ok)
        return jnp.einsum('bghqk,bgkd->bghqd', pr.astype(vb_.dtype), vb_)

    qwb = jnp.moveaxis(qg.reshape(B, G, hpg, nw, NSA_WIN_BLOCK, hd), 3, 0)
    o_win = jnp.moveaxis(lax.map(win_block, (jnp.arange(nw), qwb)), 0, 3).reshape(B, G, hpg, S, hd)
    o = (gates[..., 0:1] * o_cmp.reshape(B, H, S, hd) + gates[..., 1:2] * o_slc.reshape(B, H, S, hd)
         + gates[..., 2:3] * o_win.reshape(B, H, S, hd))
    return o.astype(q.dtype)


def _mixer_ab(xn, w_in, w_out, qn_a, kn_a, qn_b, kn_b, rel_bias):
    B, S, _ = xn.shape
    wa = MOBA_HEADS * HEAD_DIM
    wb = DIL_HEADS * HEAD_DIM
    qa, ka, va, qb, kb, vb = jnp.split(xn @ w_in, [wa, 2 * wa, 3 * wa, 3 * wa + wb, 3 * wa + 2 * wb], axis=-1)
    oa = _moba(_rms(_heads(qa, MOBA_HEADS), qn_a), _rms(_heads(ka, MOBA_HEADS), kn_a), _heads(va, MOBA_HEADS), rel_bias[:, :MOBA_HEADS].T)
    ob = _dilated(_rms(_heads(qb, DIL_HEADS), qn_b), _rms(_heads(kb, DIL_HEADS), kn_b), _heads(vb, DIL_HEADS), rel_bias[:, MOBA_HEADS:].T)
    o = jnp.concatenate([oa, ob], axis=1).transpose(0, 2, 1, 3).reshape(B, S, D_MODEL)
    return o @ w_out


def _mixer_nsa(xn, w_in, w_out, qn, kn_c, kn_s, kn_w, cmp_k, cmp_v, rel_bias):
    B, S, _ = xn.shape
    qw = NSA_HEADS * HEAD_DIM
    kvw = NSA_GROUPS * HEAD_DIM
    q, kc, vc, ks, vs, kw, vw, g = jnp.split(xn @ w_in, [qw + i * kvw for i in range(7)], axis=-1)
    q = _rms(_heads(q, NSA_HEADS), qn)
    kc = _rms(_compress(_heads(kc, NSA_GROUPS), *cmp_k), kn_c)
    vc = _compress(_heads(vc, NSA_GROUPS), *cmp_v)
    ks = _rms(_heads(ks, NSA_GROUPS), kn_s)
    kw = _rms(_heads(kw, NSA_GROUPS), kn_w)
    gates = jax.nn.sigmoid(g.astype(F32)).reshape(B, S, NSA_HEADS, 3).transpose(0, 2, 1, 3)
    o = _nsa(q, kc, vc, ks, _heads(vs, NSA_GROUPS), kw, _heads(vw, NSA_GROUPS), gates, rel_bias.T)
    return o.transpose(0, 2, 1, 3).reshape(B, S, D_MODEL) @ w_out


def _swiglu(x, wg, wu, wd):
    return (jax.nn.silu(x @ wg) * (x @ wu)) @ wd


def setup_inputs(seed: int = 0) -> dict:
    key = jax.random.key(seed)
    keys = iter(jax.random.split(key, 40))

    def nrm(shape, scale):
        return jax.random.normal(next(keys), shape, F32) * scale

    def gain(shape):
        return 1.0 + nrm(shape, 0.02)

    D, hd, F, CH = D_MODEL, HEAD_DIM, FFN_HIDDEN, NSA_CMP_HIDDEN
    res = (2 * DEPTH) ** -0.5
    w_ab = 3 * (MOBA_HEADS + DIL_HEADS) * hd
    w_nsa = NSA_HEADS * hd + 6 * NSA_GROUPS * hd + 3 * NSA_HEADS
    cin = NSA_CMP_LEN * hd
    return {
        'x': nrm((BATCH, SEQ, D), 1.0),
        'p': nrm((DEPTH, BATCH, SEQ, PLE_DIM), 1.0),
        'rel_bias': nrm((REL_BUCKETS, N_HEADS), 0.5),
        'norm_mix': gain((DEPTH, D)),
        'norm_ffn': gain((DEPTH, D)),
        'norm_ple': gain((DEPTH, D)),
        'w_ffn_gate': nrm((DEPTH, D, F), D ** -0.5),
        'w_ffn_up': nrm((DEPTH, D, F), D ** -0.5),
        'w_ffn_down': nrm((DEPTH, F, D), F ** -0.5 * res),
        'w_ple_proj': nrm((DEPTH, PLE_DIM, D), PLE_DIM ** -0.5 * res),
        'w_ple_gate': nrm((DEPTH, D, D), D ** -0.5),
        'w_in_ab': nrm((N_EVEN, D, w_ab), D ** -0.5),
        'w_out_ab': nrm((N_EVEN, D, D), D ** -0.5 * res),
        'qn_moba': gain((N_EVEN, hd)),
        'kn_moba': gain((N_EVEN, hd)),
        'qn_dil': gain((N_EVEN, hd)),
        'kn_dil': gain((N_EVEN, hd)),
        'w_in_nsa': nrm((N_ODD, D, w_nsa), D ** -0.5),
        'w_out_nsa': nrm((N_ODD, D, D), D ** -0.5 * res),
        'qn_nsa': gain((N_ODD, hd)),
        'kn_cmp': gain((N_ODD, hd)),
        'kn_slc': gain((N_ODD, hd)),
        'kn_win': gain((N_ODD, hd)),
        'cmp_k_pos': nrm((N_ODD, NSA_CMP_LEN, hd), 0.1),
        'cmp_k_w1': nrm((N_ODD, cin, CH), cin ** -0.5),
        'cmp_k_b1': nrm((N_ODD, CH), 0.01),
        'cmp_k_w2': nrm((N_ODD, CH, hd), CH ** -0.5),
        'cmp_k_b2': nrm((N_ODD, hd), 0.01),
        'cmp_v_pos': nrm((N_ODD, NSA_CMP_LEN, hd), 0.1),
        'cmp_v_w1': nrm((N_ODD, cin, CH), cin ** -0.5),
        'cmp_v_b1': nrm((N_ODD, CH), 0.01),
        'cmp_v_w2': nrm((N_ODD, CH, hd), CH ** -0.5),
        'cmp_v_b2': nrm((N_ODD, hd), 0.01),
    }


def reference(x, p, rel_bias, norm_mix, norm_ffn, norm_ple, w_ffn_gate, w_ffn_up, w_ffn_down,
              w_ple_proj, w_ple_gate, w_in_ab, w_out_ab, qn_moba, kn_moba, qn_dil, kn_dil,
              w_in_nsa, w_out_nsa, qn_nsa, kn_cmp, kn_slc, kn_win,
              cmp_k_pos, cmp_k_w1, cmp_k_b1, cmp_k_w2, cmp_k_b2,
              cmp_v_pos, cmp_v_w1, cmp_v_b1, cmp_v_w2, cmp_v_b2):
    h = x
    for i in range(DEPTH):
        e = i // 2
        xn = _rms(h, norm_mix[i])
        if i % 2 == 0:
            mix = _mixer_ab(xn, w_in_ab[e], w_out_ab[e], qn_moba[e], kn_moba[e], qn_dil[e], kn_dil[e], rel_bias)
        else:
            cmp_k = (cmp_k_pos[e], cmp_k_w1[e], cmp_k_b1[e], cmp_k_w2[e], cmp_k_b2[e])
            cmp_v = (cmp_v_pos[e], cmp_v_w1[e], cmp_v_b1[e], cmp_v_w2[e], cmp_v_b2[e])
            mix = _mixer_nsa(xn, w_in_nsa[e], w_out_nsa[e], qn_nsa[e], kn_cmp[e], kn_slc[e], kn_win[e], cmp_k, cmp_v, rel_bias)
        h = h + mix.astype(h.dtype)
        h = h + _swiglu(_rms(h, norm_ffn[i]), w_ffn_gate[i], w_ffn_up[i], w_ffn_down[i])
        gate = jax.nn.sigmoid(_rms(h, norm_ple[i]) @ w_ple_gate[i])
        h = h + gate * (p[i] @ w_ple_proj[i])
    return h
```

```cpp
#include <hip/hip_runtime.h>
#include <cstdio>
#include <cstdint>

#ifndef MK_SPLIT
#define MK_SPLIT 1
#endif
#ifndef MK_DBG
#define MK_DBG 0
#define MK_DBG_OFF (0ull << 10)
#define MK_DBG_CNT (0)
#endif
#ifndef MK_MASK
#define MK_MASK 0xFFFF
#endif
#ifndef MK_PH_END
#define MK_PH_END 16
#endif

namespace pg8 {
#define PG8_LAS __attribute__((address_space(3)))
typedef unsigned short bf16_t;
typedef short bf16x8 __attribute__((ext_vector_type(8)));
typedef float f32x4 __attribute__((ext_vector_type(4)));
typedef unsigned u32x4 __attribute__((ext_vector_type(4)));
constexpr int BM = 256, BK = 64, HALF = 128, HTB = HALF * BK * 2  , STAGE_BYTES = 8 * HTB, NXCD = 8, WGM = 8;

__host__ __device__ __forceinline__ int lds_byte(int r, int c) { const int st = (r >> 4) * 2 + (c >> 5), rr = r & 15, cc = c & 31, ob = rr * 64 + cc * 2; return st * 1024 + (ob ^ (((ob >> 9) & 1) << 5)); }
__host__ __device__ __forceinline__ void stage_rc(int b, int& R, int& C) { const int st = b / 1024, sb = b % 1024, swz = sb ^ (((sb >> 9) & 1) << 5); R = (st >> 1) * 16 + swz / 64; C = (st & 1) * 32 + (swz % 64) / 2; }
__host__ __device__ __forceinline__ int perm32(int rho) { const int n = rho >> 4, i = rho & 15; return 8 * (i >> 2) + 4 * n + (i & 3); }

struct Unit { int pm, pn; };
struct Gemm { const bf16_t* A; const bf16_t* Bt; int M, N, K; };

struct StaticOrder {
    int nM, nN, nwg, G, c;
    __host__ __device__ void init(int M, int N, int G_, int c_) { nM = M / BM; nN = N / BM; nwg = nM * nN; G = G_; c = c_; }
    __host__ __device__ bool next(int i, Unit& u) const {
        const long L = (long)i * G + c; if (L >= nwg) return false;
        int wgid = (int)L; { const int q = nwg / NXCD, r = nwg % NXCD, xcd = wgid % NXCD, off = wgid / NXCD; wgid = (xcd < r ? xcd * (q + 1) : r * (q + 1) + (xcd - r) * q) + off; }
        const int nig = WGM * nN, gid = wgid / nig, fm = gid * WGM, gsz = (nM - fm) < WGM ? (nM - fm) : WGM;
        u.pm = fm + ((wgid % nig) % gsz); u.pn = (wgid % nig) / gsz; return true;
    }
    __device__ __forceinline__ void a_ready(const Unit&) const {}
    __device__ __forceinline__ void done(const Unit&) const {}
};

__device__ __forceinline__ unsigned cvt_pk_bf16(float lo, float hi) { unsigned r; asm volatile("v_cvt_pk_bf16_f32 %0, %1, %2" : "=v"(r) : "v"(lo), "v"(hi)); return r; }
template <class Epi, class Sched, bool ALIGN_EPI = false, bool SP2 = false>
__device__ __forceinline__ void gemm_phase(PG8_LAS unsigned char* lds, const Gemm g, const Sched& S, const Epi& E) {
    int tid_ = threadIdx.x; asm volatile("" : "+v"(tid_));
    const int tid = tid_, wid = __builtin_amdgcn_readfirstlane(tid >> 6), lane = tid & 63, wr = wid >> 2, wc = wid & 3, fr = lane & 15, fq = lane >> 4;
    const int K = g.K, nt = K / BK;
    unsigned voffA[2], voffB[2];
#pragma unroll
    for (int i = 0; i < 2; ++i) { int R, C; stage_rc(tid * 16 + i * 8192, R, C); const int Rb = Epi::PERM ? ((R & ~31) + perm32(R & 31)) : R;
        voffA[i] = (unsigned)(R * K + C) * 2u; voffB[i] = (unsigned)(Rb * K + C) * 2u; }
    const size_t kstep = (size_t)(BK * 2);
    const size_t hstep = (size_t)HALF * K * 2;
    const size_t tstep = 2 * hstep;
    const unsigned ldsw = (unsigned)wid * 1024u;
    const int aoff = lds_byte(wr * 64 + fr, fq * 8), boff = lds_byte(wc * 32 + fr, fq * 8);
#define PG8_SA(b, h) (((b) * 2 + (h)) * HTB)
#define PG8_SB(b, h) ((4 + (b) * 2 + (h)) * HTB)
#define PG8_STAGE(bufoff, gbase, voff) do { _Pragma("unroll") for (int _i = 0; _i < 2; ++_i) \
        __builtin_amdgcn_global_load_lds((const unsigned*)((const char*)(gbase) + (voff)[_i]), (PG8_LAS unsigned*)(lds + (bufoff) + ldsw + _i * 8192), 16, 0, 0); } while (0)
#define PG8_LDA(dst, b, h) do { _Pragma("unroll") for (int m = 0; m < 4; ++m) _Pragma("unroll") for (int k = 0; k < 2; ++k) dst[m][k] = *(const PG8_LAS bf16x8*)(lds + PG8_SA(b, h) + aoff + m * 2048 + k * 1024); } while (0)
#define PG8_LDB(dst, b, h) do { _Pragma("unroll") for (int n = 0; n < 2; ++n) _Pragma("unroll") for (int k = 0; k < 2; ++k) dst[n][k] = *(const PG8_LAS bf16x8*)(lds + PG8_SB(b, h) + boff + n * 2048 + k * 1024); } while (0)
#define PG8_MMA(ai, bj, At, Bt) do { __builtin_amdgcn_s_setprio(1); _Pragma("unroll") for (int m = 0; m < 4; ++m) _Pragma("unroll") for (int n = 0; n < 2; ++n) _Pragma("unroll") for (int k = 0; k < 2; ++k) \
        acc[ai][bj][m][n] = __builtin_amdgcn_mfma_f32_16x16x32_bf16(Bt[n][k], At[m][k], acc[ai][bj][m][n], 0, 0, 0); __builtin_amdgcn_s_setprio(0); } while (0)
#define PG8_WAIT_V(n) asm volatile("s_waitcnt vmcnt(" #n ")" ::: "memory")
#define PG8_WAIT_L(n) asm volatile("s_waitcnt lgkmcnt(" #n ")" ::: "memory")
#define PG8_BAR __builtin_amdgcn_s_barrier()
#define PG8_SCHED __builtin_amdgcn_sched_barrier(0)
    Unit cur, nxt; int ui = 0;
    if (!S.next(0, cur)) return;
    f32x4 acc[2][2][4][2];
#pragma unroll
    for (int a = 0; a < 2; ++a)
#pragma unroll
        for (int b = 0; b < 2; ++b)
#pragma unroll
            for (int m = 0; m < 4; ++m)
#pragma unroll
                for (int n = 0; n < 2; ++n) acc[a][b][m][n] = (f32x4){0.f, 0.f, 0.f, 0.f};
    bf16x8 At[4][2], B0[2][2], B1[2][2];
    const char* cA = (const char*)g.A + (size_t)cur.pm * tstep; const char* cB = (const char*)g.Bt + (size_t)cur.pn * tstep;
    S.a_ready(cur);
    if constexpr (SP2) {
        PG8_STAGE(PG8_SB(0, 0), cB, voffB); PG8_STAGE(PG8_SB(0, 1), cB + hstep, voffB); PG8_STAGE(PG8_SA(0, 0), cA, voffA); PG8_STAGE(PG8_SA(0, 1), cA + hstep, voffA);
        if (wr == 1) PG8_BAR;
        PG8_WAIT_V(2); PG8_BAR;
        PG8_STAGE(PG8_SB(1, 0), cB + kstep, voffB); PG8_STAGE(PG8_SA(1, 0), cA + kstep, voffA); PG8_STAGE(PG8_SB(1, 1), cB + hstep + kstep, voffB);
        PG8_WAIT_V(6); PG8_BAR;
    } else {
        PG8_STAGE(PG8_SB(0, 0), cB, voffB); PG8_STAGE(PG8_SA(0, 0), cA, voffA); PG8_STAGE(PG8_SB(0, 1), cB + hstep, voffB); PG8_STAGE(PG8_SA(0, 1), cA + hstep, voffA);
        if (wr == 1) PG8_BAR;
        PG8_WAIT_V(4); PG8_BAR;
        PG8_STAGE(PG8_SB(1, 0), cB + kstep, voffB); PG8_STAGE(PG8_SA(1, 0), cA + kstep, voffA); PG8_STAGE(PG8_SB(1, 1), cB + hstep + kstep, voffB);
        PG8_WAIT_V(6); PG8_BAR;
    }
    for (;;) {
        const bool has_next = S.next(ui + 1, nxt);
        const char* nA = has_next ? (const char*)g.A + (size_t)nxt.pm * tstep : cA; const char* nB = has_next ? (const char*)g.Bt + (size_t)nxt.pn * tstep : cB;
        for (int t = 0; t < nt; t += 2) {
            const bool last = (t == nt - 2);
            const char* a1 = cA + (size_t)(t + 1) * kstep;
            const char* a2 = last ? nA : cA + (size_t)(t + 2) * kstep; const char* b2 = last ? nB : cB + (size_t)(t + 2) * kstep;
            const char* a3 = a2 + kstep; const char* b3 = b2 + kstep;
            if (last && has_next) S.a_ready(nxt);
            if constexpr (SP2) {
            PG8_LDB(B0, 0, 0); PG8_LDB(B1, 0, 1); PG8_SCHED; PG8_LDA(At, 0, 0); PG8_STAGE(PG8_SA(1, 1), a1 + hstep, voffA);
            PG8_WAIT_V(8); PG8_WAIT_L(0); PG8_BAR; PG8_MMA(0, 0, At, B0); PG8_MMA(0, 1, At, B1); PG8_BAR; PG8_SCHED;
            PG8_LDA(At, 0, 1); PG8_STAGE(PG8_SB(0, 0), b2, voffB); PG8_STAGE(PG8_SB(0, 1), b2 + hstep, voffB); PG8_STAGE(PG8_SA(0, 0), a2, voffA);
            PG8_WAIT_V(8); PG8_WAIT_L(0); PG8_BAR; PG8_MMA(1, 0, At, B0); PG8_MMA(1, 1, At, B1); PG8_BAR; PG8_SCHED;
            PG8_LDB(B0, 1, 0); PG8_LDB(B1, 1, 1); PG8_SCHED; PG8_LDA(At, 1, 0); PG8_STAGE(PG8_SA(0, 1), a2 + hstep, voffA);
            PG8_WAIT_V(8); PG8_WAIT_L(0); PG8_BAR; PG8_MMA(0, 0, At, B0); PG8_MMA(0, 1, At, B1); PG8_BAR; PG8_SCHED;
            PG8_LDA(At, 1, 1); PG8_STAGE(PG8_SB(1, 0), b3, voffB); PG8_STAGE(PG8_SB(1, 1), b3 + hstep, voffB); PG8_STAGE(PG8_SA(1, 0), a3, voffA);
            PG8_WAIT_V(8); PG8_WAIT_L(0); PG8_BAR; PG8_MMA(1, 0, At, B0); PG8_MMA(1, 1, At, B1); PG8_BAR; PG8_SCHED;
            } else {
            PG8_LDB(B0, 0, 0); PG8_SCHED; PG8_LDA(At, 0, 0); PG8_STAGE(PG8_SA(1, 1), a1 + hstep, voffA);
            PG8_WAIT_L(8); PG8_BAR; PG8_WAIT_L(0); PG8_MMA(0, 0, At, B0); PG8_BAR; PG8_SCHED;
            PG8_LDB(B1, 0, 1); PG8_STAGE(PG8_SB(0, 0), b2, voffB);
            PG8_BAR; PG8_WAIT_L(0); PG8_MMA(0, 1, At, B1); PG8_BAR;
            PG8_LDA(At, 0, 1); PG8_STAGE(PG8_SA(0, 0), a2, voffA);
            PG8_BAR; PG8_WAIT_L(0); PG8_MMA(1, 0, At, B0); PG8_BAR; PG8_SCHED;
            PG8_STAGE(PG8_SB(0, 1), b2 + hstep, voffB);
            PG8_WAIT_V(6); PG8_BAR; PG8_MMA(1, 1, At, B1); PG8_BAR;
            PG8_LDB(B0, 1, 0); PG8_SCHED; PG8_LDA(At, 1, 0); PG8_STAGE(PG8_SA(0, 1), a2 + hstep, voffA);
            PG8_WAIT_L(8); PG8_BAR; PG8_WAIT_L(0); PG8_MMA(0, 0, At, B0); PG8_BAR; PG8_SCHED;
            PG8_LDB(B1, 1, 1); PG8_STAGE(PG8_SB(1, 0), b3, voffB);
            PG8_BAR; PG8_WAIT_L(0); PG8_MMA(0, 1, At, B1); PG8_BAR;
            PG8_LDA(At, 1, 1); PG8_STAGE(PG8_SA(1, 0), a3, voffA);
            PG8_BAR; PG8_WAIT_L(0); PG8_MMA(1, 0, At, B0); PG8_BAR; PG8_SCHED;
            PG8_STAGE(PG8_SB(1, 1), b3 + hstep, voffB);
            PG8_WAIT_V(6); PG8_BAR; PG8_MMA(1, 1, At, B1); PG8_BAR;
            }
        }
        if constexpr (ALIGN_EPI) { if (wr == 0) PG8_BAR; }
        if constexpr (!Epi::AFTER_DRAIN) { E(acc, cur, wr, wc, fr, fq); S.done(cur); }
        if (!has_next) break;
#pragma unroll
        for (int a = 0; a < 2; ++a)
#pragma unroll
            for (int b = 0; b < 2; ++b)
#pragma unroll
                for (int m = 0; m < 4; ++m)
#pragma unroll
                    for (int n = 0; n < 2; ++n) acc[a][b][m][n] = (f32x4){0.f, 0.f, 0.f, 0.f};
        cur = nxt; cA = nA; cB = nB; ++ui;
        if constexpr (ALIGN_EPI) { if (wr == 1) PG8_BAR; }
    }
    PG8_WAIT_V(0);
    if constexpr (!ALIGN_EPI) { if (wr == 0) PG8_BAR; }
    PG8_BAR;
    if constexpr (Epi::AFTER_DRAIN) { E.fused(acc, cur, wr, wc, fr, fq, lds, wid, lane); S.done(cur); }
#undef PG8_SA
#undef PG8_SB
#undef PG8_STAGE
#undef PG8_LDA
#undef PG8_LDB
#undef PG8_MMA
#undef PG8_WAIT_V
#undef PG8_WAIT_L
#undef PG8_BAR
#undef PG8_SCHED
}
}

constexpr int BATCH = 8, SEQ = 2048, DM = 1024, M = BATCH * SEQ, FF = 2816, PLE = 256;
constexpr int NH = 16, HD = 64;
constexpr int N_IN0 = 3072, N_IN1 = 2608, N_IN1P = 2816, N_GU = 2 * FF;
constexpr float RMS_EPS = 1e-6f;
constexpr float LOG2E = 1.4426950408889634f;
constexpr float C2 = 0.125f * LOG2E;
constexpr int TABN = 1536;

constexpr size_t MiB = 1u << 20, KiB = 1u << 10;
constexpr size_t WS_CTL = 0, CTL_ZERO_BYTES = 2 * MiB;
constexpr size_t WS_SS = 256 * KiB;
constexpr size_t WS_KMEAN = 1280 * KiB;
constexpr size_t WS_W = 2 * MiB;
constexpr size_t WS_WIN0 = WS_W, WS_WOUT0 = WS_WIN0 + 6 * MiB, WS_WGU0 = WS_WOUT0 + 2 * MiB, WS_WD0 = WS_WGU0 + 11 * MiB,
                 WS_WPG0 = WS_WD0 + 5632 * KiB, WS_WPP0 = WS_WPG0 + 2 * MiB,
                 WS_WIN1 = WS_WPP0 + 512 * KiB, WS_WOUT1 = WS_WIN1 + 5632 * KiB, WS_WGU1 = WS_WOUT1 + 2 * MiB, WS_WD1 = WS_WGU1 + 11 * MiB,
                 WS_WPG1 = WS_WD1 + 5632 * KiB, WS_WPP1 = WS_WPG1 + 2 * MiB,
                 WS_CW1K = WS_WPP1 + 512 * KiB, WS_CW1V = WS_CW1K + 512 * KiB, WS_CW2K = WS_CW1V + 512 * KiB, WS_CW2V = WS_CW2K + 16 * KiB,
                 WS_WEND = WS_CW2V + 16 * KiB;
static_assert(WS_WEND <= 58 * MiB, "weights");
constexpr size_t WS_MISC = 58 * MiB;
constexpr size_t WS_BIASD = WS_MISC;
constexpr size_t WS_CB1 = WS_MISC + 128 * KiB;
constexpr size_t WS_GN = WS_MISC + 192 * KiB;
constexpr size_t WS_KC = WS_MISC + 256 * KiB, WS_VC = WS_KC + 512 * KiB;
constexpr size_t WS_HB = 60 * MiB;
constexpr size_t WS_PP = 92 * MiB;
constexpr size_t WS_O = 124 * MiB;
constexpr size_t WS_QKV = 156 * MiB;
constexpr size_t WS_Q = WS_QKV, WS_K0 = WS_QKV + 32 * MiB, WS_V0 = WS_QKV + 64 * MiB;
constexpr size_t WS_KV1 = WS_QKV + 32 * MiB;
constexpr size_t WS_HID = WS_QKV;
constexpr size_t WS_PB1 = WS_QKV + 88 * MiB;
constexpr size_t WS_PB0 = WS_O;
constexpr size_t WS_GATES = 252 * MiB;
constexpr size_t WS_END = 256 * MiB;
static_assert(WS_QKV + 96 * MiB <= WS_GATES && WS_GATES + 3 * MiB <= WS_END, "ws map");

constexpr int CW_BAR = 4096;

constexpr int WAVE_LDS = 16512;
constexpr int KCH = 1040;
constexpr int TAB_OFF = 8 * WAVE_LDS;
constexpr int KM_OFF = TAB_OFF + 4 * TABN * 4;
constexpr int MISC_OFF = KM_OFF + 2048;
constexpr int LDS_BYTES = MISC_OFF + 512;
static_assert(LDS_BYTES <= 163840 && TAB_OFF >= 131072, "LDS map");

#define GAS __attribute__((address_space(1)))
#define LAS __attribute__((address_space(3)))
typedef unsigned short bf16;
typedef float f32x4 __attribute__((ext_vector_type(4)));
typedef float f32x16 __attribute__((ext_vector_type(16)));
typedef short bf16x8 __attribute__((ext_vector_type(8)));
typedef unsigned u32x4 __attribute__((ext_vector_type(4)));
typedef unsigned u32x2 __attribute__((ext_vector_type(2)));
typedef GAS unsigned gu32;

__device__ __forceinline__ unsigned f2bf(float f) { unsigned u = __builtin_bit_cast(unsigned, f); return (u + 0x7fffu + ((u >> 16) & 1u)) >> 16; }
__device__ __forceinline__ unsigned pk2(float lo, float hi) { return f2bf(lo) | (f2bf(hi) << 16); }
__device__ __forceinline__ float bf2f(unsigned short h) { return __builtin_bit_cast(float, (unsigned)h << 16); }
typedef float f32x2_t __attribute__((ext_vector_type(2))); typedef __bf16 bf16x2_t __attribute__((ext_vector_type(2)));
__device__ __forceinline__ unsigned cvtpk(float lo, float hi) { f32x2_t v = {lo, hi}; bf16x2_t b = __builtin_convertvector(v, bf16x2_t); return __builtin_bit_cast(unsigned, b); }
__device__ __forceinline__ float fast_exp2(float x) { return __builtin_amdgcn_exp2f(x); }
__device__ __forceinline__ float fast_rcp(float x) { return __builtin_amdgcn_rcpf(x); }
__device__ __forceinline__ float sigmoidf_(float x) { return fast_rcp(1.0f + fast_exp2(-x * LOG2E)); }

using pg8::Unit;
typedef float accf4 __attribute__((ext_vector_type(4)));
#define EPI_ARGS const accf4 (&acc)[2][2][4][2], const Unit& u, int wr, int wc, int fr_in, int fq_in
#define EPI_OPAQUE int fr = fr_in, fq = fq_in; asm volatile("" : "+v"(fr), "+v"(fq));
typedef unsigned long long ss_t;
constexpr float SS_SCALE = 16777216.0f;
__device__ __forceinline__ float rstd_row(const ss_t* ss, int row) { return rsqrtf((float)ss[row] * (1.0f / (SS_SCALE * DM)) + RMS_EPS); }

struct EpiStoreBf16 {
    static constexpr bool PERM = true, AFTER_DRAIN = false;
    bf16* O; int ldc;
    __device__ __forceinline__ void operator()(EPI_ARGS) const {
        EPI_OPAQUE
        const int row0 = u.pm * 256 + wr * 64 + fr, col0 = u.pn * 256 + wc * 32 + 8 * fq;
#pragma unroll
        for (int ai = 0; ai < 2; ++ai)
#pragma unroll
            for (int m = 0; m < 4; ++m) { bf16* rowp = O + (size_t)(row0 + ai * 128 + m * 16) * ldc + col0;
#pragma unroll
                for (int bj = 0; bj < 2; ++bj) { const accf4 v0 = acc[ai][bj][m][0], v1 = acc[ai][bj][m][1];
                    u32x4 w; w.x = cvtpk(v0[0], v0[1]); w.y = cvtpk(v0[2], v0[3]); w.z = cvtpk(v1[0], v1[1]); w.w = cvtpk(v1[2], v1[3]);
                    *(u32x4*)(rowp + bj * 128) = w; } }
    }
};

template <int MODE> struct EpiResid {
    static constexpr bool PERM = true, AFTER_DRAIN = false;
    const float* base; float* out; bf16* hb; ss_t* ss_out; const ss_t* ss_in; const bf16* pp;
    __device__ __forceinline__ void operator()(EPI_ARGS) const {
        EPI_OPAQUE
        const int row0 = u.pm * 256 + wr * 64 + fr, col0 = u.pn * 256 + wc * 32 + 8 * fq;
#pragma unroll
        for (int ai = 0; ai < 2; ++ai)
#pragma unroll
            for (int m = 0; m < 4; ++m) {
                const int row = row0 + ai * 128 + m * 16; const size_t off = (size_t)row * DM + col0;
                float rs = 1.f; if (MODE == 1) rs = rstd_row(ss_in, row);
                float sq = 0.f;
#pragma unroll
                for (int bj = 0; bj < 2; ++bj) {
                    accf4 v0 = acc[ai][bj][m][0], v1 = acc[ai][bj][m][1];
                    const f32x4 b0 = *(const f32x4*)(base + off + bj * 128), b1 = *(const f32x4*)(base + off + bj * 128 + 4);
                    if (MODE == 1) {
                        const u32x4 pw = *(const u32x4*)(pp + off + bj * 128);
                        const float p[8] = {__builtin_bit_cast(float, pw.x << 16), __builtin_bit_cast(float, pw.x & 0xffff0000u), __builtin_bit_cast(float, pw.y << 16), __builtin_bit_cast(float, pw.y & 0xffff0000u),
                                            __builtin_bit_cast(float, pw.z << 16), __builtin_bit_cast(float, pw.z & 0xffff0000u), __builtin_bit_cast(float, pw.w << 16), __builtin_bit_cast(float, pw.w & 0xffff0000u)};
#pragma unroll
                        for (int i = 0; i < 4; ++i) { v0[i] = sigmoidf_(v0[i] * rs) * p[i]; v1[i] = sigmoidf_(v1[i] * rs) * p[4 + i]; }
                    }
                    const f32x4 h0 = b0 + v0, h1 = b1 + v1;
                    *(f32x4*)(out + off + bj * 128) = h0; *(f32x4*)(out + off + bj * 128 + 4) = h1;
                    u32x4 w; w.x = cvtpk(h0[0], h0[1]); w.y = cvtpk(h0[2], h0[3]); w.z = cvtpk(h1[0], h1[1]); w.w = cvtpk(h1[2], h1[3]);
                    *(u32x4*)(hb + off + bj * 128) = w;
                    sq += (h0[0] * h0[0] + h0[1] * h0[1]) + (h0[2] * h0[2] + h0[3] * h0[3]) + (h1[0] * h1[0] + h1[1] * h1[1]) + (h1[2] * h1[2] + h1[3] * h1[3]);
                }
                sq += __shfl_xor(sq, 16); sq += __shfl_xor(sq, 32);
                if (ss_out && fq == 0) atomicAdd(ss_out + row, (ss_t)(sq * SS_SCALE));
            }
    }
};

struct EpiSwiglu {
    static constexpr bool PERM = true, AFTER_DRAIN = false;
    bf16* hid; const ss_t* ss_in;
    __device__ __forceinline__ void operator()(EPI_ARGS) const {
        EPI_OPAQUE
        const int row0 = u.pm * 256 + wr * 64 + fr, col0 = u.pn * 128 + wc * 32 + 8 * fq;
#pragma unroll
        for (int ai = 0; ai < 2; ++ai)
#pragma unroll
            for (int m = 0; m < 4; ++m) {
                const int row = row0 + ai * 128 + m * 16; const float rs = rstd_row(ss_in, row);
                float r[8];
#pragma unroll
                for (int n = 0; n < 2; ++n)
#pragma unroll
                    for (int i = 0; i < 4; ++i) { const float g = acc[ai][0][m][n][i] * rs, uu = acc[ai][1][m][n][i] * rs; r[4 * n + i] = g * sigmoidf_(g) * uu; }
                u32x4 w; w.x = cvtpk(r[0], r[1]); w.y = cvtpk(r[2], r[3]); w.z = cvtpk(r[4], r[5]); w.w = cvtpk(r[6], r[7]);
                *(u32x4*)(hid + (size_t)row * FF + col0) = w;
            }
    }
};

template <int LAYER> struct EpiInProj {
    static constexpr bool PERM = true, AFTER_DRAIN = false;
    const ss_t* ss_in; bf16* Q;
    const float* gains;
    float* kmean; float* gates;
    __device__ __forceinline__ void operator()(EPI_ARGS) const {
        EPI_OPAQUE
        const int pn = u.pn;
        const float* gain = gains; bool has_gain = false; bf16* dst = Q; int head, nheads; bool do_km = false;
        if (LAYER == 0) {
            const int t6 = pn >> 1, type = t6 % 3, grp = t6 / 3;
            head = grp * 8 + (pn & 1) * 4 + wc; nheads = 16;
            dst = Q + (size_t)type * ((size_t)M * DM);
            has_gain = type < 2; gain = gains + 64 * (grp * 2 + (type & 1)); do_km = (type == 1 && grp == 0);
        } else {
            if (pn < 4) { head = pn * 4 + wc; nheads = 16; has_gain = true; gain = gains + 64 * 4; }
            else { head = wc; nheads = 4; dst = Q + (size_t)M * DM + (size_t)(pn - 4) * ((size_t)BATCH * 4 * SEQ * HD); has_gain = (pn == 6) || (pn == 8); gain = gains + 64 * (pn == 6 ? 5 : 6); }
        }
        const int row0 = u.pm * 256 + wr * 64 + fr;
        if (LAYER == 1 && pn == 10) {
            if (wc == 0) {
#pragma unroll
                for (int ai = 0; ai < 2; ++ai)
#pragma unroll
                    for (int m = 0; m < 4; ++m) { const int row = row0 + ai * 128 + m * 16; const float rs = rstd_row(ss_in, row);
#pragma unroll
                        for (int bj = 0; bj < 2; ++bj) { const int j0 = 32 * bj + 8 * fq;
                            if (j0 < 48) { const accf4 v0 = acc[ai][bj][m][0], v1 = acc[ai][bj][m][1];
                                f32x4 g0, g1;
#pragma unroll
                                for (int i = 0; i < 4; ++i) { g0[i] = sigmoidf_(v0[i] * rs); g1[i] = sigmoidf_(v1[i] * rs); }
                                *(f32x4*)(gates + (size_t)row * 48 + j0) = g0; *(f32x4*)(gates + (size_t)row * 48 + j0 + 4) = g1; } } }
            }
            return;
        }
        float ksum[2][2][4];
#pragma unroll
        for (int bj = 0; bj < 2; ++bj)
#pragma unroll
            for (int n = 0; n < 2; ++n)
#pragma unroll
                for (int i = 0; i < 4; ++i) ksum[bj][n][i] = 0.f;
#pragma unroll
        for (int ai = 0; ai < 2; ++ai)
#pragma unroll
            for (int m = 0; m < 4; ++m) {
                const int row = row0 + ai * 128 + m * 16, b = row >> 11, s = row & (SEQ - 1); const float rs = rstd_row(ss_in, row);
                float v[2][2][4]; float sq = 0.f;
#pragma unroll
                for (int bj = 0; bj < 2; ++bj)
#pragma unroll
                    for (int n = 0; n < 2; ++n)
#pragma unroll
                        for (int i = 0; i < 4; ++i) { v[bj][n][i] = acc[ai][bj][m][n][i] * rs; sq += v[bj][n][i] * v[bj][n][i]; }
                if (has_gain) {
                    sq += __shfl_xor(sq, 16); sq += __shfl_xor(sq, 32);
                    const float r2 = rsqrtf(sq * (1.0f / HD) + RMS_EPS);
#pragma unroll
                    for (int bj = 0; bj < 2; ++bj)
#pragma unroll
                        for (int n = 0; n < 2; ++n) { const f32x4 gq = *(const f32x4*)(gain + 32 * bj + 8 * fq + 4 * n);
#pragma unroll
                            for (int i = 0; i < 4; ++i) v[bj][n][i] = v[bj][n][i] * r2 * gq[i]; }
                }
                if (LAYER == 0 && do_km) {
#pragma unroll
                    for (int bj = 0; bj < 2; ++bj)
#pragma unroll
                        for (int n = 0; n < 2; ++n)
#pragma unroll
                            for (int i = 0; i < 4; ++i) ksum[bj][n][i] += v[bj][n][i];
                }
                bf16* rowp = dst + ((size_t)(b * nheads + head) * SEQ + s) * HD + 8 * fq;
#pragma unroll
                for (int bj = 0; bj < 2; ++bj) { u32x4 w; w.x = cvtpk(v[bj][0][0], v[bj][0][1]); w.y = cvtpk(v[bj][0][2], v[bj][0][3]); w.z = cvtpk(v[bj][1][0], v[bj][1][1]); w.w = cvtpk(v[bj][1][2], v[bj][1][3]);
                    *(u32x4*)(rowp + 32 * bj) = w; }
                asm volatile("" ::: "memory");
            }
        if (LAYER == 0 && do_km) {
            const int b = u.pm >> 3, blk = u.pm & 7;
            float* kp = kmean + ((size_t)((b * 8 + head) * 8 + blk)) * HD + 8 * fq;
#pragma unroll
            for (int bj = 0; bj < 2; ++bj)
#pragma unroll
                for (int n = 0; n < 2; ++n)
#pragma unroll
                    for (int i = 0; i < 4; ++i) { float s = ksum[bj][n][i];
                        s += __shfl_xor(s, 1); s += __shfl_xor(s, 2); s += __shfl_xor(s, 4); s += __shfl_xor(s, 8);
                        if (fr == 0) atomicAdd(kp + 32 * bj + 4 * n + i, s); }
        }
    }
};
#define XB_TMO      128
#define XB_XCNT(j)  (256  + 64 * (j))
#define XB_XSUB(j)  (1280 + 64 * (j))
#define XB_XGEN(j)  (2304 + 64 * (j))
#define XB_TOP      3328
#define XB_TOPGEN   3392
#define XCD_BAR_WORDS 3456
#define XB_SPIN_CAP (1u << 18)

__device__ __forceinline__ unsigned xb_ld(unsigned* p)              { return __hip_atomic_load(p, __ATOMIC_RELAXED, __HIP_MEMORY_SCOPE_AGENT); }
__device__ __forceinline__ unsigned xb_add(unsigned* p, unsigned v) { return __hip_atomic_fetch_add(p, v, __ATOMIC_RELAXED, __HIP_MEMORY_SCOPE_AGENT); }
__device__ __forceinline__ unsigned xb_xcc_id() { return (unsigned)__builtin_amdgcn_s_getreg((3 << 11) | 20) & 0xFu; }
#define XB_SPIN(cond, bar) do { unsigned _sp = 0; while (cond) { __builtin_amdgcn_s_sleep(1); \
    if ((++_sp & 255u) == 0u) { if (xb_ld(&(bar)[XB_TMO])) break; if (_sp > XB_SPIN_CAP) { atomicAdd(&(bar)[XB_TMO], 1u); break; } } } } while (0)

struct XcdBarrier {
    unsigned* bar; unsigned x;
    volatile LAS unsigned* st;
};

__device__ __forceinline__ XcdBarrier xcd_barrier_post(unsigned* bar, volatile LAS unsigned* st) {
    XcdBarrier b; b.bar = bar; b.x = xb_xcc_id(); b.st = st;
    if (threadIdx.x == 0) (void)xb_add(&bar[XB_XCNT(b.x)], 1u);
    return b;
}
__device__ __forceinline__ void xcd_barrier_complete(unsigned* bar, unsigned x, unsigned& nloc, unsigned& nx) {
    const unsigned G = gridDim.x * gridDim.y * gridDim.z;
    unsigned sum, cnt, mine, sp = 0u;
    for (;;) {
        sum = 0u; cnt = 0u; mine = 0u;
#pragma unroll
        for (unsigned j = 0; j < 16; ++j) { const unsigned c = xb_ld(&bar[XB_XCNT(j)]); sum += c; cnt += (c > 0u) ? 1u : 0u; mine = (j == x) ? c : mine; }
        if (sum == G) break;
        __builtin_amdgcn_s_sleep(1);
        if ((++sp & 255u) == 0u) { if (xb_ld(&bar[XB_TMO])) break; if (sp > XB_SPIN_CAP) { atomicAdd(&bar[XB_TMO], 1u); break; } }
    }
    nloc = mine > 0u ? mine : 1u; nx = cnt > 0u ? cnt : 1u;
}

__device__ __forceinline__ void xcd_barrier(const XcdBarrier& b) {
    asm volatile("s_waitcnt vmcnt(0)" ::: "memory");
    __syncthreads();
    if (threadIdx.x == 0) {
        unsigned* bar = b.bar;
        __builtin_amdgcn_s_waitcnt(0);
        unsigned nloc = b.st[0], nx = b.st[1];
        if (nloc == 0u) { xcd_barrier_complete(bar, b.x, nloc, nx); b.st[0] = nloc; b.st[1] = nx; }
        const unsigned old = xb_add(&bar[XB_XSUB(b.x)], 1u);
        const unsigned gen = old / nloc;
        if (old + 1u == (gen + 1u) * nloc) {
            __builtin_amdgcn_fence(__ATOMIC_RELEASE, "agent");
            asm volatile("s_waitcnt vmcnt(0)" ::: "memory");
            const unsigned og = xb_add(&bar[XB_TOP], 1u);
            const unsigned tg = og / nx;
            if (og + 1u == (tg + 1u) * nx) xb_add(&bar[XB_TOPGEN], 1u);
            else XB_SPIN(xb_ld(&bar[XB_TOPGEN]) == tg, bar);
            __builtin_amdgcn_fence(__ATOMIC_ACQUIRE, "agent");
            xb_add(&bar[XB_XGEN(b.x)], 1u);
            asm volatile("s_waitcnt vmcnt(0)" ::: "memory");
        } else {
            XB_SPIN(xb_ld(&bar[XB_XGEN(b.x)]) == gen, bar);
            __builtin_amdgcn_fence(__ATOMIC_ACQUIRE, "agent");
            asm volatile("s_waitcnt vmcnt(0)" ::: "memory");
        }
    }
    __syncthreads();
}

__device__ __forceinline__ int crow(int r, int hi) { return (r & 3) + 8 * (r >> 2) + 4 * hi; }
__device__ __forceinline__ void glds16(const void* gsrc, unsigned lds_dst) { unsigned keep;
    asm volatile("s_mov_b32 %0, m0\n\ts_mov_b32 m0, %2\n\ts_nop 0\n\tglobal_load_lds_dwordx4 %1, off\n\ts_mov_b32 m0, %0" : "=&s"(keep) : "v"(gsrc), "s"(lds_dst) : "memory"); }
typedef short v4i16_t __attribute__((ext_vector_type(4)));
typedef LAS const char* lds_cptr;
__device__ __forceinline__ v4i16_t vtr(lds_cptr p) { return __builtin_amdgcn_ds_read_tr16_b64_v4i16((LAS v4i16_t*)p); }

struct WCtx { int lane, r32, hi; unsigned kl, vl; lds_cptr klp, vlp; };
__device__ __forceinline__ WCtx make_ctx(LAS unsigned char* L, int wave) {
    int lane = threadIdx.x & 63; asm volatile("" : "+v"(lane));
    WCtx c; c.lane = lane; c.r32 = lane & 31; c.hi = lane >> 5; c.klp = (lds_cptr)(L + wave * WAVE_LDS); c.vlp = c.klp + 8 * KCH;
    c.kl = (unsigned)(uintptr_t)((unsigned char*)L) + wave * WAVE_LDS; c.vl = c.kl + 8 * KCH; return c;
}
struct AState { f32x16 o0, o1; float m, l; };
__device__ __forceinline__ void astate_init(AState& s) {
#pragma unroll
    for (int r = 0; r < 16; ++r) { s.o0[r] = 0.f; s.o1[r] = 0.f; }
    s.m = -INFINITY; s.l = 0.f;
}

template <class RowF> __device__ __forceinline__ void tile_issue(const WCtx& c, const bf16* Kb, const bf16* Vb, RowF rowf) {
    asm volatile("s_waitcnt lgkmcnt(0)" ::: "memory");
    unsigned kro = (unsigned)rowf(c.lane) * 128u; asm volatile("" : "+v"(kro));
    const char* kp = (const char*)Kb + kro;
#pragma unroll
    for (int cc = 0; cc < 8; ++cc) glds16(kp + 16 * cc, (unsigned)__builtin_amdgcn_readfirstlane(c.kl + cc * KCH));
#pragma unroll
    for (int g = 0; g < 4; ++g) { unsigned vro = (unsigned)rowf(16 * g + (c.lane >> 2)) * 128u + (c.lane & 3) * 16; asm volatile("" : "+v"(vro));
        const char* vp = (const char*)Vb + vro;
        glds16(vp, (unsigned)__builtin_amdgcn_readfirstlane(c.vl + g * 1024));
        glds16(vp + 64, (unsigned)__builtin_amdgcn_readfirstlane(c.vl + (4 + g) * 1024)); }
}
__device__ __forceinline__ void tile_wait() { asm volatile("s_waitcnt vmcnt(0)" ::: "memory"); }

__device__ __forceinline__ void tile_qk(const WCtx& c, const bf16x8 (&qr)[4], f32x16& p0, f32x16& p1) {
#pragma unroll
    for (int r = 0; r < 16; ++r) { p0[r] = 0.f; p1[r] = 0.f; }
    lds_cptr kb = c.klp + c.hi * KCH + c.r32 * 16;
#pragma unroll
    for (int d0 = 0; d0 < 4; ++d0) {
        const bf16x8 b0 = *(LAS const bf16x8*)(kb + d0 * 2 * KCH), b1 = *(LAS const bf16x8*)(kb + d0 * 2 * KCH + 512);
        p0 = __builtin_amdgcn_mfma_f32_32x32x16_bf16(b0, qr[d0], p0, 0, 0, 0);
        p1 = __builtin_amdgcn_mfma_f32_32x32x16_bf16(b1, qr[d0], p1, 0, 0, 0);
    }
}
__device__ __forceinline__ void tile_pv(const WCtx& c, f32x16& o0, f32x16& o1, const f32x16& p0, const f32x16& p1) {
    u32x4 pw[4];
#pragma unroll
    for (int k = 0; k < 2; ++k) {
        pw[k]     = (u32x4){cvtpk(p0[8 * k], p0[8 * k + 1]), cvtpk(p0[8 * k + 2], p0[8 * k + 3]), cvtpk(p0[8 * k + 4], p0[8 * k + 5]), cvtpk(p0[8 * k + 6], p0[8 * k + 7])};
        pw[2 + k] = (u32x4){cvtpk(p1[8 * k], p1[8 * k + 1]), cvtpk(p1[8 * k + 2], p1[8 * k + 3]), cvtpk(p1[8 * k + 4], p1[8 * k + 5]), cvtpk(p1[8 * k + 6], p1[8 * k + 7])};
    }
    lds_cptr vb = c.vlp + ((c.lane >> 4) & 1) * 32 + (c.lane & 3) * 8 + (4 * c.hi + ((c.lane & 15) >> 2)) * 64;
#pragma unroll
    for (int ks = 0; ks < 4; ++ks) {
        const v4i16_t l0 = vtr(vb + ks * 1024), h0 = vtr(vb + ks * 1024 + 512), l1 = vtr(vb + 4096 + ks * 1024), h1 = vtr(vb + 4096 + ks * 1024 + 512);
        const bf16x8 v0 = (bf16x8){l0[0], l0[1], l0[2], l0[3], h0[0], h0[1], h0[2], h0[3]};
        const bf16x8 v1 = (bf16x8){l1[0], l1[1], l1[2], l1[3], h1[0], h1[1], h1[2], h1[3]};
        const bf16x8 pf = __builtin_bit_cast(bf16x8, pw[ks]);
        o0 = __builtin_amdgcn_mfma_f32_32x32x16_bf16(v0, pf, o0, 0, 0, 0);
        o1 = __builtin_amdgcn_mfma_f32_32x32x16_bf16(v1, pf, o1, 0, 0, 0);
        asm volatile("" ::: "memory");
    }
}
template <class ScoreF> __device__ __forceinline__ void tile_step(const WCtx& c, AState& st, const bf16x8 (&qr)[4], ScoreF sf) {
    f32x16 p0, p1; tile_qk(c, qr, p0, p1);
    float rm = -INFINITY;
#pragma unroll
    for (int r = 0; r < 16; ++r) { const int j = crow(r, c.hi); p0[r] = sf(p0[r], j); rm = fmaxf(rm, p0[r]); }
    asm volatile("" ::: "memory");
#pragma unroll
    for (int r = 0; r < 16; ++r) { const int j = crow(r, c.hi); p1[r] = sf(p1[r], j + 32); rm = fmaxf(rm, p1[r]); }
    asm volatile("" ::: "memory");
    rm = fmaxf(rm, __shfl_xor(rm, 32));
    const float mn = fmaxf(st.m, rm), mu = fmaxf(mn, -1e30f);
    const float f = fast_exp2(st.m - mu);
    st.m = mn;
    float sum = 0.f;
#pragma unroll
    for (int r = 0; r < 16; ++r) { p0[r] = fast_exp2(p0[r] - mu); p1[r] = fast_exp2(p1[r] - mu); sum += p0[r] + p1[r]; }
    st.l = st.l * f + sum;
#pragma unroll
    for (int r = 0; r < 16; ++r) { st.o0[r] *= f; st.o1[r] *= f; }
    tile_pv(c, st.o0, st.o1, p0, p1);
}
__device__ __forceinline__ void astate_fold(const AState& st, float w, f32x16& a0, f32x16& a1) {
    const float lt = st.l + __shfl_xor(st.l, 32);
    const float sc = lt > 0.f ? w / lt : 0.f;
#pragma unroll
    for (int r = 0; r < 16; ++r) { a0[r] += st.o0[r] * sc; a1[r] += st.o1[r] * sc; }
}
__device__ __forceinline__ void store_o(const WCtx& c, bf16* orow, const f32x16& a0, const f32x16& a1) {
#pragma unroll
    for (int g = 0; g < 4; ++g) {
        u32x2 w0, w1; w0.x = cvtpk(a0[4 * g], a0[4 * g + 1]); w0.y = cvtpk(a0[4 * g + 2], a0[4 * g + 3]); w1.x = cvtpk(a1[4 * g], a1[4 * g + 1]); w1.y = cvtpk(a1[4 * g + 2], a1[4 * g + 3]);
        *(u32x2*)(orow + 8 * g + 4 * c.hi) = w0; *(u32x2*)(orow + 32 + 8 * g + 4 * c.hi) = w1;
    }
}
__device__ __forceinline__ void load_q(bf16x8 (&qr)[4], const bf16* qrow, int hi) {
#pragma unroll
    for (int d0 = 0; d0 < 4; ++d0) qr[d0] = *(const bf16x8*)(qrow + d0 * 16 + hi * 8);
}
__device__ __forceinline__ float tab_at(LAS const float* tab, int d) { const unsigned i = (unsigned)d > (unsigned)(TABN - 1) ? (unsigned)(TABN - 1) : (unsigned)d; return tab[i]; }

__device__ __forceinline__ void moba_wave(LAS unsigned char* L_, int wid, int b, int h, int j, const bf16* Q, const bf16* K, const bf16* V, bf16* O, LAS const float* tab, LAS const float* km) {
    const WCtx c = make_ctx(L_, wid);
    const size_t hb = (size_t)(b * NH + h) * SEQ;
    const bf16* Kb = K + hb * HD; const bf16* Vb = V + hb * HD;
    const int t0 = 256 * j + 32 * wid, tq = t0 + c.r32;
    const bf16* qrow = Q + (hb + tq) * HD;
    bf16x8 qr[4]; load_q(qr, qrow, c.hi);
    unsigned sel = 0u;
    if (j > 0) {
        float g4[4] = {0.f, 0.f, 0.f, 0.f};
#pragma unroll
        for (int ch = 0; ch < 8; ++ch) {
            const u32x4 qq = *(const u32x4*)(qrow + 8 * ch);
            const float qf[8] = {__builtin_bit_cast(float, qq.x << 16), __builtin_bit_cast(float, qq.x & 0xffff0000u), __builtin_bit_cast(float, qq.y << 16), __builtin_bit_cast(float, qq.y & 0xffff0000u),
                                 __builtin_bit_cast(float, qq.z << 16), __builtin_bit_cast(float, qq.z & 0xffff0000u), __builtin_bit_cast(float, qq.w << 16), __builtin_bit_cast(float, qq.w & 0xffff0000u)};
#pragma unroll
            for (int k = 0; k < 4; ++k) { LAS const float* kr = km + (2 * k + c.hi) * 64 + 8 * ch;
                const f32x4 a = *(LAS const f32x4*)kr, bq = *(LAS const f32x4*)(kr + 4);
                g4[k] += (qf[0] * a[0] + qf[1] * a[1]) + (qf[2] * a[2] + qf[3] * a[3]) + (qf[4] * bq[0] + qf[5] * bq[1]) + (qf[6] * bq[2] + qf[7] * bq[3]); }
        }
        float ga[8];
#pragma unroll
        for (int k = 0; k < 4; ++k) { const float ot = __shfl_xor(g4[k], 32); ga[2 * k] = c.hi ? ot : g4[k]; ga[2 * k + 1] = c.hi ? g4[k] : ot; }
#pragma unroll
        for (int n = 0; n < 8; ++n) if (n >= j) ga[n] = -INFINITY;
#pragma unroll
        for (int n = 0; n < 8; ++n) { int rank = 0;
#pragma unroll
            for (int n2 = 0; n2 < 8; ++n2) if (n2 != n) rank += (n2 < n) ? (ga[n2] >= ga[n] ? 1 : 0) : (ga[n2] > ga[n] ? 1 : 0);
            if (rank < 3 && n < j) sel |= 1u << n; }
    }
    AState st; astate_init(st);
    const int nown = (wid >> 1) + 1;
    for (int kt = 0; kt < nown; ++kt) {
        const int k0 = 256 * j + 64 * kt;
        tile_issue(c, Kb, Vb, [&](int jj) { return k0 + jj; }); tile_wait();
        tile_step(c, st, qr, [&](float raw, int jj) { const int d = tq - (k0 + jj); return d >= 0 ? raw * C2 + tab_at(tab, d) : -INFINITY; });
    }
    for (int n = 0; n < j; ++n) {
        const bool mine = (sel >> n) & 1u;
        if (!__any(mine)) continue;
        for (int kt = 0; kt < 4; ++kt) {
            const int k0 = 256 * n + 64 * kt;
            tile_issue(c, Kb, Vb, [&](int jj) { return k0 + jj; }); tile_wait();
            tile_step(c, st, qr, [&](float raw, int jj) { const int d = tq - (k0 + jj); return mine ? raw * C2 + tab_at(tab, d) : -INFINITY; });
        }
    }
    f32x16 a0, a1;
#pragma unroll
    for (int r = 0; r < 16; ++r) { a0[r] = 0.f; a1[r] = 0.f; }
    astate_fold(st, 1.0f, a0, a1);
    store_o(c, O + ((size_t)b * SEQ + tq) * DM + h * HD, a0, a1);
}

__device__ __forceinline__ void dil_wave(LAS unsigned char* L_, int wid, int b, int h, int chunk, int rho, const bf16* Q, const bf16* K, const bf16* V, bf16* O, LAS const float* tab) {
    const WCtx c = make_ctx(L_, wid);
    const size_t hb = (size_t)(b * NH + h) * SEQ;
    const bf16* Kb = K + hb * HD; const bf16* Vb = V + hb * HD;
    const int t0 = 512 * chunk + rho, tq = t0 + 16 * c.r32;
    bf16x8 qr[4]; load_q(qr, Q + (hb + tq) * HD, c.hi);
    AState st; astate_init(st);
#pragma unroll 1
    for (int br = 0; br < 3; ++br) {
        const int r = br == 0 ? 1 : br == 1 ? 4 : 16;
        const int maxd = 128 * r, kbase = t0 - maxd;
        const int t_last = t0 + 16 * 31;
        const int ntile = (t_last - kbase) / (64 * r) + 1;
        for (int kt = 0; kt < ntile; ++kt) {
            const int k0 = kbase + 64 * r * kt;
            tile_issue(c, Kb, Vb, [&](int jj) { int kp = k0 + r * jj; kp = kp < 0 ? 0 : kp; return kp > SEQ - 1 ? SEQ - 1 : kp; }); tile_wait();
            tile_step(c, st, qr, [&](float raw, int jj) { const int kp = k0 + r * jj, d = tq - kp; return ((unsigned)d <= (unsigned)maxd && kp >= 0) ? raw * C2 + tab_at(tab, d) : -INFINITY; });
        }
    }
    f32x16 a0, a1;
#pragma unroll
    for (int r = 0; r < 16; ++r) { a0[r] = 0.f; a1[r] = 0.f; }
    astate_fold(st, 1.0f, a0, a1);
    store_o(c, O + ((size_t)b * SEQ + tq) * DM + h * HD, a0, a1);
}

__device__ __forceinline__ void nsa_wave(int wid, LAS unsigned char* lds, int b, int g, int chunk, const bf16* Q, const bf16* KV1, const bf16* KC, const bf16* VC,
                                         const float* gates, bf16* O, LAS const float* tabs) {
    const WCtx c = make_ctx(lds, wid);
    const int hh = wid & 3, qt = wid >> 2, h = 4 * g + hh;
    LAS const float* tab = tabs + hh * TABN;
    const int t0 = 64 * chunk + 32 * qt, tq = t0 + c.r32, cur = chunk;
    const size_t qb = (size_t)(b * NH + h) * SEQ, gb = (size_t)(b * 4 + g) * SEQ, TS = (size_t)BATCH * 4 * SEQ * HD;
    bf16x8 qr[4]; load_q(qr, Q + (qb + tq) * HD, c.hi);
    const bf16* KCb = KC + (size_t)(b * 4 + g) * 128 * HD; const bf16* VCb = VC + (size_t)(b * 4 + g) * 128 * HD;
    const float* grow = gates + ((size_t)b * SEQ + tq) * 48 + 3 * h;
    const float g0 = grow[0], g1 = grow[1], g2 = grow[2];
    f32x16 a0, a1;
#pragma unroll
    for (int r = 0; r < 16; ++r) { a0[r] = 0.f; a1[r] = 0.f; }
    f32x16 p[4];
    tile_issue(c, KCb, VCb, [&](int jj) { return jj; }); tile_wait();
    tile_qk(c, qr, p[0], p[1]);
    float rm = -INFINITY;
#pragma unroll
    for (int T = 0; T < 2; ++T)
#pragma unroll
        for (int r = 0; r < 16; ++r) { const int cc = 32 * T + crow(r, c.hi), dc = tq - (16 * cc + 31); p[T][r] = dc >= 0 ? p[T][r] * C2 + tab_at(tab, dc) : -INFINITY; rm = fmaxf(rm, p[T][r]); }
    {   asm volatile("s_waitcnt lgkmcnt(0)" ::: "memory");
        const char* kp = (const char*)KCb + (size_t)(64 + c.lane) * 128;
#pragma unroll
        for (int cc = 0; cc < 8; ++cc) glds16(kp + 16 * cc, (unsigned)__builtin_amdgcn_readfirstlane(c.kl + cc * KCH));
        tile_wait(); }
    tile_qk(c, qr, p[2], p[3]);
#pragma unroll
    for (int T = 2; T < 4; ++T)
#pragma unroll
        for (int r = 0; r < 16; ++r) { const int cc = 32 * T + crow(r, c.hi), dc = tq - (16 * cc + 31); p[T][r] = (dc >= 0 && cc < 127) ? p[T][r] * C2 + tab_at(tab, dc) : -INFINITY; rm = fmaxf(rm, p[T][r]); }
    rm = fmaxf(rm, __shfl_xor(rm, 32));
    const float mu = fmaxf(rm, -1e30f);
    float lsum = 0.f;
#pragma unroll
    for (int T = 0; T < 4; ++T)
#pragma unroll
        for (int r = 0; r < 16; ++r) { p[T][r] = fast_exp2(p[T][r] - mu); lsum += p[T][r]; }
    lsum += __shfl_xor(lsum, 32);
    const float linv = lsum > 0.f ? 1.0f / lsum : 0.f;
#pragma unroll
    for (int T = 0; T < 4; ++T)
#pragma unroll
        for (int r = 0; r < 16; ++r) p[T][r] *= linv;
    tile_pv(c, a0, a1, p[0], p[1]);
    {   asm volatile("s_waitcnt lgkmcnt(0)" ::: "memory");
#pragma unroll
        for (int gq = 0; gq < 4; ++gq) { const char* vp = (const char*)VCb + (size_t)(64 + 16 * gq + (c.lane >> 2)) * 128 + (c.lane & 3) * 16;
            glds16(vp, (unsigned)__builtin_amdgcn_readfirstlane(c.vl + gq * 1024));
            glds16(vp + 64, (unsigned)__builtin_amdgcn_readfirstlane(c.vl + (4 + gq) * 1024)); }
        tile_wait(); }
    tile_pv(c, a0, a1, p[2], p[3]);
#pragma unroll
    for (int r = 0; r < 16; ++r) { a0[r] *= g0; a1[r] *= g0; }
    LAS float* IA = (LAS float*)(lds + wid * WAVE_LDS); LAS float* IB = IA + 32 * 33;
    asm volatile("s_waitcnt lgkmcnt(0)" ::: "memory");
#pragma unroll
    for (int T = 0; T < 4; ++T)
#pragma unroll
        for (int gq = 0; gq < 4; ++gq) { const int n = 8 * T + 2 * gq + c.hi; const float b3 = 16.f * p[T][4 * gq + 3];
            IA[c.r32 * 33 + n] = 32.f * (p[T][4 * gq] + p[T][4 * gq + 1] + p[T][4 * gq + 2]) + b3; IB[c.r32 * 33 + n] = b3; }
    __syncthreads();
    float imp[16];
#pragma unroll
    for (int k = 0; k < 16; ++k) imp[k] = 0.f;
#pragma unroll
    for (int w4 = 0; w4 < 4; ++w4) { LAS const float* A = (LAS const float*)(lds + (w4 + 4 * qt) * WAVE_LDS) + c.r32 * 33; LAS const float* Bq = A + 32 * 33;
#pragma unroll
        for (int k = 0; k < 16; ++k) { const int n = 16 * c.hi + k; imp[k] += A[n] + (n > 0 ? Bq[n - 1] : 0.f); } }
    __syncthreads();
    int mine[16], oth[16];
#pragma unroll
    for (int k = 0; k < 16; ++k) { const int n = 16 * c.hi + k; const bool valid = n <= cur, forced = (n == 0) || (n == cur) || (n == cur - 1);
        mine[k] = !valid ? -2 : forced ? 0x7f000000 : __builtin_bit_cast(int, imp[k]);
        oth[k] = __shfl_xor(mine[k], 32); }
    unsigned selm = 0u;
#pragma unroll
    for (int k = 0; k < 16; ++k) { int rank = 0; const int me = mine[k], me1 = mine[k] - 1, meo = mine[k] - c.hi;
#pragma unroll
        for (int k2 = 0; k2 < 16; ++k2) { if (k2 < k) rank += mine[k2] > me1 ? 1 : 0; else if (k2 > k) rank += mine[k2] > me ? 1 : 0; rank += oth[k2] > meo ? 1 : 0; }
        if (rank < 16) selm |= 1u << k; }
    selm <<= 16 * c.hi;
    selm |= __shfl_xor(selm, 32);
    selm &= (cur >= 31) ? 0xffffffffu : ((2u << cur) - 1u);
    {   const bf16* Kb = KV1 + 2 * TS + gb * HD; const bf16* Vb = KV1 + 3 * TS + gb * HD;
        AState st; astate_init(st);
        for (int n = 0; n <= cur; ++n) {
            const bool mine = (selm >> n) & 1u;
            if (!__any(mine)) continue;
            const int k0 = 64 * n;
            tile_issue(c, Kb, Vb, [&](int jj) { return k0 + jj; }); tile_wait();
            tile_step(c, st, qr, [&](float raw, int jj) { const int d = tq - (k0 + jj); return (mine && d >= 0) ? raw * C2 + tab_at(tab, d) : -INFINITY; });
        }
        astate_fold(st, g1, a0, a1);
    }
    {   const bf16* Kb = KV1 + 4 * TS + gb * HD; const bf16* Vb = KV1 + 5 * TS + gb * HD;
        AState st; astate_init(st);
        int lo = t0 - 511; lo = lo < 0 ? 0 : lo;
        for (int kt = lo >> 6; kt <= (t0 + 31) >> 6; ++kt) {
            const int k0 = 64 * kt;
            tile_issue(c, Kb, Vb, [&](int jj) { return k0 + jj; }); tile_wait();
            tile_step(c, st, qr, [&](float raw, int jj) { const int d = tq - (k0 + jj); return ((unsigned)d < 512u) ? raw * C2 + tab_at(tab, d) : -INFINITY; });
        }
        astate_fold(st, g2, a0, a1);
    }
    store_o(c, O + ((size_t)b * SEQ + tq) * DM + h * HD, a0, a1);
}

#define LDS_WAIT() asm volatile("s_waitcnt lgkmcnt(0)" ::: "memory")
#define VM_WAIT() asm volatile("s_waitcnt vmcnt(0)" ::: "memory")
constexpr int NWAVES = 8;
__device__ __forceinline__ float wave_sum(float v) {
#pragma unroll
    for (int o = 1; o < 64; o <<= 1) v += __shfl_xor(v, o);
    return v;
}

struct Args { const float* in[33]; float* out; unsigned char* ws; int ph_lo, ph_hi; };

__device__ __forceinline__ void tr_item(const float* src, int Nsrc, int srccol0, const float* gain, bf16* dst, int Kdst, int dstrow0, int k0, LAS float* scr, int lane) {
    const int col = srccol0 + (lane & 31); const bool ok = col < Nsrc;
#pragma unroll 8
    for (int i = 0; i < 32; ++i) { const int kk = 2 * i + (lane >> 5); float v = ok ? src[(size_t)(k0 + kk) * Nsrc + col] : 0.f; if (gain) v *= gain[k0 + kk]; scr[kk * 33 + (lane & 31)] = v; }
    LDS_WAIT(); asm volatile("" ::: "memory");
    const int c = lane & 7;
#pragma unroll
    for (int j = 0; j < 4; ++j) { const int n = (lane >> 3) + 8 * j; const LAS float* s = scr + (8 * c) * 33 + n;
        u32x4 o; o.x = pk2(s[0 * 33], s[1 * 33]); o.y = pk2(s[2 * 33], s[3 * 33]); o.z = pk2(s[4 * 33], s[5 * 33]); o.w = pk2(s[6 * 33], s[7 * 33]);
        *(GAS u32x4*)(dst + (size_t)(dstrow0 + n) * Kdst + k0 + 8 * c) = o; }
    LDS_WAIT(); asm volatile("" ::: "memory");
}
__device__ __forceinline__ void tr_matrix(int item, const float* src, const float* src2, int Ksrc, int Nsrc, int Ndst, int map, const float* gain, bf16* dst, LAS float* scr, int lane) {
    const int nblk = Ndst / 32, kb = item / nblk, nb = item % nblk;
    int srccol0 = 32 * nb; const float* s = src;
    if (map == 1) { const int pn = nb >> 3, pb = nb & 7, half = pb >> 2, hh = pb & 3; srccol0 = 256 * pn + 64 * hh + 32 * half; }
    else if (map == 2) { const int pn = nb >> 3, pb = nb & 7; srccol0 = 128 * pn + 32 * (pb & 3); s = (pb < 4) ? src : src2; }
    tr_item(s, Nsrc, srccol0, gain, dst, Ksrc, 32 * nb, 64 * kb, scr, lane);
}

__device__ __forceinline__ int rel_bucket(int d) {
    if (d < 16) return d;
    int b = 16;
    b += d >= 22; b += d >= 30; b += d >= 40; b += d >= 54; b += d >= 73; b += d >= 99; b += d >= 134; b += d >= 182;
    b += d >= 246; b += d >= 332; b += d >= 450; b += d >= 609; b += d >= 825; b += d >= 1117; b += d >= 1513;
    return b;
}

__global__ void __launch_bounds__(NWAVES * 64, 2) fwd_kernel(Args args) {
    extern __shared__ __attribute__((aligned(16))) unsigned char lds[];
    LAS unsigned char* L = (LAS unsigned char*)lds;
    volatile LAS unsigned* MISC = (volatile LAS unsigned*)(L + MISC_OFF);
    const int tid = threadIdx.x, lane = tid & 63, wave = __builtin_amdgcn_readfirstlane(tid >> 6);
    const int G = gridDim.x; const int bx = blockIdx.x; const int vcu = (G % 8 == 0) ? (bx % 8) * (G / 8) + bx / 8 : bx;
    unsigned char* ws = args.ws;
    gu32* ctl = (gu32*)(ws + WS_CTL);
    for (int u = tid; u < 128; u += NWAVES * 64) ((LAS unsigned*)(L + MISC_OFF))[u] = 0u;
    __syncthreads();
    XcdBarrier bar = xcd_barrier_post((unsigned*)(ctl + CW_BAR), MISC + 8);
    const int lo = args.ph_lo, hi = args.ph_hi;
#define IN(k) (((MK_MASK >> (k)) & 1) && lo <= (k) && (k) < hi)
#define PHASE_IDS int tid_o = threadIdx.x; asm volatile("" : "+v"(tid_o)); const int tid = tid_o, lane = tid_o & 63; (void)tid; (void)lane;
#define INR(k) (lo <= (k) && (k) < hi)
#define SEAM(k) do { if (INR(k) && INR((k) + 1)) xcd_barrier(bar); } while (0)

    ss_t* ssb = (ss_t*)(ws + WS_SS);
    float* kmean = (float*)(ws + WS_KMEAN);
    float* biasd = (float*)(ws + WS_BIASD);
    float* cb1 = (float*)(ws + WS_CB1);
    bf16* HB = (bf16*)(ws + WS_HB); bf16* PP = (bf16*)(ws + WS_PP); bf16* OB = (bf16*)(ws + WS_O);
    bf16* QB = (bf16*)(ws + WS_Q); bf16* K0 = (bf16*)(ws + WS_K0); bf16* V0 = (bf16*)(ws + WS_V0); bf16* KV1 = (bf16*)(ws + WS_KV1);
    bf16* HID = (bf16*)(ws + WS_HID); bf16* PB0 = (bf16*)(ws + WS_PB0); bf16* PB1 = (bf16*)(ws + WS_PB1);
    bf16* KC = (bf16*)(ws + WS_KC); bf16* VC = (bf16*)(ws + WS_VC);
    float* GATES = (float*)(ws + WS_GATES);
    const int gw = vcu * NWAVES + wave, NGW = G * NWAVES;

    if (IN(0)) {
        PHASE_IDS
        LAS float* scr = (LAS float*)(L + wave * WAVE_LDS);
        const float* nmix = args.in[3]; const float* nffn = args.in[4]; const float* nple = args.in[5];
        constexpr int I_IN0 = 16 * (N_IN0 / 32), I_IN1 = 16 * (N_IN1P / 32), I_OUT = 16 * 32, I_GU = 16 * (N_GU / 32), I_D = (FF / 64) * 32, I_PG = 16 * 32, I_PP = 4 * 32, I_C1 = 32 * 4, I_C2 = 2 * 2;
        constexpr int NIT = I_IN0 + I_IN1 + 2 * I_OUT + 2 * I_GU + 2 * I_D + 2 * I_PG + 2 * I_PP + 2 * I_C1 + 2 * I_C2;
        for (int it = gw; it < NIT; it += NGW) {
            int r = it;
            if (r < I_IN0) { tr_matrix(r, args.in[11], nullptr, DM, N_IN0, N_IN0, 1, nmix, (bf16*)(ws + WS_WIN0), scr, lane); continue; } r -= I_IN0;
            if (r < I_IN1) { tr_matrix(r, args.in[17], nullptr, DM, N_IN1, N_IN1P, 1, nmix + DM, (bf16*)(ws + WS_WIN1), scr, lane); continue; } r -= I_IN1;
            if (r < I_OUT) { tr_matrix(r, args.in[12], nullptr, DM, DM, DM, 0, nullptr, (bf16*)(ws + WS_WOUT0), scr, lane); continue; } r -= I_OUT;
            if (r < I_OUT) { tr_matrix(r, args.in[18], nullptr, DM, DM, DM, 0, nullptr, (bf16*)(ws + WS_WOUT1), scr, lane); continue; } r -= I_OUT;
            if (r < I_GU) { tr_matrix(r, args.in[6], args.in[7], DM, FF, N_GU, 2, nffn, (bf16*)(ws + WS_WGU0), scr, lane); continue; } r -= I_GU;
            if (r < I_GU) { tr_matrix(r, args.in[6] + (size_t)DM * FF, args.in[7] + (size_t)DM * FF, DM, FF, N_GU, 2, nffn + DM, (bf16*)(ws + WS_WGU1), scr, lane); continue; } r -= I_GU;
            if (r < I_D) { tr_matrix(r, args.in[8], nullptr, FF, DM, DM, 0, nullptr, (bf16*)(ws + WS_WD0), scr, lane); continue; } r -= I_D;
            if (r < I_D) { tr_matrix(r, args.in[8] + (size_t)FF * DM, nullptr, FF, DM, DM, 0, nullptr, (bf16*)(ws + WS_WD1), scr, lane); continue; } r -= I_D;
            if (r < I_PG) { tr_matrix(r, args.in[10], nullptr, DM, DM, DM, 0, nple, (bf16*)(ws + WS_WPG0), scr, lane); continue; } r -= I_PG;
            if (r < I_PG) { tr_matrix(r, args.in[10] + (size_t)DM * DM, nullptr, DM, DM, DM, 0, nple + DM, (bf16*)(ws + WS_WPG1), scr, lane); continue; } r -= I_PG;
            if (r < I_PP) { tr_matrix(r, args.in[9], nullptr, PLE, DM, DM, 0, nullptr, (bf16*)(ws + WS_WPP0), scr, lane); continue; } r -= I_PP;
            if (r < I_PP) { tr_matrix(r, args.in[9] + (size_t)PLE * DM, nullptr, PLE, DM, DM, 0, nullptr, (bf16*)(ws + WS_WPP1), scr, lane); continue; } r -= I_PP;
            if (r < I_C1) { tr_matrix(r, args.in[24], nullptr, 2048, 128, 128, 0, nullptr, (bf16*)(ws + WS_CW1K), scr, lane); continue; } r -= I_C1;
            if (r < I_C1) { tr_matrix(r, args.in[29], nullptr, 2048, 128, 128, 0, nullptr, (bf16*)(ws + WS_CW1V), scr, lane); continue; } r -= I_C1;
            if (r < I_C2) { tr_matrix(r, args.in[26], nullptr, 128, 64, 64, 0, nullptr, (bf16*)(ws + WS_CW2K), scr, lane); continue; } r -= I_C2;
            tr_matrix(r, args.in[31], nullptr, 128, 64, 64, 0, nullptr, (bf16*)(ws + WS_CW2V), scr, lane);
        }
        const float* x = args.in[0];
        for (int m = gw; m < M; m += NGW) {
            const GAS f32x4* xr = (const GAS f32x4*)(x + (size_t)m * DM) + lane; f32x4 v[4]; float s = 0.f;
#pragma unroll
            for (int j = 0; j < 4; ++j) { v[j] = xr[64 * j]; s += (v[j].x * v[j].x + v[j].y * v[j].y) + (v[j].z * v[j].z + v[j].w * v[j].w); }
            s = wave_sum(s);
            GAS unsigned long long* o8 = (GAS unsigned long long*)(HB + (size_t)m * DM) + lane;
#pragma unroll
            for (int j = 0; j < 4; ++j) o8[64 * j] = (unsigned long long)pk2(v[j].x, v[j].y) | ((unsigned long long)pk2(v[j].z, v[j].w) << 32);
            if (lane == 0) ssb[m] = (ss_t)(s * SS_SCALE);
        }
        const float* p0 = args.in[1];
        for (int m = gw; m < M; m += NGW) { const f32x4 v = ((const GAS f32x4*)(p0 + (size_t)m * PLE))[lane];
            ((GAS unsigned long long*)(PB0 + (size_t)m * PLE))[lane] = (unsigned long long)pk2(v.x, v.y) | ((unsigned long long)pk2(v.z, v.w) << 32); }
        const float* relb = args.in[2];
        for (int i = bx * 512 + tid; i < NH * TABN; i += G * 512) { const int h = i / TABN, d = i % TABN; biasd[i] = relb[rel_bucket(d) * NH + h] * LOG2E; }
        for (int o = gw; o < 256; o += NGW) { const int kv = o >> 7, col = o & 127; const float* pos = args.in[kv ? 28 : 23]; const float* w1 = args.in[kv ? 29 : 24]; const float* b1 = args.in[kv ? 30 : 25];
            float s = 0.f; for (int k = lane; k < 2048; k += 64) s += pos[k] * w1[(size_t)k * 128 + col];
            s = wave_sum(s); if (lane == 0) cb1[o] = s + b1[col]; }
        if (bx == 0) { const int gi = tid >> 6; const int src_idx = gi < 4 ? 13 + gi : gi == 4 ? 19 : gi == 5 ? 21 : gi == 6 ? 22 : 20; ((float*)(ws + WS_GN))[tid] = args.in[src_idx][tid & 63]; }
        for (int i = bx * 512 + tid; i < 2 * 32 * 32; i += G * 512) { const int kv = i >> 10, bg = (i >> 5) & 31, w = i & 31; ((unsigned*)((kv ? VC : KC) + ((size_t)bg * 128 + 127) * HD))[w] = 0u; }
    }
    SEAM(0);
    using namespace pg8;
    if (IN(1)) { int kk = PLE; asm volatile("" : "+s"(kk)); Gemm g{PB0, (const bf16*)(ws + WS_WPP0), M, DM, kk}; StaticOrder S; S.init(M, DM, G, bx); EpiStoreBf16 E{PP, DM};
        gemm_phase<EpiStoreBf16, StaticOrder, true, true>(L, g, S, E); }
    SEAM(1);
    if (IN(2)) { Gemm g{HB, (const bf16*)(ws + WS_WIN0), M, N_IN0, DM}; StaticOrder S; S.init(M, N_IN0, G, bx);
        EpiInProj<0> E{ssb, QB, (const float*)(ws + WS_GN), kmean, nullptr};
        gemm_phase<EpiInProj<0>, StaticOrder, true, true>(L, g, S, E); }
    SEAM(2);
    if (IN(3)) {
        PHASE_IDS
        LAS float* tab = (LAS float*)(L + TAB_OFF); LAS float* km = (LAS float*)(L + KM_OFF);
        const int nwg8 = G;
        for (int v = vcu; v < 256; v += nwg8) {
            const int bh = v >> 2, b = bh >> 3, h = bh & 7, sub = v & 3;
            __syncthreads();
            for (int i = tid; i < TABN; i += 512) tab[i] = biasd[h * TABN + i];
            { const int i = tid; km[i] = kmean[(size_t)(b * 8 + h) * 512 + i] * (1.0f / 256.0f); }
            __syncthreads();
            moba_wave(L, wave, b, h, sub, QB, K0, V0, OB, tab, km);
            moba_wave(L, wave, b, h, 7 - sub, QB, K0, V0, OB, tab, km);
            __syncthreads();
            for (int i = tid; i < TABN; i += 512) tab[i] = biasd[(8 + h) * TABN + i];
            __syncthreads();
            dil_wave(L, wave, b, 8 + h, sub, wave, QB, K0, V0, OB, tab);
            dil_wave(L, wave, b, 8 + h, sub, 8 + wave, QB, K0, V0, OB, tab);
        }
    }
    SEAM(3);
#pragma unroll 1
    for (int layer = 0; layer < 2; ++layer) {
        const int pb = layer ? 12 : 4;
        const size_t wofs = layer ? (WS_WIN1 - WS_WIN0) : 0;
        (void)wofs;
        const bf16* Wout = (const bf16*)(ws + (layer ? WS_WOUT1 : WS_WOUT0)); const bf16* Wgu = (const bf16*)(ws + (layer ? WS_WGU1 : WS_WGU0));
        const bf16* Wd = (const bf16*)(ws + (layer ? WS_WD1 : WS_WD0)); const bf16* Wpg = (const bf16*)(ws + (layer ? WS_WPG1 : WS_WPG0));
        ss_t* ss_ffn = ssb + (size_t)(3 * layer + 1) * M; ss_t* ss_ple = ssb + (size_t)(3 * layer + 2) * M; ss_t* ss_next = layer ? nullptr : ssb + (size_t)3 * M;
        if (layer == 1) {
            if (IN(8)) { int kk = PLE; asm volatile("" : "+s"(kk)); Gemm g{PB1, (const bf16*)(ws + WS_WPP1), M, DM, kk}; StaticOrder S; S.init(M, DM, G, bx); EpiStoreBf16 E{PP, DM};
                gemm_phase<EpiStoreBf16, StaticOrder, true, true>(L, g, S, E); }
            SEAM(8);
            if (IN(9)) { Gemm g{HB, (const bf16*)(ws + WS_WIN1), M, N_IN1P, DM}; StaticOrder S; S.init(M, N_IN1P, G, bx);
                EpiInProj<1> E{ssb + (size_t)3 * M, QB, (const float*)(ws + WS_GN), nullptr, GATES};
                gemm_phase<EpiInProj<1>, StaticOrder, true, true>(L, g, S, E); }
            SEAM(9);
            if (IN(10)) {
                PHASE_IDS
                for (int task = vcu; task < 256; task += G) {
                    const int kv = task >> 7, bg = (task >> 2) & 31, rt = task & 3, i0 = 32 * rt;
                    const bf16* T = KV1 + (size_t)kv * ((size_t)BATCH * 4 * SEQ * HD) + (size_t)bg * SEQ * HD;
                    const bf16* W1 = (const bf16*)(ws + (kv ? WS_CW1V : WS_CW1K)); const bf16* W2 = (const bf16*)(ws + (kv ? WS_CW2V : WS_CW2K));
                    const int r32 = lane & 31, hi5 = lane >> 5, nb = wave & 3, kh = wave >> 2;
                    f32x16 acc;
#pragma unroll
                    for (int r = 0; r < 16; ++r) acc[r] = 0.f;
                    int arow = i0 + r32; arow = arow > 126 ? 126 : arow;
                    const bf16* ap = T + (size_t)arow * 16 * HD + 1024 * kh + 8 * hi5;
                    const bf16* bp = W1 + (size_t)(32 * nb + r32) * 2048 + 1024 * kh + 8 * hi5;
#pragma unroll 8
                    for (int s = 0; s < 64; ++s) { const bf16x8 a = *(const bf16x8*)(ap + 16 * s), bb = *(const bf16x8*)(bp + 16 * s);
                        acc = __builtin_amdgcn_mfma_f32_32x32x16_bf16(a, bb, acc, 0, 0, 0); }
                    __syncthreads();
                    LAS float* part = (LAS float*)L;
#pragma unroll
                    for (int r = 0; r < 16; ++r) part[(kh * 32 + crow(r, hi5)) * 129 + 32 * nb + r32] = acc[r];
                    __syncthreads();
                    LAS bf16* H1 = (LAS bf16*)(L + 40960);
                    for (int e = tid; e < 32 * 128; e += 512) { const int row = e >> 7, col = e & 127;
                        const float v = part[row * 129 + col] + part[(32 + row) * 129 + col] + cb1[kv * 128 + col];
                        const float u2 = 0.7978845608028654f * (v + 0.044715f * v * v * v);
                        const float th = 1.0f - 2.0f * fast_rcp(1.0f + fast_exp2(2.0f * u2 * LOG2E));
                        H1[row * 136 + col] = (bf16)f2bf(0.5f * v * (1.0f + th)); }
                    __syncthreads();
                    LAS float* OUT = (LAS float*)(L + 57344);
                    if (wave < 2) {
                        f32x16 a2;
#pragma unroll
                        for (int r = 0; r < 16; ++r) a2[r] = 0.f;
#pragma unroll
                        for (int s = 0; s < 8; ++s) { const bf16x8 a = *(LAS const bf16x8*)(H1 + r32 * 136 + 16 * s + 8 * hi5);
                            const bf16x8 bb = *(const bf16x8*)(W2 + (size_t)(32 * wave + r32) * 128 + 16 * s + 8 * hi5);
                            a2 = __builtin_amdgcn_mfma_f32_32x32x16_bf16(a, bb, a2, 0, 0, 0); }
                        const float* b2 = args.in[kv ? 32 : 27];
#pragma unroll
                        for (int r = 0; r < 16; ++r) OUT[crow(r, hi5) * 65 + 32 * wave + r32] = a2[r] + b2[32 * wave + r32];
                    }
                    __syncthreads();
                    if (tid < 256) { const int row = tid >> 3, c8 = (tid & 7) * 8; float v[8]; float sq = 0.f;
#pragma unroll
                        for (int i = 0; i < 8; ++i) { v[i] = OUT[row * 65 + c8 + i]; sq += v[i] * v[i]; }
                        sq += __shfl_xor(sq, 1); sq += __shfl_xor(sq, 2); sq += __shfl_xor(sq, 4);
                        if (kv == 0) { const float r2 = rsqrtf(sq * (1.0f / HD) + RMS_EPS); const float* kn = (const float*)(ws + WS_GN) + 7 * 64;
#pragma unroll
                            for (int i = 0; i < 8; ++i) v[i] = v[i] * r2 * kn[c8 + i]; }
                        if (i0 + row < 127) { u32x4 w; w.x = pk2(v[0], v[1]); w.y = pk2(v[2], v[3]); w.z = pk2(v[4], v[5]); w.w = pk2(v[6], v[7]);
                            *(u32x4*)((kv ? VC : KC) + ((size_t)bg * 128 + i0 + row) * HD + c8) = w; } }
                    __syncthreads();
                }
            }
            SEAM(10);
            if (IN(11)) {
                PHASE_IDS
                LAS float* tabs = (LAS float*)(L + TAB_OFF);
                for (int v = vcu; v < 256; v += G) {
                    const int bg = v >> 3, b = bg >> 2, g = bg & 3, sub = v & 7;
                    __syncthreads();
                    for (int i = tid; i < 4 * TABN; i += 512) tabs[i] = biasd[(4 * g) * TABN + i];
                    __syncthreads();
#pragma unroll 1
                    for (int k = 0; k < 4; ++k) { const int pr = 2 * sub + (k >> 1); const int chunk = (k & 1) ? 31 - pr : pr;
                        nsa_wave(wave, L, b, g, chunk, QB, KV1, KC, VC, GATES, OB, tabs); }
                }
            }
            SEAM(11);
        }
        if (IN(pb)) {
            if (layer == 0) {
                PHASE_IDS
                const float* p1 = args.in[1] + (size_t)M * PLE;
                for (int m = gw; m < M; m += NGW) { const f32x4 v = ((const GAS f32x4*)(p1 + (size_t)m * PLE))[lane];
                    ((GAS unsigned long long*)(PB1 + (size_t)m * PLE))[lane] = (unsigned long long)pk2(v.x, v.y) | ((unsigned long long)pk2(v.z, v.w) << 32); }
            }
            Gemm g{OB, Wout, M, DM, DM}; StaticOrder S; S.init(M, DM, G, bx);
            EpiResid<0> E{layer ? args.out : args.in[0], args.out, HB, ss_ffn, nullptr, nullptr};
            gemm_phase<EpiResid<0>, StaticOrder, true, true>(L, g, S, E); }
        SEAM(pb);
        if (IN(pb + 1)) { Gemm g{HB, Wgu, M, N_GU, DM}; StaticOrder S; S.init(M, N_GU, G, bx); EpiSwiglu E{HID, ss_ffn};
            gemm_phase<EpiSwiglu, StaticOrder, true, true>(L, g, S, E); }
        SEAM(pb + 1);
        if (IN(pb + 2)) { Gemm g{HID, Wd, M, DM, FF}; StaticOrder S; S.init(M, DM, G, bx);
            EpiResid<0> E{args.out, args.out, HB, ss_ple, nullptr, nullptr};
            gemm_phase<EpiResid<0>, StaticOrder, true, true>(L, g, S, E); }
        SEAM(pb + 2);
        if (IN(pb + 3)) { Gemm g{HB, Wpg, M, DM, DM}; StaticOrder S; S.init(M, DM, G, bx);
            EpiResid<1> E{args.out, args.out, HB, ss_next, ss_ple, PP};
            gemm_phase<EpiResid<1>, StaticOrder, true, true>(L, g, S, E); }
        if (layer == 0) SEAM(7);
    }
#if MK_DBG
    if (lo == 99) {
        const bf16* src = (const bf16*)(ws + (size_t)MK_DBG_OFF);
        for (size_t i = (size_t)bx * 512 + threadIdx.x; i < (size_t)M * DM; i += (size_t)G * 512) args.out[i] = i < (size_t)MK_DBG_CNT ? bf2f(src[i]) : 0.f;
    }
#endif
#undef IN
#undef SEAM
}

extern "C" void kernel_launch(void* const* d_in, const int* in_sizes, int n_in, void* d_out, int out_size, void* d_ws, size_t ws_size, hipStream_t stream) {
    static int grid = 0;
    if (grid == 0) {
        if (n_in != 33 || out_size != M * DM || ws_size < WS_END) { fprintf(stderr, "kernel_launch: unexpected problem (n_in %d out %d ws %zu)\n", n_in, out_size, ws_size); grid = -1; return; }
        int dev = 0, cus = 0, per_cu = 0;
        if (hipGetDevice(&dev) != hipSuccess || hipDeviceGetAttribute(&cus, hipDeviceAttributeMultiprocessorCount, dev) != hipSuccess) { grid = -1; return; }
        if (hipFuncSetAttribute((const void*)fwd_kernel, hipFuncAttributeMaxDynamicSharedMemorySize, LDS_BYTES) != hipSuccess) { fprintf(stderr, "kernel_launch: hipFuncSetAttribute failed\n"); grid = -1; return; }
        if (hipOccupancyMaxActiveBlocksPerMultiprocessor(&per_cu, (const void*)fwd_kernel, NWAVES * 64, LDS_BYTES) != hipSuccess || per_cu < 1) { fprintf(stderr, "kernel_launch: occupancy query says %d\n", per_cu); }
        (void)hipGetLastError();
        grid = cus < 256 ? cus : 256;
    }
    if (grid < 0) return;
    if (hipMemsetAsync((char*)d_ws + WS_CTL, 0, CTL_ZERO_BYTES, stream) != hipSuccess) return;
    Args a{};
    for (int i = 0; i < 33; ++i) a.in[i] = (const float*)d_in[i];
    a.out = (float*)d_out; a.ws = (unsigned char*)d_ws;
#if MK_SPLIT
    for (int ph = 0; ph < MK_PH_END; ++ph) { a.ph_lo = ph; a.ph_hi = ph + 1; hipLaunchKernelGGL(fwd_kernel, dim3(grid), dim3(NWAVES * 64), LDS_BYTES, stream, a); }
#if MK_DBG
    a.ph_lo = 99; a.ph_hi = 100; hipLaunchKernelGGL(fwd_kernel, dim3(grid), dim3(NWAVES * 64), LDS_BYTES, stream, a);
#endif
#else
    a.ph_lo = 0; a.ph_hi = MK_PH_END;
    hipLaunchKernelGGL(fwd_kernel, dim3(grid), dim3(NWAVES * 64), LDS_BYTES, stream, a);
#endif
}
```

```cpp
#include <hip/hip_runtime.h>
#include <cstdio>
#include <cstdint>

#ifndef MK_SPLIT
#define MK_SPLIT 0
#endif
#ifndef MK_DBG
#define MK_DBG 0
#define MK_DBG_OFF (0ull << 10)
#define MK_DBG_CNT (0)
#endif
#ifndef MK_MASK
#define MK_MASK 0xFFFF
#endif
#ifndef MK_PH_END
#define MK_PH_END 16
#endif

namespace pg8 {
#define PG8_LAS __attribute__((address_space(3)))
typedef unsigned short bf16_t;
typedef short bf16x8 __attribute__((ext_vector_type(8)));
typedef float f32x4 __attribute__((ext_vector_type(4)));
typedef unsigned u32x4 __attribute__((ext_vector_type(4)));
constexpr int BM = 256, BK = 64, HALF = 128, HTB = HALF * BK * 2  , STAGE_BYTES = 8 * HTB, NXCD = 8, WGM = 8;

__host__ __device__ __forceinline__ int lds_byte(int r, int c) { const int st = (r >> 4) * 2 + (c >> 5), rr = r & 15, cc = c & 31, ob = rr * 64 + cc * 2; return st * 1024 + (ob ^ (((ob >> 9) & 1) << 5)); }
__host__ __device__ __forceinline__ void stage_rc(int b, int& R, int& C) { const int st = b / 1024, sb = b % 1024, swz = sb ^ (((sb >> 9) & 1) << 5); R = (st >> 1) * 16 + swz / 64; C = (st & 1) * 32 + (swz % 64) / 2; }
__host__ __device__ __forceinline__ int perm32(int rho) { const int n = rho >> 4, i = rho & 15; return 8 * (i >> 2) + 4 * n + (i & 3); }

struct Unit { int pm, pn; };
struct Gemm { const bf16_t* A; const bf16_t* Bt; int M, N, K; };

struct StaticOrder {
    int nM, nN, nwg, G, c;
    __host__ __device__ void init(int M, int N, int G_, int c_) { nM = M / BM; nN = N / BM; nwg = nM * nN; G = G_; c = c_; }
    __host__ __device__ bool next(int i, Unit& u) const {
        const long L = (long)i * G + c; if (L >= nwg) return false;
        int wgid = (int)L; { const int q = nwg / NXCD, r = nwg % NXCD, xcd = wgid % NXCD, off = wgid / NXCD; wgid = (xcd < r ? xcd * (q + 1) : r * (q + 1) + (xcd - r) * q) + off; }
        const int nig = WGM * nN, gid = wgid / nig, fm = gid * WGM, gsz = (nM - fm) < WGM ? (nM - fm) : WGM;
        u.pm = fm + ((wgid % nig) % gsz); u.pn = (wgid % nig) / gsz; return true;
    }
    __device__ __forceinline__ void a_ready(const Unit&) const {}
    __device__ __forceinline__ void done(const Unit&) const {}
};

__device__ __forceinline__ unsigned cvt_pk_bf16(float lo, float hi) { unsigned r; asm volatile("v_cvt_pk_bf16_f32 %0, %1, %2" : "=v"(r) : "v"(lo), "v"(hi)); return r; }
template <class Epi, class Sched, bool ALIGN_EPI = false, bool SP2 = false>
__device__ __forceinline__ void gemm_phase(PG8_LAS unsigned char* lds, const Gemm g, const Sched& S, const Epi& E) {
    int tid_ = threadIdx.x; asm volatile("" : "+v"(tid_));
    const int tid = tid_, wid = __builtin_amdgcn_readfirstlane(tid >> 6), lane = tid & 63, wr = wid >> 2, wc = wid & 3, fr = lane & 15, fq = lane >> 4;
    const int K = g.K, nt = K / BK;
    unsigned voffA[2], voffB[2];
#pragma unroll
    for (int i = 0; i < 2; ++i) { int R, C; stage_rc(tid * 16 + i * 8192, R, C); const int Rb = Epi::PERM ? ((R & ~31) + perm32(R & 31)) : R;
        voffA[i] = (unsigned)(R * K + C) * 2u; voffB[i] = (unsigned)(Rb * K + C) * 2u; }
    const size_t kstep = (size_t)(BK * 2);
    const size_t hstep = (size_t)HALF * K * 2;
    const size_t tstep = 2 * hstep;
    const unsigned ldsw = (unsigned)wid * 1024u;
    const int aoff = lds_byte(wr * 64 + fr, fq * 8), boff = lds_byte(wc * 32 + fr, fq * 8);
#define PG8_SA(b, h) (((b) * 2 + (h)) * HTB)
#define PG8_SB(b, h) ((4 + (b) * 2 + (h)) * HTB)
#define PG8_STAGE(bufoff, gbase, voff) do { _Pragma("unroll") for (int _i = 0; _i < 2; ++_i) \
        __builtin_amdgcn_global_load_lds((const unsigned*)((const char*)(gbase) + (voff)[_i]), (PG8_LAS unsigned*)(lds + (bufoff) + ldsw + _i * 8192), 16, 0, 0); } while (0)
#define PG8_LDA(dst, b, h) do { _Pragma("unroll") for (int m = 0; m < 4; ++m) _Pragma("unroll") for (int k = 0; k < 2; ++k) dst[m][k] = *(const PG8_LAS bf16x8*)(lds + PG8_SA(b, h) + aoff + m * 2048 + k * 1024); } while (0)
#define PG8_LDB(dst, b, h) do { _Pragma("unroll") for (int n = 0; n < 2; ++n) _Pragma("unroll") for (int k = 0; k < 2; ++k) dst[n][k] = *(const PG8_LAS bf16x8*)(lds + PG8_SB(b, h) + boff + n * 2048 + k * 1024); } while (0)
#define PG8_MMA(ai, bj, At, Bt) do { __builtin_amdgcn_s_setprio(1); _Pragma("unroll") for (int m = 0; m < 4; ++m) _Pragma("unroll") for (int n = 0; n < 2; ++n) _Pragma("unroll") for (int k = 0; k < 2; ++k) \
        acc[ai][bj][m][n] = __builtin_amdgcn_mfma_f32_16x16x32_bf16(Bt[n][k], At[m][k], acc[ai][bj][m][n], 0, 0, 0); __builtin_amdgcn_s_setprio(0); } while (0)
#define PG8_WAIT_V(n) asm volatile("s_waitcnt vmcnt(" #n ")" ::: "memory")
#define PG8_WAIT_L(n) asm volatile("s_waitcnt lgkmcnt(" #n ")" ::: "memory")
#define PG8_BAR __builtin_amdgcn_s_barrier()
#define PG8_SCHED __builtin_amdgcn_sched_barrier(0)
    Unit cur, nxt; int ui = 0;
    if (!S.next(0, cur)) return;
    f32x4 acc[2][2][4][2];
#pragma unroll
    for (int a = 0; a < 2; ++a)
#pragma unroll
        for (int b = 0; b < 2; ++b)
#pragma unroll
            for (int m = 0; m < 4; ++m)
#pragma unroll
                for (int n = 0; n < 2; ++n) acc[a][b][m][n] = (f32x4){0.f, 0.f, 0.f, 0.f};
    bf16x8 At[4][2], B0[2][2], B1[2][2];
    const char* cA = (const char*)g.A + (size_t)cur.pm * tstep; const char* cB = (const char*)g.Bt + (size_t)cur.pn * tstep;
    S.a_ready(cur);
    if constexpr (SP2) {
        PG8_STAGE(PG8_SB(0, 0), cB, voffB); PG8_STAGE(PG8_SB(0, 1), cB + hstep, voffB); PG8_STAGE(PG8_SA(0, 0), cA, voffA); PG8_STAGE(PG8_SA(0, 1), cA + hstep, voffA);
        if (wr == 1) PG8_BAR;
        PG8_WAIT_V(2); PG8_BAR;
        PG8_STAGE(PG8_SB(1, 0), cB + kstep, voffB); PG8_STAGE(PG8_SA(1, 0), cA + kstep, voffA); PG8_STAGE(PG8_SB(1, 1), cB + hstep + kstep, voffB);
        PG8_WAIT_V(6); PG8_BAR;
    } else {
        PG8_STAGE(PG8_SB(0, 0), cB, voffB); PG8_STAGE(PG8_SA(0, 0), cA, voffA); PG8_STAGE(PG8_SB(0, 1), cB + hstep, voffB); PG8_STAGE(PG8_SA(0, 1), cA + hstep, voffA);
        if (wr == 1) PG8_BAR;
        PG8_WAIT_V(4); PG8_BAR;
        PG8_STAGE(PG8_SB(1, 0), cB + kstep, voffB); PG8_STAGE(PG8_SA(1, 0), cA + kstep, voffA); PG8_STAGE(PG8_SB(1, 1), cB + hstep + kstep, voffB);
        PG8_WAIT_V(6); PG8_BAR;
    }
    for (;;) {
        const bool has_next = S.next(ui + 1, nxt);
        const char* nA = has_next ? (const char*)g.A + (size_t)nxt.pm * tstep : cA; const char* nB = has_next ? (const char*)g.Bt + (size_t)nxt.pn * tstep : cB;
        for (int t = 0; t < nt; t += 2) {
            const bool last = (t == nt - 2);
            const char* a1 = cA + (size_t)(t + 1) * kstep;
            const char* a2 = last ? nA : cA + (size_t)(t + 2) * kstep; const char* b2 = last ? nB : cB + (size_t)(t + 2) * kstep;
            const char* a3 = a2 + kstep; const char* b3 = b2 + kstep;
            if (last && has_next) S.a_ready(nxt);
            if constexpr (SP2) {
            PG8_LDB(B0, 0, 0); PG8_LDB(B1, 0, 1); PG8_SCHED; PG8_LDA(At, 0, 0); PG8_STAGE(PG8_SA(1, 1), a1 + hstep, voffA);
            PG8_WAIT_V(8); PG8_WAIT_L(0); PG8_BAR; PG8_MMA(0, 0, At, B0); PG8_MMA(0, 1, At, B1); PG8_BAR; PG8_SCHED;
            PG8_LDA(At, 0, 1); PG8_STAGE(PG8_SB(0, 0), b2, voffB); PG8_STAGE(PG8_SB(0, 1), b2 + hstep, voffB); PG8_STAGE(PG8_SA(0, 0), a2, voffA);
            PG8_WAIT_V(8); PG8_WAIT_L(0); PG8_BAR; PG8_MMA(1, 0, At, B0); PG8_MMA(1, 1, At, B1); PG8_BAR; PG8_SCHED;
            PG8_LDB(B0, 1, 0); PG8_LDB(B1, 1, 1); PG8_SCHED; PG8_LDA(At, 1, 0); PG8_STAGE(PG8_SA(0, 1), a2 + hstep, voffA);
            PG8_WAIT_V(8); PG8_WAIT_L(0); PG8_BAR; PG8_MMA(0, 0, At, B0); PG8_MMA(0, 1, At, B1); PG8_BAR; PG8_SCHED;
            PG8_LDA(At, 1, 1); PG8_STAGE(PG8_SB(1, 0), b3, voffB); PG8_STAGE(PG8_SB(1, 1), b3 + hstep, voffB); PG8_STAGE(PG8_SA(1, 0), a3, voffA);
            PG8_WAIT_V(8); PG8_WAIT_L(0); PG8_BAR; PG8_MMA(1, 0, At, B0); PG8_MMA(1, 1, At, B1); PG8_BAR; PG8_SCHED;
            } else {
            PG8_LDB(B0, 0, 0); PG8_SCHED; PG8_LDA(At, 0, 0); PG8_STAGE(PG8_SA(1, 1), a1 + hstep, voffA);
            PG8_WAIT_L(8); PG8_BAR; PG8_WAIT_L(0); PG8_MMA(0, 0, At, B0); PG8_BAR; PG8_SCHED;
            PG8_LDB(B1, 0, 1); PG8_STAGE(PG8_SB(0, 0), b2, voffB);
            PG8_BAR; PG8_WAIT_L(0); PG8_MMA(0, 1, At, B1); PG8_BAR;
            PG8_LDA(At, 0, 1); PG8_STAGE(PG8_SA(0, 0), a2, voffA);
            PG8_BAR; PG8_WAIT_L(0); PG8_MMA(1, 0, At, B0); PG8_BAR; PG8_SCHED;
            PG8_STAGE(PG8_SB(0, 1), b2 + hstep, voffB);
            PG8_WAIT_V(6); PG8_BAR; PG8_MMA(1, 1, At, B1); PG8_BAR;
            PG8_LDB(B0, 1, 0); PG8_SCHED; PG8_LDA(At, 1, 0); PG8_STAGE(PG8_SA(0, 1), a2 + hstep, voffA);
            PG8_WAIT_L(8); PG8_BAR; PG8_WAIT_L(0); PG8_MMA(0, 0, At, B0); PG8_BAR; PG8_SCHED;
            PG8_LDB(B1, 1, 1); PG8_STAGE(PG8_SB(1, 0), b3, voffB);
            PG8_BAR; PG8_WAIT_L(0); PG8_MMA(0, 1, At, B1); PG8_BAR;
            PG8_LDA(At, 1, 1); PG8_STAGE(PG8_SA(1, 0), a3, voffA);
            PG8_BAR; PG8_WAIT_L(0); PG8_MMA(1, 0, At, B0); PG8_BAR; PG8_SCHED;
            PG8_STAGE(PG8_SB(1, 1), b3 + hstep, voffB);
            PG8_WAIT_V(6); PG8_BAR; PG8_MMA(1, 1, At, B1); PG8_BAR;
            }
        }
        if constexpr (ALIGN_EPI) { if (wr == 0) PG8_BAR; }
        if constexpr (!Epi::AFTER_DRAIN) { E(acc, cur, wr, wc, fr, fq); S.done(cur); }
        if (!has_next) break;
#pragma unroll
        for (int a = 0; a < 2; ++a)
#pragma unroll
            for (int b = 0; b < 2; ++b)
#pragma unroll
                for (int m = 0; m < 4; ++m)
#pragma unroll
                    for (int n = 0; n < 2; ++n) acc[a][b][m][n] = (f32x4){0.f, 0.f, 0.f, 0.f};
        cur = nxt; cA = nA; cB = nB; ++ui;
        if constexpr (ALIGN_EPI) { if (wr == 1) PG8_BAR; }
    }
    PG8_WAIT_V(0);
    if constexpr (!ALIGN_EPI) { if (wr == 0) PG8_BAR; }
    PG8_BAR;
    if constexpr (Epi::AFTER_DRAIN) { E.fused(acc, cur, wr, wc, fr, fq, lds, wid, lane); S.done(cur); }
#undef PG8_SA
#undef PG8_SB
#undef PG8_STAGE
#undef PG8_LDA
#undef PG8_LDB
#undef PG8_MMA
#undef PG8_WAIT_V
#undef PG8_WAIT_L
#undef PG8_BAR
#undef PG8_SCHED
}
}

constexpr int BATCH = 8, SEQ = 2048, DM = 1024, M = BATCH * SEQ, FF = 2816, PLE = 256;
constexpr int NH = 16, HD = 64;
constexpr int N_IN0 = 3072, N_IN1 = 2608, N_IN1P = 2816, N_GU = 2 * FF;
constexpr float RMS_EPS = 1e-6f;
constexpr float LOG2E = 1.4426950408889634f;
constexpr float C2 = 0.125f * LOG2E;
constexpr int TABN = 1536;

constexpr size_t MiB = 1u << 20, KiB = 1u << 10;
constexpr size_t WS_CTL = 0, CTL_ZERO_BYTES = 2 * MiB;
constexpr size_t WS_SS = 256 * KiB;
constexpr size_t WS_KMEAN = 1280 * KiB;
constexpr size_t WS_W = 2 * MiB;
constexpr size_t WS_WIN0 = WS_W, WS_WOUT0 = WS_WIN0 + 6 * MiB, WS_WGU0 = WS_WOUT0 + 2 * MiB, WS_WD0 = WS_WGU0 + 11 * MiB,
                 WS_WPG0 = WS_WD0 + 5632 * KiB, WS_WPP0 = WS_WPG0 + 2 * MiB,
                 WS_WIN1 = WS_WPP0 + 512 * KiB, WS_WOUT1 = WS_WIN1 + 5632 * KiB, WS_WGU1 = WS_WOUT1 + 2 * MiB, WS_WD1 = WS_WGU1 + 11 * MiB,
                 WS_WPG1 = WS_WD1 + 5632 * KiB, WS_WPP1 = WS_WPG1 + 2 * MiB,
                 WS_CW1K = WS_WPP1 + 512 * KiB, WS_CW1V = WS_CW1K + 512 * KiB, WS_CW2K = WS_CW1V + 512 * KiB, WS_CW2V = WS_CW2K + 16 * KiB,
                 WS_WEND = WS_CW2V + 16 * KiB;
static_assert(WS_WEND <= 58 * MiB, "weights");
constexpr size_t WS_MISC = 58 * MiB;
constexpr size_t WS_BIASD = WS_MISC;
constexpr size_t WS_CB1 = WS_MISC + 128 * KiB;
constexpr size_t WS_GN = WS_MISC + 192 * KiB;
constexpr size_t WS_KC = WS_MISC + 256 * KiB, WS_VC = WS_KC + 512 * KiB;
constexpr size_t WS_HB = 60 * MiB;
constexpr size_t WS_PP = 92 * MiB;
constexpr size_t WS_O = 124 * MiB;
constexpr size_t WS_QKV = 156 * MiB;
constexpr size_t WS_Q = WS_QKV, WS_K0 = WS_QKV + 32 * MiB, WS_V0 = WS_QKV + 64 * MiB;
constexpr size_t WS_KV1 = WS_QKV + 32 * MiB;
constexpr size_t WS_HID = WS_QKV;
constexpr size_t WS_PB1 = WS_QKV + 88 * MiB;
constexpr size_t WS_PB0 = WS_O;
constexpr size_t WS_GATES = 252 * MiB;
constexpr size_t WS_END = 256 * MiB;
static_assert(WS_QKV + 96 * MiB <= WS_GATES && WS_GATES + 3 * MiB <= WS_END, "ws map");

constexpr int CW_BAR = 4096;

constexpr int WAVE_LDS = 16512;
constexpr int KCH = 1040;
constexpr int TAB_OFF = 8 * WAVE_LDS;
constexpr int KM_OFF = TAB_OFF + 4 * TABN * 4;
constexpr int MISC_OFF = KM_OFF + 2048;
constexpr int LDS_BYTES = MISC_OFF + 512;
static_assert(LDS_BYTES <= 163840 && TAB_OFF >= 131072, "LDS map");

#define GAS __attribute__((address_space(1)))
#define LAS __attribute__((address_space(3)))
typedef unsigned short bf16;
typedef float f32x4 __attribute__((ext_vector_type(4)));
typedef float f32x16 __attribute__((ext_vector_type(16)));
typedef short bf16x8 __attribute__((ext_vector_type(8)));
typedef unsigned u32x4 __attribute__((ext_vector_type(4)));
typedef unsigned u32x2 __attribute__((ext_vector_type(2)));
typedef GAS unsigned gu32;

__device__ __forceinline__ unsigned f2bf(float f) { unsigned u = __builtin_bit_cast(unsigned, f); return (u + 0x7fffu + ((u >> 16) & 1u)) >> 16; }
__device__ __forceinline__ unsigned pk2(float lo, float hi) { return f2bf(lo) | (f2bf(hi) << 16); }
__device__ __forceinline__ float bf2f(unsigned short h) { return __builtin_bit_cast(float, (unsigned)h << 16); }
typedef float f32x2_t __attribute__((ext_vector_type(2))); typedef __bf16 bf16x2_t __attribute__((ext_vector_type(2)));
__device__ __forceinline__ unsigned cvtpk(float lo, float hi) { f32x2_t v = {lo, hi}; bf16x2_t b = __builtin_convertvector(v, bf16x2_t); return __builtin_bit_cast(unsigned, b); }
__device__ __forceinline__ float fast_exp2(float x) { return __builtin_amdgcn_exp2f(x); }
__device__ __forceinline__ float fast_rcp(float x) { return __builtin_amdgcn_rcpf(x); }
__device__ __forceinline__ float sigmoidf_(float x) { return fast_rcp(1.0f + fast_exp2(-x * LOG2E)); }

using pg8::Unit;
typedef float accf4 __attribute__((ext_vector_type(4)));
#define EPI_ARGS const accf4 (&acc)[2][2][4][2], const Unit& u, int wr, int wc, int fr_in, int fq_in
#define EPI_OPAQUE int fr = fr_in, fq = fq_in; asm volatile("" : "+v"(fr), "+v"(fq));
typedef unsigned long long ss_t;
constexpr float SS_SCALE = 16777216.0f;
__device__ __forceinline__ float rstd_row(const ss_t* ss, int row) { return rsqrtf((float)ss[row] * (1.0f / (SS_SCALE * DM)) + RMS_EPS); }

struct EpiStoreBf16 {
    static constexpr bool PERM = true, AFTER_DRAIN = false;
    bf16* O; int ldc;
    __device__ __forceinline__ void operator()(EPI_ARGS) const {
        EPI_OPAQUE
        const int row0 = u.pm * 256 + wr * 64 + fr, col0 = u.pn * 256 + wc * 32 + 8 * fq;
#pragma unroll
        for (int ai = 0; ai < 2; ++ai)
#pragma unroll
            for (int m = 0; m < 4; ++m) { bf16* rowp = O + (size_t)(row0 + ai * 128 + m * 16) * ldc + col0;
#pragma unroll
                for (int bj = 0; bj < 2; ++bj) { const accf4 v0 = acc[ai][bj][m][0], v1 = acc[ai][bj][m][1];
                    u32x4 w; w.x = cvtpk(v0[0], v0[1]); w.y = cvtpk(v0[2], v0[3]); w.z = cvtpk(v1[0], v1[1]); w.w = cvtpk(v1[2], v1[3]);
                    *(u32x4*)(rowp + bj * 128) = w; } }
    }
};

template <int MODE> struct EpiResid {
    static constexpr bool PERM = true, AFTER_DRAIN = false;
    const float* base; float* out; bf16* hb; ss_t* ss_out; const ss_t* ss_in; const bf16* pp;
    __device__ __forceinline__ void operator()(EPI_ARGS) const {
        EPI_OPAQUE
        const int row0 = u.pm * 256 + wr * 64 + fr, col0 = u.pn * 256 + wc * 32 + 8 * fq;
#pragma unroll
        for (int ai = 0; ai < 2; ++ai)
#pragma unroll
            for (int m = 0; m < 4; ++m) {
                const int row = row0 + ai * 128 + m * 16; const size_t off = (size_t)row * DM + col0;
                float rs = 1.f; if (MODE == 1) rs = rstd_row(ss_in, row);
                float sq = 0.f;
#pragma unroll
                for (int bj = 0; bj < 2; ++bj) {
                    accf4 v0 = acc[ai][bj][m][0], v1 = acc[ai][bj][m][1];
                    const f32x4 b0 = *(const f32x4*)(base + off + bj * 128), b1 = *(const f32x4*)(base + off + bj * 128 + 4);
                    if (MODE == 1) {
                        const u32x4 pw = *(const u32x4*)(pp + off + bj * 128);
                        const float p[8] = {__builtin_bit_cast(float, pw.x << 16), __builtin_bit_cast(float, pw.x & 0xffff0000u), __builtin_bit_cast(float, pw.y << 16), __builtin_bit_cast(float, pw.y & 0xffff0000u),
                                            __builtin_bit_cast(float, pw.z << 16), __builtin_bit_cast(float, pw.z & 0xffff0000u), __builtin_bit_cast(float, pw.w << 16), __builtin_bit_cast(float, pw.w & 0xffff0000u)};
#pragma unroll
                        for (int i = 0; i < 4; ++i) { v0[i] = sigmoidf_(v0[i] * rs) * p[i]; v1[i] = sigmoidf_(v1[i] * rs) * p[4 + i]; }
                    }
                    const f32x4 h0 = b0 + v0, h1 = b1 + v1;
                    *(f32x4*)(out + off + bj * 128) = h0; *(f32x4*)(out + off + bj * 128 + 4) = h1;
                    u32x4 w; w.x = cvtpk(h0[0], h0[1]); w.y = cvtpk(h0[2], h0[3]); w.z = cvtpk(h1[0], h1[1]); w.w = cvtpk(h1[2], h1[3]);
                    *(u32x4*)(hb + off + bj * 128) = w;
                    sq += (h0[0] * h0[0] + h0[1] * h0[1]) + (h0[2] * h0[2] + h0[3] * h0[3]) + (h1[0] * h1[0] + h1[1] * h1[1]) + (h1[2] * h1[2] + h1[3] * h1[3]);
                }
                sq += __shfl_xor(sq, 16); sq += __shfl_xor(sq, 32);
                if (ss_out && fq == 0) atomicAdd(ss_out + row, (ss_t)(sq * SS_SCALE));
            }
    }
};

struct EpiSwiglu {
    static constexpr bool PERM = true, AFTER_DRAIN = false;
    bf16* hid; const ss_t* ss_in;
    __device__ __forceinline__ void operator()(EPI_ARGS) const {
        EPI_OPAQUE
        const int row0 = u.pm * 256 + wr * 64 + fr, col0 = u.pn * 128 + wc * 32 + 8 * fq;
#pragma unroll
        for (int ai = 0; ai < 2; ++ai)
#pragma unroll
            for (int m = 0; m < 4; ++m) {
                const int row = row0 + ai * 128 + m * 16; const float rs = rstd_row(ss_in, row);
                float r[8];
#pragma unroll
                for (int n = 0; n < 2; ++n)
#pragma unroll
                    for (int i = 0; i < 4; ++i) { const float g = acc[ai][0][m][n][i] * rs, uu = acc[ai][1][m][n][i] * rs; r[4 * n + i] = g * sigmoidf_(g) * uu; }
                u32x4 w; w.x = cvtpk(r[0], r[1]); w.y = cvtpk(r[2], r[3]); w.z = cvtpk(r[4], r[5]); w.w = cvtpk(r[6], r[7]);
                *(u32x4*)(hid + (size_t)row * FF + col0) = w;
            }
    }
};

template <int LAYER> struct EpiInProj {
    static constexpr bool PERM = true, AFTER_DRAIN = false;
    const ss_t* ss_in; bf16* Q;
    const float* gains;
    float* kmean; float* gates;
    __device__ __forceinline__ void operator()(EPI_ARGS) const {
        EPI_OPAQUE
        const int pn = u.pn;
        const float* gain = gains; bool has_gain = false; bf16* dst = Q; int head, nheads; bool do_km = false;
        if (LAYER == 0) {
            const int t6 = pn >> 1, type = t6 % 3, grp = t6 / 3;
            head = grp * 8 + (pn & 1) * 4 + wc; nheads = 16;
            dst = Q + (size_t)type * ((size_t)M * DM);
            has_gain = type < 2; gain = gains + 64 * (grp * 2 + (type & 1)); do_km = (type == 1 && grp == 0);
        } else {
            if (pn < 4) { head = pn * 4 + wc; nheads = 16; has_gain = true; gain = gains + 64 * 4; }
            else { head = wc; nheads = 4; dst = Q + (size_t)M * DM + (size_t)(pn - 4) * ((size_t)BATCH * 4 * SEQ * HD); has_gain = (pn == 6) || (pn == 8); gain = gains + 64 * (pn == 6 ? 5 : 6); }
        }
        const int row0 = u.pm * 256 + wr * 64 + fr;
        if (LAYER == 1 && pn == 10) {
            if (wc == 0) {
#pragma unroll
                for (int ai = 0; ai < 2; ++ai)
#pragma unroll
                    for (int m = 0; m < 4; ++m) { const int row = row0 + ai * 128 + m * 16; const float rs = rstd_row(ss_in, row);
#pragma unroll
                        for (int bj = 0; bj < 2; ++bj) { const int j0 = 32 * bj + 8 * fq;
                            if (j0 < 48) { const accf4 v0 = acc[ai][bj][m][0], v1 = acc[ai][bj][m][1];
                                f32x4 g0, g1;
#pragma unroll
                                for (int i = 0; i < 4; ++i) { g0[i] = sigmoidf_(v0[i] * rs); g1[i] = sigmoidf_(v1[i] * rs); }
                                *(f32x4*)(gates + (size_t)row * 48 + j0) = g0; *(f32x4*)(gates + (size_t)row * 48 + j0 + 4) = g1; } } }
            }
            return;
        }
        float ksum[2][2][4];
#pragma unroll
        for (int bj = 0; bj < 2; ++bj)
#pragma unroll
            for (int n = 0; n < 2; ++n)
#pragma unroll
                for (int i = 0; i < 4; ++i) ksum[bj][n][i] = 0.f;
#pragma unroll
        for (int ai = 0; ai < 2; ++ai)
#pragma unroll
            for (int m = 0; m < 4; ++m) {
                const int row = row0 + ai * 128 + m * 16, b = row >> 11, s = row & (SEQ - 1); const float rs = rstd_row(ss_in, row);
                float v[2][2][4]; float sq = 0.f;
#pragma unroll
                for (int bj = 0; bj < 2; ++bj)
#pragma unroll
                    for (int n = 0; n < 2; ++n)
#pragma unroll
                        for (int i = 0; i < 4; ++i) { v[bj][n][i] = acc[ai][bj][m][n][i] * rs; sq += v[bj][n][i] * v[bj][n][i]; }
                if (has_gain) {
                    sq += __shfl_xor(sq, 16); sq += __shfl_xor(sq, 32);
                    const float r2 = rsqrtf(sq * (1.0f / HD) + RMS_EPS);
#pragma unroll
                    for (int bj = 0; bj < 2; ++bj)
#pragma unroll
                        for (int n = 0; n < 2; ++n) { const f32x4 gq = *(const f32x4*)(gain + 32 * bj + 8 * fq + 4 * n);
#pragma unroll
                            for (int i = 0; i < 4; ++i) v[bj][n][i] = v[bj][n][i] * r2 * gq[i]; }
                }
                if (LAYER == 0 && do_km) {
#pragma unroll
                    for (int bj = 0; bj < 2; ++bj)
#pragma unroll
                        for (int n = 0; n < 2; ++n)
#pragma unroll
                            for (int i = 0; i < 4; ++i) ksum[bj][n][i] += v[bj][n][i];
                }
                bf16* rowp = dst + ((size_t)(b * nheads + head) * SEQ + s) * HD + 8 * fq;
#pragma unroll
                for (int bj = 0; bj < 2; ++bj) { u32x4 w; w.x = cvtpk(v[bj][0][0], v[bj][0][1]); w.y = cvtpk(v[bj][0][2], v[bj][0][3]); w.z = cvtpk(v[bj][1][0], v[bj][1][1]); w.w = cvtpk(v[bj][1][2], v[bj][1][3]);
                    *(u32x4*)(rowp + 32 * bj) = w; }
                asm volatile("" ::: "memory");
            }
        if (LAYER == 0 && do_km) {
            const int b = u.pm >> 3, blk = u.pm & 7;
            float* kp = kmean + ((size_t)((b * 8 + head) * 8 + blk)) * HD + 8 * fq;
#pragma unroll
            for (int bj = 0; bj < 2; ++bj)
#pragma unroll
                for (int n = 0; n < 2; ++n)
#pragma unroll
                    for (int i = 0; i < 4; ++i) { float s = ksum[bj][n][i];
                        s += __shfl_xor(s, 1); s += __shfl_xor(s, 2); s += __shfl_xor(s, 4); s += __shfl_xor(s, 8);
                        if (fr == 0) atomicAdd(kp + 32 * bj + 4 * n + i, s); }
        }
    }
};
#define XB_TMO      128
#define XB_XCNT(j)  (256  + 64 * (j))
#define XB_XSUB(j)  (1280 + 64 * (j))
#define XB_XGEN(j)  (2304 + 64 * (j))
#define XB_TOP      3328
#define XB_TOPGEN   3392
#define XCD_BAR_WORDS 3456
#define XB_SPIN_CAP (1u << 18)

__device__ __forceinline__ unsigned xb_ld(unsigned* p)              { return __hip_atomic_load(p, __ATOMIC_RELAXED, __HIP_MEMORY_SCOPE_AGENT); }
__device__ __forceinline__ unsigned xb_add(unsigned* p, unsigned v) { return __hip_atomic_fetch_add(p, v, __ATOMIC_RELAXED, __HIP_MEMORY_SCOPE_AGENT); }
__device__ __forceinline__ unsigned xb_xcc_id() { return (unsigned)__builtin_amdgcn_s_getreg((3 << 11) | 20) & 0xFu; }
#define XB_SPIN(cond, bar) do { unsigned _sp = 0; while (cond) { __builtin_amdgcn_s_sleep(1); \
    if ((++_sp & 255u) == 0u) { if (xb_ld(&(bar)[XB_TMO])) break; if (_sp > XB_SPIN_CAP) { atomicAdd(&(bar)[XB_TMO], 1u); break; } } } } while (0)

struct XcdBarrier {
    unsigned* bar; unsigned x;
    volatile LAS unsigned* st;
};

__device__ __forceinline__ XcdBarrier xcd_barrier_post(unsigned* bar, volatile LAS unsigned* st) {
    XcdBarrier b; b.bar = bar; b.x = xb_xcc_id(); b.st = st;
    if (threadIdx.x == 0) (void)xb_add(&bar[XB_XCNT(b.x)], 1u);
    return b;
}
__device__ __forceinline__ void xcd_barrier_complete(unsigned* bar, unsigned x, unsigned& nloc, unsigned& nx) {
    const unsigned G = gridDim.x * gridDim.y * gridDim.z;
    unsigned sum, cnt, mine, sp = 0u;
    for (;;) {
        sum = 0u; cnt = 0u; mine = 0u;
#pragma unroll
        for (unsigned j = 0; j < 16; ++j) { const unsigned c = xb_ld(&bar[XB_XCNT(j)]); sum += c; cnt += (c > 0u) ? 1u : 0u; mine = (j == x) ? c : mine; }
        if (sum == G) break;
        __builtin_amdgcn_s_sleep(1);
        if ((++sp & 255u) == 0u) { if (xb_ld(&bar[XB_TMO])) break; if (sp > XB_SPIN_CAP) { atomicAdd(&bar[XB_TMO], 1u); break; } }
    }
    nloc = mine > 0u ? mine : 1u; nx = cnt > 0u ? cnt : 1u;
}

__device__ __forceinline__ void xcd_barrier(const XcdBarrier& b) {
    asm volatile("s_waitcnt vmcnt(0)" ::: "memory");
    __syncthreads();
    if (threadIdx.x == 0) {
        unsigned* bar = b.bar;
        __builtin_amdgcn_s_waitcnt(0);
        unsigned nloc = b.st[0], nx = b.st[1];
        if (nloc == 0u) { xcd_barrier_complete(bar, b.x, nloc, nx); b.st[0] = nloc; b.st[1] = nx; }
        const unsigned old = xb_add(&bar[XB_XSUB(b.x)], 1u);
        const unsigned gen = old / nloc;
        if (old + 1u == (gen + 1u) * nloc) {
            __builtin_amdgcn_fence(__ATOMIC_RELEASE, "agent");
            asm volatile("s_waitcnt vmcnt(0)" ::: "memory");
            const unsigned og = xb_add(&bar[XB_TOP], 1u);
            const unsigned tg = og / nx;
            if (og + 1u == (tg + 1u) * nx) xb_add(&bar[XB_TOPGEN], 1u);
            else XB_SPIN(xb_ld(&bar[XB_TOPGEN]) == tg, bar);
            __builtin_amdgcn_fence(__ATOMIC_ACQUIRE, "agent");
            xb_add(&bar[XB_XGEN(b.x)], 1u);
            asm volatile("s_waitcnt vmcnt(0)" ::: "memory");
        } else {
            XB_SPIN(xb_ld(&bar[XB_XGEN(b.x)]) == gen, bar);
            __builtin_amdgcn_fence(__ATOMIC_ACQUIRE, "agent");
            asm volatile("s_waitcnt vmcnt(0)" ::: "memory");
        }
    }
    __syncthreads();
}

__device__ __forceinline__ int crow(int r, int hi) { return (r & 3) + 8 * (r >> 2) + 4 * hi; }
__device__ __forceinline__ void glds16(const void* gsrc, unsigned lds_dst) { unsigned keep;
    asm volatile("s_mov_b32 %0, m0\n\ts_mov_b32 m0, %2\n\ts_nop 0\n\tglobal_load_lds_dwordx4 %1, off\n\ts_mov_b32 m0, %0" : "=&s"(keep) : "v"(gsrc), "s"(lds_dst) : "memory"); }
typedef short v4i16_t __attribute__((ext_vector_type(4)));
typedef LAS const char* lds_cptr;
__device__ __forceinline__ v4i16_t vtr(lds_cptr p) { return __builtin_amdgcn_ds_read_tr16_b64_v4i16((LAS v4i16_t*)p); }

struct WCtx { int lane, r32, hi; unsigned kl, vl; lds_cptr klp, vlp; };
__device__ __forceinline__ WCtx make_ctx(LAS unsigned char* L, int wave) {
    int lane = threadIdx.x & 63; asm volatile("" : "+v"(lane));
    WCtx c; c.lane = lane; c.r32 = lane & 31; c.hi = lane >> 5; c.klp = (lds_cptr)(L + wave * WAVE_LDS); c.vlp = c.klp + 8 * KCH;
    c.kl = (unsigned)(uintptr_t)((unsigned char*)L) + wave * WAVE_LDS; c.vl = c.kl + 8 * KCH; return c;
}
struct AState { f32x16 o0, o1; float m, l; };
__device__ __forceinline__ void astate_init(AState& s) {
#pragma unroll
    for (int r = 0; r < 16; ++r) { s.o0[r] = 0.f; s.o1[r] = 0.f; }
    s.m = -INFINITY; s.l = 0.f;
}

template <class RowF> __device__ __forceinline__ void tile_issue(const WCtx& c, const bf16* Kb, const bf16* Vb, RowF rowf) {
    asm volatile("s_waitcnt lgkmcnt(0)" ::: "memory");
    unsigned kro = (unsigned)rowf(c.lane) * 128u; asm volatile("" : "+v"(kro));
    const char* kp = (const char*)Kb + kro;
#pragma unroll
    for (int cc = 0; cc < 8; ++cc) glds16(kp + 16 * cc, (unsigned)__builtin_amdgcn_readfirstlane(c.kl + cc * KCH));
#pragma unroll
    for (int g = 0; g < 4; ++g) { unsigned vro = (unsigned)rowf(16 * g + (c.lane >> 2)) * 128u + (c.lane & 3) * 16; asm volatile("" : "+v"(vro));
        const char* vp = (const char*)Vb + vro;
        glds16(vp, (unsigned)__builtin_amdgcn_readfirstlane(c.vl + g * 1024));
        glds16(vp + 64, (unsigned)__builtin_amdgcn_readfirstlane(c.vl + (4 + g) * 1024)); }
}
__device__ __forceinline__ void tile_wait() { asm volatile("s_waitcnt vmcnt(0)" ::: "memory"); }

__device__ __forceinline__ void tile_qk(const WCtx& c, const bf16x8 (&qr)[4], f32x16& p0, f32x16& p1) {
#pragma unroll
    for (int r = 0; r < 16; ++r) { p0[r] = 0.f; p1[r] = 0.f; }
    lds_cptr kb = c.klp + c.hi * KCH + c.r32 * 16;
#pragma unroll
    for (int d0 = 0; d0 < 4; ++d0) {
        const bf16x8 b0 = *(LAS const bf16x8*)(kb + d0 * 2 * KCH), b1 = *(LAS const bf16x8*)(kb + d0 * 2 * KCH + 512);
        p0 = __builtin_amdgcn_mfma_f32_32x32x16_bf16(b0, qr[d0], p0, 0, 0, 0);
        p1 = __builtin_amdgcn_mfma_f32_32x32x16_bf16(b1, qr[d0], p1, 0, 0, 0);
    }
}
__device__ __forceinline__ void tile_pv(const WCtx& c, f32x16& o0, f32x16& o1, const f32x16& p0, const f32x16& p1) {
    u32x4 pw[4];
#pragma unroll
    for (int k = 0; k < 2; ++k) {
        pw[k]     = (u32x4){cvtpk(p0[8 * k], p0[8 * k + 1]), cvtpk(p0[8 * k + 2], p0[8 * k + 3]), cvtpk(p0[8 * k + 4], p0[8 * k + 5]), cvtpk(p0[8 * k + 6], p0[8 * k + 7])};
        pw[2 + k] = (u32x4){cvtpk(p1[8 * k], p1[8 * k + 1]), cvtpk(p1[8 * k + 2], p1[8 * k + 3]), cvtpk(p1[8 * k + 4], p1[8 * k + 5]), cvtpk(p1[8 * k + 6], p1[8 * k + 7])};
    }
    lds_cptr vb = c.vlp + ((c.lane >> 4) & 1) * 32 + (c.lane & 3) * 8 + (4 * c.hi + ((c.lane & 15) >> 2)) * 64;
#pragma unroll
    for (int ks = 0; ks < 4; ++ks) {
        const v4i16_t l0 = vtr(vb + ks * 1024), h0 = vtr(vb + ks * 1024 + 512), l1 = vtr(vb + 4096 + ks * 1024), h1 = vtr(vb + 4096 + ks * 1024 + 512);
        const bf16x8 v0 = (bf16x8){l0[0], l0[1], l0[2], l0[3], h0[0], h0[1], h0[2], h0[3]};
        const bf16x8 v1 = (bf16x8){l1[0], l1[1], l1[2], l1[3], h1[0], h1[1], h1[2], h1[3]};
        const bf16x8 pf = __builtin_bit_cast(bf16x8, pw[ks]);
        o0 = __builtin_amdgcn_mfma_f32_32x32x16_bf16(v0, pf, o0, 0, 0, 0);
        o1 = __builtin_amdgcn_mfma_f32_32x32x16_bf16(v1, pf, o1, 0, 0, 0);
        asm volatile("" ::: "memory");
    }
}
template <class ScoreF> __device__ __forceinline__ void tile_step(const WCtx& c, AState& st, const bf16x8 (&qr)[4], ScoreF sf) {
    f32x16 p0, p1; tile_qk(c, qr, p0, p1);
    float rm = -INFINITY;
#pragma unroll
    for (int r = 0; r < 16; ++r) { const int j = crow(r, c.hi); p0[r] = sf(p0[r], j); rm = fmaxf(rm, p0[r]); }
    asm volatile("" ::: "memory");
#pragma unroll
    for (int r = 0; r < 16; ++r) { const int j = crow(r, c.hi); p1[r] = sf(p1[r], j + 32); rm = fmaxf(rm, p1[r]); }
    asm volatile("" ::: "memory");
    rm = fmaxf(rm, __shfl_xor(rm, 32));
    const float mn = fmaxf(st.m, rm), mu = fmaxf(mn, -1e30f);
    const float f = fast_exp2(st.m - mu);
    st.m = mn;
    float sum = 0.f;
#pragma unroll
    for (int r = 0; r < 16; ++r) { p0[r] = fast_exp2(p0[r] - mu); p1[r] = fast_exp2(p1[r] - mu); sum += p0[r] + p1[r]; }
    st.l = st.l * f + sum;
#pragma unroll
    for (int r = 0; r < 16; ++r) { st.o0[r] *= f; st.o1[r] *= f; }
    tile_pv(c, st.o0, st.o1, p0, p1);
}
__device__ __forceinline__ void astate_fold(const AState& st, float w, f32x16& a0, f32x16& a1) {
    const float lt = st.l + __shfl_xor(st.l, 32);
    const float sc = lt > 0.f ? w / lt : 0.f;
#pragma unroll
    for (int r = 0; r < 16; ++r) { a0[r] += st.o0[r] * sc; a1[r] += st.o1[r] * sc; }
}
__device__ __forceinline__ void store_o(const WCtx& c, bf16* orow, const f32x16& a0, const f32x16& a1) {
#pragma unroll
    for (int g = 0; g < 4; ++g) {
        u32x2 w0, w1; w0.x = cvtpk(a0[4 * g], a0[4 * g + 1]); w0.y = cvtpk(a0[4 * g + 2], a0[4 * g + 3]); w1.x = cvtpk(a1[4 * g], a1[4 * g + 1]); w1.y = cvtpk(a1[4 * g + 2], a1[4 * g + 3]);
        *(u32x2*)(orow + 8 * g + 4 * c.hi) = w0; *(u32x2*)(orow + 32 + 8 * g + 4 * c.hi) = w1;
    }
}
__device__ __forceinline__ void load_q(bf16x8 (&qr)[4], const bf16* qrow, int hi) {
#pragma unroll
    for (int d0 = 0; d0 < 4; ++d0) qr[d0] = *(const bf16x8*)(qrow + d0 * 16 + hi * 8);
}
__device__ __forceinline__ float tab_at(LAS const float* tab, int d) { const unsigned i = (unsigned)d > (unsigned)(TABN - 1) ? (unsigned)(TABN - 1) : (unsigned)d; return tab[i]; }

__device__ __forceinline__ void moba_wave(LAS unsigned char* L_, int wid, int b, int h, int j, const bf16* Q, const bf16* K, const bf16* V, bf16* O, LAS const float* tab, LAS const float* km) {
    const WCtx c = make_ctx(L_, wid);
    const size_t hb = (size_t)(b * NH + h) * SEQ;
    const bf16* Kb = K + hb * HD; const bf16* Vb = V + hb * HD;
    const int t0 = 256 * j + 32 * wid, tq = t0 + c.r32;
    const bf16* qrow = Q + (hb + tq) * HD;
    bf16x8 qr[4]; load_q(qr, qrow, c.hi);
    unsigned sel = 0u;
    if (j > 0) {
        float g4[4] = {0.f, 0.f, 0.f, 0.f};
#pragma unroll
        for (int ch = 0; ch < 8; ++ch) {
            const u32x4 qq = *(const u32x4*)(qrow + 8 * ch);
            const float qf[8] = {__builtin_bit_cast(float, qq.x << 16), __builtin_bit_cast(float, qq.x & 0xffff0000u), __builtin_bit_cast(float, qq.y << 16), __builtin_bit_cast(float, qq.y & 0xffff0000u),
                                 __builtin_bit_cast(float, qq.z << 16), __builtin_bit_cast(float, qq.z & 0xffff0000u), __builtin_bit_cast(float, qq.w << 16), __builtin_bit_cast(float, qq.w & 0xffff0000u)};
#pragma unroll
            for (int k = 0; k < 4; ++k) { LAS const float* kr = km + (2 * k + c.hi) * 64 + 8 * ch;
                const f32x4 a = *(LAS const f32x4*)kr, bq = *(LAS const f32x4*)(kr + 4);
                g4[k] += (qf[0] * a[0] + qf[1] * a[1]) + (qf[2] * a[2] + qf[3] * a[3]) + (qf[4] * bq[0] + qf[5] * bq[1]) + (qf[6] * bq[2] + qf[7] * bq[3]); }
        }
        float ga[8];
#pragma unroll
        for (int k = 0; k < 4; ++k) { const float ot = __shfl_xor(g4[k], 32); ga[2 * k] = c.hi ? ot : g4[k]; ga[2 * k + 1] = c.hi ? g4[k] : ot; }
#pragma unroll
        for (int n = 0; n < 8; ++n) if (n >= j) ga[n] = -INFINITY;
#pragma unroll
        for (int n = 0; n < 8; ++n) { int rank = 0;
#pragma unroll
            for (int n2 = 0; n2 < 8; ++n2) if (n2 != n) rank += (n2 < n) ? (ga[n2] >= ga[n] ? 1 : 0) : (ga[n2] > ga[n] ? 1 : 0);
            if (rank < 3 && n < j) sel |= 1u << n; }
    }
    AState st; astate_init(st);
    const int nown = (wid >> 1) + 1;
    for (int kt = 0; kt < nown; ++kt) {
        const int k0 = 256 * j + 64 * kt;
        tile_issue(c, Kb, Vb, [&](int jj) { return k0 + jj; }); tile_wait();
        tile_step(c, st, qr, [&](float raw, int jj) { const int d = tq - (k0 + jj); return d >= 0 ? raw * C2 + tab_at(tab, d) : -INFINITY; });
    }
    for (int n = 0; n < j; ++n) {
        const bool mine = (sel >> n) & 1u;
        if (!__any(mine)) continue;
        for (int kt = 0; kt < 4; ++kt) {
            const int k0 = 256 * n + 64 * kt;
            tile_issue(c, Kb, Vb, [&](int jj) { return k0 + jj; }); tile_wait();
            tile_step(c, st, qr, [&](float raw, int jj) { const int d = tq - (k0 + jj); return mine ? raw * C2 + tab_at(tab, d) : -INFINITY; });
        }
    }
    f32x16 a0, a1;
#pragma unroll
    for (int r = 0; r < 16; ++r) { a0[r] = 0.f; a1[r] = 0.f; }
    astate_fold(st, 1.0f, a0, a1);
    store_o(c, O + ((size_t)b * SEQ + tq) * DM + h * HD, a0, a1);
}

__device__ __forceinline__ void dil_wave(LAS unsigned char* L_, int wid, int b, int h, int chunk, int rho, const bf16* Q, const bf16* K, const bf16* V, bf16* O, LAS const float* tab) {
    const WCtx c = make_ctx(L_, wid);
    const size_t hb = (size_t)(b * NH + h) * SEQ;
    const bf16* Kb = K + hb * HD; const bf16* Vb = V + hb * HD;
    const int t0 = 512 * chunk + rho, tq = t0 + 16 * c.r32;
    bf16x8 qr[4]; load_q(qr, Q + (hb + tq) * HD, c.hi);
    AState st; astate_init(st);
#pragma unroll 1
    for (int br = 0; br < 3; ++br) {
        const int r = br == 0 ? 1 : br == 1 ? 4 : 16;
        const int maxd = 128 * r, kbase = t0 - maxd;
        const int t_last = t0 + 16 * 31;
        const int ntile = (t_last - kbase) / (64 * r) + 1;
        for (int kt = 0; kt < ntile; ++kt) {
            const int k0 = kbase + 64 * r * kt;
            tile_issue(c, Kb, Vb, [&](int jj) { int kp = k0 + r * jj; kp = kp < 0 ? 0 : kp; return kp > SEQ - 1 ? SEQ - 1 : kp; }); tile_wait();
            tile_step(c, st, qr, [&](float raw, int jj) { const int kp = k0 + r * jj, d = tq - kp; return ((unsigned)d <= (unsigned)maxd && kp >= 0) ? raw * C2 + tab_at(tab, d) : -INFINITY; });
        }
    }
    f32x16 a0, a1;
#pragma unroll
    for (int r = 0; r < 16; ++r) { a0[r] = 0.f; a1[r] = 0.f; }
    astate_fold(st, 1.0f, a0, a1);
    store_o(c, O + ((size_t)b * SEQ + tq) * DM + h * HD, a0, a1);
}

__device__ __forceinline__ void nsa_wave(int wid, LAS unsigned char* lds, int b, int g, int chunk, const bf16* Q, const bf16* KV1, const bf16* KC, const bf16* VC,
                                         const float* gates, bf16* O, LAS const float* tabs) {
    const WCtx c = make_ctx(lds, wid);
    const int hh = wid & 3, qt = wid >> 2, h = 4 * g + hh;
    LAS const float* tab = tabs + hh * TABN;
    const int t0 = 64 * chunk + 32 * qt, tq = t0 + c.r32, cur = chunk;
    const size_t qb = (size_t)(b * NH + h) * SEQ, gb = (size_t)(b * 4 + g) * SEQ, TS = (size_t)BATCH * 4 * SEQ * HD;
    bf16x8 qr[4]; load_q(qr, Q + (qb + tq) * HD, c.hi);
    const bf16* KCb = KC + (size_t)(b * 4 + g) * 128 * HD; const bf16* VCb = VC + (size_t)(b * 4 + g) * 128 * HD;
    const float* grow = gates + ((size_t)b * SEQ + tq) * 48 + 3 * h;
    const float g0 = grow[0], g1 = grow[1], g2 = grow[2];
    f32x16 a0, a1;
#pragma unroll
    for (int r = 0; r < 16; ++r) { a0[r] = 0.f; a1[r] = 0.f; }
    f32x16 p[4];
    tile_issue(c, KCb, VCb, [&](int jj) { return jj; }); tile_wait();
    tile_qk(c, qr, p[0], p[1]);
    float rm = -INFINITY;
#pragma unroll
    for (int T = 0; T < 2; ++T)
#pragma unroll
        for (int r = 0; r < 16; ++r) { const int cc = 32 * T + crow(r, c.hi), dc = tq - (16 * cc + 31); p[T][r] = dc >= 0 ? p[T][r] * C2 + tab_at(tab, dc) : -INFINITY; rm = fmaxf(rm, p[T][r]); }
    {   asm volatile("s_waitcnt lgkmcnt(0)" ::: "memory");
        const char* kp = (const char*)KCb + (size_t)(64 + c.lane) * 128;
#pragma unroll
        for (int cc = 0; cc < 8; ++cc) glds16(kp + 16 * cc, (unsigned)__builtin_amdgcn_readfirstlane(c.kl + cc * KCH));
        tile_wait(); }
    tile_qk(c, qr, p[2], p[3]);
#pragma unroll
    for (int T = 2; T < 4; ++T)
#pragma unroll
        for (int r = 0; r < 16; ++r) { const int cc = 32 * T + crow(r, c.hi), dc = tq - (16 * cc + 31); p[T][r] = (dc >= 0 && cc < 127) ? p[T][r] * C2 + tab_at(tab, dc) : -INFINITY; rm = fmaxf(rm, p[T][r]); }
    rm = fmaxf(rm, __shfl_xor(rm, 32));
    const float mu = fmaxf(rm, -1e30f);
    float lsum = 0.f;
#pragma unroll
    for (int T = 0; T < 4; ++T)
#pragma unroll
        for (int r = 0; r < 16; ++r) { p[T][r] = fast_exp2(p[T][r] - mu); lsum += p[T][r]; }
    lsum += __shfl_xor(lsum, 32);
    const float linv = lsum > 0.f ? 1.0f / lsum : 0.f;
#pragma unroll
    for (int T = 0; T < 4; ++T)
#pragma unroll
        for (int r = 0; r < 16; ++r) p[T][r] *= linv;
    tile_pv(c, a0, a1, p[0], p[1]);
    {   asm volatile("s_waitcnt lgkmcnt(0)" ::: "memory");
#pragma unroll
        for (int gq = 0; gq < 4; ++gq) { const char* vp = (const char*)VCb + (size_t)(64 + 16 * gq + (c.lane >> 2)) * 128 + (c.lane & 3) * 16;
            glds16(vp, (unsigned)__builtin_amdgcn_readfirstlane(c.vl + gq * 1024));
            glds16(vp + 64, (unsigned)__builtin_amdgcn_readfirstlane(c.vl + (4 + gq) * 1024)); }
        tile_wait(); }
    tile_pv(c, a0, a1, p[2], p[3]);
#pragma unroll
    for (int r = 0; r < 16; ++r) { a0[r] *= g0; a1[r] *= g0; }
    LAS float* IA = (LAS float*)(lds + wid * WAVE_LDS); LAS float* IB = IA + 32 * 33;
    asm volatile("s_waitcnt lgkmcnt(0)" ::: "memory");
#pragma unroll
    for (int T = 0; T < 4; ++T)
#pragma unroll
        for (int gq = 0; gq < 4; ++gq) { const int n = 8 * T + 2 * gq + c.hi; const float b3 = 16.f * p[T][4 * gq + 3];
            IA[c.r32 * 33 + n] = 32.f * (p[T][4 * gq] + p[T][4 * gq + 1] + p[T][4 * gq + 2]) + b3; IB[c.r32 * 33 + n] = b3; }
    __syncthreads();
    float imp[16];
#pragma unroll
    for (int k = 0; k < 16; ++k) imp[k] = 0.f;
#pragma unroll
    for (int w4 = 0; w4 < 4; ++w4) { LAS const float* A = (LAS const float*)(lds + (w4 + 4 * qt) * WAVE_LDS) + c.r32 * 33; LAS const float* Bq = A + 32 * 33;
#pragma unroll
        for (int k = 0; k < 16; ++k) { const int n = 16 * c.hi + k; imp[k] += A[n] + (n > 0 ? Bq[n - 1] : 0.f); } }
    __syncthreads();
    int mine[16], oth[16];
#pragma unroll
    for (int k = 0; k < 16; ++k) { const int n = 16 * c.hi + k; const bool valid = n <= cur, forced = (n == 0) || (n == cur) || (n == cur - 1);
        mine[k] = !valid ? -2 : forced ? 0x7f000000 : __builtin_bit_cast(int, imp[k]);
        oth[k] = __shfl_xor(mine[k], 32); }
    unsigned selm = 0u;
#pragma unroll
    for (int k = 0; k < 16; ++k) { int rank = 0; const int me = mine[k], me1 = mine[k] - 1, meo = mine[k] - c.hi;
#pragma unroll
        for (int k2 = 0; k2 < 16; ++k2) { if (k2 < k) rank += mine[k2] > me1 ? 1 : 0; else if (k2 > k) rank += mine[k2] > me ? 1 : 0; rank += oth[k2] > meo ? 1 : 0; }
        if (rank < 16) selm |= 1u << k; }
    selm <<= 16 * c.hi;
    selm |= __shfl_xor(selm, 32);
    selm &= (cur >= 31) ? 0xffffffffu : ((2u << cur) - 1u);
    {   const bf16* Kb = KV1 + 2 * TS + gb * HD; const bf16* Vb = KV1 + 3 * TS + gb * HD;
        AState st; astate_init(st);
        for (int n = 0; n <= cur; ++n) {
            const bool mine = (selm >> n) & 1u;
            if (!__any(mine)) continue;
            const int k0 = 64 * n;
            tile_issue(c, Kb, Vb, [&](int jj) { return k0 + jj; }); tile_wait();
            tile_step(c, st, qr, [&](float raw, int jj) { const int d = tq - (k0 + jj); return (mine && d >= 0) ? raw * C2 + tab_at(tab, d) : -INFINITY; });
        }
        astate_fold(st, g1, a0, a1);
    }
    {   const bf16* Kb = KV1 + 4 * TS + gb * HD; const bf16* Vb = KV1 + 5 * TS + gb * HD;
        AState st; astate_init(st);
        int lo = t0 - 511; lo = lo < 0 ? 0 : lo;
        for (int kt = lo >> 6; kt <= (t0 + 31) >> 6; ++kt) {
            const int k0 = 64 * kt;
            tile_issue(c, Kb, Vb, [&](int jj) { return k0 + jj; }); tile_wait();
            tile_step(c, st, qr, [&](float raw, int jj) { const int d = tq - (k0 + jj); return ((unsigned)d < 512u) ? raw * C2 + tab_at(tab, d) : -INFINITY; });
        }
        astate_fold(st, g2, a0, a1);
    }
    store_o(c, O + ((size_t)b * SEQ + tq) * DM + h * HD, a0, a1);
}

#define LDS_WAIT() asm volatile("s_waitcnt lgkmcnt(0)" ::: "memory")
#define VM_WAIT() asm volatile("s_waitcnt vmcnt(0)" ::: "memory")
constexpr int NWAVES = 8;
__device__ __forceinline__ float wave_sum(float v) {
#pragma unroll
    for (int o = 1; o < 64; o <<= 1) v += __shfl_xor(v, o);
    return v;
}

struct Args { const float* in[33]; float* out; unsigned char* ws; int ph_lo, ph_hi; };

__device__ __forceinline__ void tr_item(const float* src, int Nsrc, int srccol0, const float* gain, bf16* dst, int Kdst, int dstrow0, int k0, LAS float* scr, int lane) {
    const int col = srccol0 + (lane & 31); const bool ok = col < Nsrc;
#pragma unroll 8
    for (int i = 0; i < 32; ++i) { const int kk = 2 * i + (lane >> 5); float v = ok ? src[(size_t)(k0 + kk) * Nsrc + col] : 0.f; if (gain) v *= gain[k0 + kk]; scr[kk * 33 + (lane & 31)] = v; }
    LDS_WAIT(); asm volatile("" ::: "memory");
    const int c = lane & 7;
#pragma unroll
    for (int j = 0; j < 4; ++j) { const int n = (lane >> 3) + 8 * j; const LAS float* s = scr + (8 * c) * 33 + n;
        u32x4 o; o.x = pk2(s[0 * 33], s[1 * 33]); o.y = pk2(s[2 * 33], s[3 * 33]); o.z = pk2(s[4 * 33], s[5 * 33]); o.w = pk2(s[6 * 33], s[7 * 33]);
        *(GAS u32x4*)(dst + (size_t)(dstrow0 + n) * Kdst + k0 + 8 * c) = o; }
    LDS_WAIT(); asm volatile("" ::: "memory");
}
__device__ __forceinline__ void tr_matrix(int item, const float* src, const float* src2, int Ksrc, int Nsrc, int Ndst, int map, const float* gain, bf16* dst, LAS float* scr, int lane) {
    const int nblk = Ndst / 32, kb = item / nblk, nb = item % nblk;
    int srccol0 = 32 * nb; const float* s = src;
    if (map == 1) { const int pn = nb >> 3, pb = nb & 7, half = pb >> 2, hh = pb & 3; srccol0 = 256 * pn + 64 * hh + 32 * half; }
    else if (map == 2) { const int pn = nb >> 3, pb = nb & 7; srccol0 = 128 * pn + 32 * (pb & 3); s = (pb < 4) ? src : src2; }
    tr_item(s, Nsrc, srccol0, gain, dst, Ksrc, 32 * nb, 64 * kb, scr, lane);
}

__device__ __forceinline__ int rel_bucket(int d) {
    if (d < 16) return d;
    int b = 16;
    b += d >= 22; b += d >= 30; b += d >= 40; b += d >= 54; b += d >= 73; b += d >= 99; b += d >= 134; b += d >= 182;
    b += d >= 246; b += d >= 332; b += d >= 450; b += d >= 609; b += d >= 825; b += d >= 1117; b += d >= 1513;
    return b;
}

__global__ void __launch_bounds__(NWAVES * 64, 2) fwd_kernel(Args args) {
    extern __shared__ __attribute__((aligned(16))) unsigned char lds[];
    LAS unsigned char* L = (LAS unsigned char*)lds;
    volatile LAS unsigned* MISC = (volatile LAS unsigned*)(L + MISC_OFF);
    const int tid = threadIdx.x, lane = tid & 63, wave = __builtin_amdgcn_readfirstlane(tid >> 6);
    const int G = gridDim.x; const int bx = blockIdx.x; const int vcu = (G % 8 == 0) ? (bx % 8) * (G / 8) + bx / 8 : bx;
    unsigned char* ws = args.ws;
    gu32* ctl = (gu32*)(ws + WS_CTL);
    for (int u = tid; u < 128; u += NWAVES * 64) ((LAS unsigned*)(L + MISC_OFF))[u] = 0u;
    __syncthreads();
    XcdBarrier bar = xcd_barrier_post((unsigned*)(ctl + CW_BAR), MISC + 8);
    const int lo = args.ph_lo, hi = args.ph_hi;
#define IN(k) (((MK_MASK >> (k)) & 1) && lo <= (k) && (k) < hi)
#define PHASE_IDS int tid_o = threadIdx.x; asm volatile("" : "+v"(tid_o)); const int tid = tid_o, lane = tid_o & 63; (void)tid; (void)lane;
#define INR(k) (lo <= (k) && (k) < hi)
#define SEAM(k) do { if (INR(k) && INR((k) + 1)) xcd_barrier(bar); } while (0)

    ss_t* ssb = (ss_t*)(ws + WS_SS);
    float* kmean = (float*)(ws + WS_KMEAN);
    float* biasd = (float*)(ws + WS_BIASD);
    float* cb1 = (float*)(ws + WS_CB1);
    bf16* HB = (bf16*)(ws + WS_HB); bf16* PP = (bf16*)(ws + WS_PP); bf16* OB = (bf16*)(ws + WS_O);
    bf16* QB = (bf16*)(ws + WS_Q); bf16* K0 = (bf16*)(ws + WS_K0); bf16* V0 = (bf16*)(ws + WS_V0); bf16* KV1 = (bf16*)(ws + WS_KV1);
    bf16* HID = (bf16*)(ws + WS_HID); bf16* PB0 = (bf16*)(ws + WS_PB0); bf16* PB1 = (bf16*)(ws + WS_PB1);
    bf16* KC = (bf16*)(ws + WS_KC); bf16* VC = (bf16*)(ws + WS_VC);
    float* GATES = (float*)(ws + WS_GATES);
    const int gw = vcu * NWAVES + wave, NGW = G * NWAVES;

    if (IN(0)) {
        PHASE_IDS
        LAS float* scr = (LAS float*)(L + wave * WAVE_LDS);
        const float* nmix = args.in[3]; const float* nffn = args.in[4]; const float* nple = args.in[5];
        constexpr int I_IN0 = 16 * (N_IN0 / 32), I_IN1 = 16 * (N_IN1P / 32), I_OUT = 16 * 32, I_GU = 16 * (N_GU / 32), I_D = (FF / 64) * 32, I_PG = 16 * 32, I_PP = 4 * 32, I_C1 = 32 * 4, I_C2 = 2 * 2;
        constexpr int NIT = I_IN0 + I_IN1 + 2 * I_OUT + 2 * I_GU + 2 * I_D + 2 * I_PG + 2 * I_PP + 2 * I_C1 + 2 * I_C2;
        for (int it = gw; it < NIT; it += NGW) {
            int r = it;
            if (r < I_IN0) { tr_matrix(r, args.in[11], nullptr, DM, N_IN0, N_IN0, 1, nmix, (bf16*)(ws + WS_WIN0), scr, lane); continue; } r -= I_IN0;
            if (r < I_IN1) { tr_matrix(r, args.in[17], nullptr, DM, N_IN1, N_IN1P, 1, nmix + DM, (bf16*)(ws + WS_WIN1), scr, lane); continue; } r -= I_IN1;
            if (r < I_OUT) { tr_matrix(r, args.in[12], nullptr, DM, DM, DM, 0, nullptr, (bf16*)(ws + WS_WOUT0), scr, lane); continue; } r -= I_OUT;
            if (r < I_OUT) { tr_matrix(r, args.in[18], nullptr, DM, DM, DM, 0, nullptr, (bf16*)(ws + WS_WOUT1), scr, lane); continue; } r -= I_OUT;
            if (r < I_GU) { tr_matrix(r, args.in[6], args.in[7], DM, FF, N_GU, 2, nffn, (bf16*)(ws + WS_WGU0), scr, lane); continue; } r -= I_GU;
            if (r < I_GU) { tr_matrix(r, args.in[6] + (size_t)DM * FF, args.in[7] + (size_t)DM * FF, DM, FF, N_GU, 2, nffn + DM, (bf16*)(ws + WS_WGU1), scr, lane); continue; } r -= I_GU;
            if (r < I_D) { tr_matrix(r, args.in[8], nullptr, FF, DM, DM, 0, nullptr, (bf16*)(ws + WS_WD0), scr, lane); continue; } r -= I_D;
            if (r < I_D) { tr_matrix(r, args.in[8] + (size_t)FF * DM, nullptr, FF, DM, DM, 0, nullptr, (bf16*)(ws + WS_WD1), scr, lane); continue; } r -= I_D;
            if (r < I_PG) { tr_matrix(r, args.in[10], nullptr, DM, DM, DM, 0, nple, (bf16*)(ws + WS_WPG0), scr, lane); continue; } r -= I_PG;
            if (r < I_PG) { tr_matrix(r, args.in[10] + (size_t)DM * DM, nullptr, DM, DM, DM, 0, nple + DM, (bf16*)(ws + WS_WPG1), scr, lane); continue; } r -= I_PG;
            if (r < I_PP) { tr_matrix(r, args.in[9], nullptr, PLE, DM, DM, 0, nullptr, (bf16*)(ws + WS_WPP0), scr, lane); continue; } r -= I_PP;
            if (r < I_PP) { tr_matrix(r, args.in[9] + (size_t)PLE * DM, nullptr, PLE, DM, DM, 0, nullptr, (bf16*)(ws + WS_WPP1), scr, lane); continue; } r -= I_PP;
            if (r < I_C1) { tr_matrix(r, args.in[24], nullptr, 2048, 128, 128, 0, nullptr, (bf16*)(ws + WS_CW1K), scr, lane); continue; } r -= I_C1;
            if (r < I_C1) { tr_matrix(r, args.in[29], nullptr, 2048, 128, 128, 0, nullptr, (bf16*)(ws + WS_CW1V), scr, lane); continue; } r -= I_C1;
            if (r < I_C2) { tr_matrix(r, args.in[26], nullptr, 128, 64, 64, 0, nullptr, (bf16*)(ws + WS_CW2K), scr, lane); continue; } r -= I_C2;
            tr_matrix(r, args.in[31], nullptr, 128, 64, 64, 0, nullptr, (bf16*)(ws + WS_CW2V), scr, lane);
        }
        const float* x = args.in[0];
        for (int m = gw; m < M; m += NGW) {
            const GAS f32x4* xr = (const GAS f32x4*)(x + (size_t)m * DM) + lane; f32x4 v[4]; float s = 0.f;
#pragma unroll
            for (int j = 0; j < 4; ++j) { v[j] = xr[64 * j]; s += (v[j].x * v[j].x + v[j].y * v[j].y) + (v[j].z * v[j].z + v[j].w * v[j].w); }
            s = wave_sum(s);
            GAS unsigned long long* o8 = (GAS unsigned long long*)(HB + (size_t)m * DM) + lane;
#pragma unroll
            for (int j = 0; j < 4; ++j) o8[64 * j] = (unsigned long long)pk2(v[j].x, v[j].y) | ((unsigned long long)pk2(v[j].z, v[j].w) << 32);
            if (lane == 0) ssb[m] = (ss_t)(s * SS_SCALE);
        }
        const float* p0 = args.in[1];
        for (int m = gw; m < M; m += NGW) { const f32x4 v = ((const GAS f32x4*)(p0 + (size_t)m * PLE))[lane];
            ((GAS unsigned long long*)(PB0 + (size_t)m * PLE))[lane] = (unsigned long long)pk2(v.x, v.y) | ((unsigned long long)pk2(v.z, v.w) << 32); }
        const float* relb = args.in[2];
        for (int i = bx * 512 + tid; i < NH * TABN; i += G * 512) { const int h = i / TABN, d = i % TABN; biasd[i] = relb[rel_bucket(d) * NH + h] * LOG2E; }
        for (int o = gw; o < 256; o += NGW) { const int kv = o >> 7, col = o & 127; const float* pos = args.in[kv ? 28 : 23]; const float* w1 = args.in[kv ? 29 : 24]; const float* b1 = args.in[kv ? 30 : 25];
            float s = 0.f; for (int k = lane; k < 2048; k += 64) s += pos[k] * w1[(size_t)k * 128 + col];
            s = wave_sum(s); if (lane == 0) cb1[o] = s + b1[col]; }
        if (bx == 0) { const int gi = tid >> 6; const int src_idx = gi < 4 ? 13 + gi : gi == 4 ? 19 : gi == 5 ? 21 : gi == 6 ? 22 : 20; ((float*)(ws + WS_GN))[tid] = args.in[src_idx][tid & 63]; }
        for (int i = bx * 512 + tid; i < 2 * 32 * 32; i += G * 512) { const int kv = i >> 10, bg = (i >> 5) & 31, w = i & 31; ((unsigned*)((kv ? VC : KC) + ((size_t)bg * 128 + 127) * HD))[w] = 0u; }
    }
    SEAM(0);
    using namespace pg8;
    if (IN(1)) { int kk = PLE; asm volatile("" : "+s"(kk)); Gemm g{PB0, (const bf16*)(ws + WS_WPP0), M, DM, kk}; StaticOrder S; S.init(M, DM, G, bx); EpiStoreBf16 E{PP, DM};
        gemm_phase<EpiStoreBf16, StaticOrder, true, true>(L, g, S, E); }
    SEAM(1);
    if (IN(2)) { Gemm g{HB, (const bf16*)(ws + WS_WIN0), M, N_IN0, DM}; StaticOrder S; S.init(M, N_IN0, G, bx);
        EpiInProj<0> E{ssb, QB, (const float*)(ws + WS_GN), kmean, nullptr};
        gemm_phase<EpiInProj<0>, StaticOrder, true, true>(L, g, S, E); }
    SEAM(2);
    if (IN(3)) {
        PHASE_IDS
        LAS float* tab = (LAS float*)(L + TAB_OFF); LAS float* km = (LAS float*)(L + KM_OFF);
        const int nwg8 = G;
        for (int v = vcu; v < 256; v += nwg8) {
            const int bh = v >> 2, b = bh >> 3, h = bh & 7, sub = v & 3;
            __syncthreads();
            for (int i = tid; i < TABN; i += 512) tab[i] = biasd[h * TABN + i];
            { const int i = tid; km[i] = kmean[(size_t)(b * 8 + h) * 512 + i] * (1.0f / 256.0f); }
            __syncthreads();
            moba_wave(L, wave, b, h, sub, QB, K0, V0, OB, tab, km);
            moba_wave(L, wave, b, h, 7 - sub, QB, K0, V0, OB, tab, km);
            __syncthreads();
            for (int i = tid; i < TABN; i += 512) tab[i] = biasd[(8 + h) * TABN + i];
            __syncthreads();
            dil_wave(L, wave, b, 8 + h, sub, wave, QB, K0, V0, OB, tab);
            dil_wave(L, wave, b, 8 + h, sub, 8 + wave, QB, K0, V0, OB, tab);
        }
    }
    SEAM(3);
#pragma unroll 1
    for (int layer = 0; layer < 2; ++layer) {
        const int pb = layer ? 12 : 4;
        const size_t wofs = layer ? (WS_WIN1 - WS_WIN0) : 0;
        (void)wofs;
        const bf16* Wout = (const bf16*)(ws + (layer ? WS_WOUT1 : WS_WOUT0)); const bf16* Wgu = (const bf16*)(ws + (layer ? WS_WGU1 : WS_WGU0));
        const bf16* Wd = (const bf16*)(ws + (layer ? WS_WD1 : WS_WD0)); const bf16* Wpg = (const bf16*)(ws + (layer ? WS_WPG1 : WS_WPG0));
        ss_t* ss_ffn = ssb + (size_t)(3 * layer + 1) * M; ss_t* ss_ple = ssb + (size_t)(3 * layer + 2) * M; ss_t* ss_next = layer ? nullptr : ssb + (size_t)3 * M;
        if (layer == 1) {
            if (IN(8)) { int kk = PLE; asm volatile("" : "+s"(kk)); Gemm g{PB1, (const bf16*)(ws + WS_WPP1), M, DM, kk}; StaticOrder S; S.init(M, DM, G, bx); EpiStoreBf16 E{PP, DM};
                gemm_phase<EpiStoreBf16, StaticOrder, true, true>(L, g, S, E); }
            SEAM(8);
            if (IN(9)) { Gemm g{HB, (const bf16*)(ws + WS_WIN1), M, N_IN1P, DM}; StaticOrder S; S.init(M, N_IN1P, G, bx);
                EpiInProj<1> E{ssb + (size_t)3 * M, QB, (const float*)(ws + WS_GN), nullptr, GATES};
                gemm_phase<EpiInProj<1>, StaticOrder, true, true>(L, g, S, E); }
            SEAM(9);
            if (IN(10)) {
                PHASE_IDS
                for (int task = vcu; task < 256; task += G) {
                    const int kv = task >> 7, bg = (task >> 2) & 31, rt = task & 3, i0 = 32 * rt;
                    const bf16* T = KV1 + (size_t)kv * ((size_t)BATCH * 4 * SEQ * HD) + (size_t)bg * SEQ * HD;
                    const bf16* W1 = (const bf16*)(ws + (kv ? WS_CW1V : WS_CW1K)); const bf16* W2 = (const bf16*)(ws + (kv ? WS_CW2V : WS_CW2K));
                    const int r32 = lane & 31, hi5 = lane >> 5, nb = wave & 3, kh = wave >> 2;
                    f32x16 acc;
#pragma unroll
                    for (int r = 0; r < 16; ++r) acc[r] = 0.f;
                    int arow = i0 + r32; arow = arow > 126 ? 126 : arow;
                    const bf16* ap = T + (size_t)arow * 16 * HD + 1024 * kh + 8 * hi5;
                    const bf16* bp = W1 + (size_t)(32 * nb + r32) * 2048 + 1024 * kh + 8 * hi5;
#pragma unroll 8
                    for (int s = 0; s < 64; ++s) { const bf16x8 a = *(const bf16x8*)(ap + 16 * s), bb = *(const bf16x8*)(bp + 16 * s);
                        acc = __builtin_amdgcn_mfma_f32_32x32x16_bf16(a, bb, acc, 0, 0, 0); }
                    __syncthreads();
                    LAS float* part = (LAS float*)L;
#pragma unroll
                    for (int r = 0; r < 16; ++r) part[(kh * 32 + crow(r, hi5)) * 129 + 32 * nb + r32] = acc[r];
                    __syncthreads();
                    LAS bf16* H1 = (LAS bf16*)(L + 40960);
                    for (int e = tid; e < 32 * 128; e += 512) { const int row = e >> 7, col = e & 127;
                        const float v = part[row * 129 + col] + part[(32 + row) * 129 + col] + cb1[kv * 128 + col];
                        const float u2 = 0.7978845608028654f * (v + 0.044715f * v * v * v);
                        const float th = 1.0f - 2.0f * fast_rcp(1.0f + fast_exp2(2.0f * u2 * LOG2E));
                        H1[row * 136 + col] = (bf16)f2bf(0.5f * v * (1.0f + th)); }
                    __syncthreads();
                    LAS float* OUT = (LAS float*)(L + 57344);
                    if (wave < 2) {
                        f32x16 a2;
#pragma unroll
                        for (int r = 0; r < 16; ++r) a2[r] = 0.f;
#pragma unroll
                        for (int s = 0; s < 8; ++s) { const bf16x8 a = *(LAS const bf16x8*)(H1 + r32 * 136 + 16 * s + 8 * hi5);
                            const bf16x8 bb = *(const bf16x8*)(W2 + (size_t)(32 * wave + r32) * 128 + 16 * s + 8 * hi5);
                            a2 = __builtin_amdgcn_mfma_f32_32x32x16_bf16(a, bb, a2, 0, 0, 0); }
                        const float* b2 = args.in[kv ? 32 : 27];
#pragma unroll
                        for (int r = 0; r < 16; ++r) OUT[crow(r, hi5) * 65 + 32 * wave + r32] = a2[r] + b2[32 * wave + r32];
                    }
                    __syncthreads();
                    if (tid < 256) { const int row = tid >> 3, c8 = (tid & 7) * 8; float v[8]; float sq = 0.f;
#pragma unroll
                        for (int i = 0; i < 8; ++i) { v[i] = OUT[row * 65 + c8 + i]; sq += v[i] * v[i]; }
                        sq += __shfl_xor(sq, 1); sq += __shfl_xor(sq, 2); sq += __shfl_xor(sq, 4);
                        if (kv == 0) { const float r2 = rsqrtf(sq * (1.0f / HD) + RMS_EPS); const float* kn = (const float*)(ws + WS_GN) + 7 * 64;
#pragma unroll
                            for (int i = 0; i < 8; ++i) v[i] = v[i] * r2 * kn[c8 + i]; }
                        if (i0 + row < 127) { u32x4 w; w.x = pk2(v[0], v[1]); w.y = pk2(v[2], v[3]); w.z = pk2(v[4], v[5]); w.w = pk2(v[6], v[7]);
                            *(u32x4*)((kv ? VC : KC) + ((size_t)bg * 128 + i0 + row) * HD + c8) = w; } }
                    __syncthreads();
                }
            }
            SEAM(10);
            if (IN(11)) {
                PHASE_IDS
                LAS float* tabs = (LAS float*)(L + TAB_OFF);
                for (int v = vcu; v < 256; v += G) {
                    const int bg = v >> 3, b = bg >> 2, g = bg & 3, sub = v & 7;
                    __syncthreads();
                    for (int i = tid; i < 4 * TABN; i += 512) tabs[i] = biasd[(4 * g) * TABN + i];
                    __syncthreads();
#pragma unroll 1
                    for (int k = 0; k < 4; ++k) { const int pr = 2 * sub + (k >> 1); const int chunk = (k & 1) ? 31 - pr : pr;
                        nsa_wave(wave, L, b, g, chunk, QB, KV1, KC, VC, GATES, OB, tabs); }
                }
            }
            SEAM(11);
        }
        if (IN(pb)) {
            if (layer == 0) {
                PHASE_IDS
                const float* p1 = args.in[1] + (size_t)M * PLE;
                for (int m = gw; m < M; m += NGW) { const f32x4 v = ((const GAS f32x4*)(p1 + (size_t)m * PLE))[lane];
                    ((GAS unsigned long long*)(PB1 + (size_t)m * PLE))[lane] = (unsigned long long)pk2(v.x, v.y) | ((unsigned long long)pk2(v.z, v.w) << 32); }
            }
            Gemm g{OB, Wout, M, DM, DM}; StaticOrder S; S.init(M, DM, G, bx);
            EpiResid<0> E{layer ? args.out : args.in[0], args.out, HB, ss_ffn, nullptr, nullptr};
            gemm_phase<EpiResid<0>, StaticOrder, true, true>(L, g, S, E); }
        SEAM(pb);
        if (IN(pb + 1)) { Gemm g{HB, Wgu, M, N_GU, DM}; StaticOrder S; S.init(M, N_GU, G, bx); EpiSwiglu E{HID, ss_ffn};
            gemm_phase<EpiSwiglu, StaticOrder, true, true>(L, g, S, E); }
        SEAM(pb + 1);
        if (IN(pb + 2)) { Gemm g{HID, Wd, M, DM, FF}; StaticOrder S; S.init(M, DM, G, bx);
            EpiResid<0> E{args.out, args.out, HB, ss_ple, nullptr, nullptr};
            gemm_phase<EpiResid<0>, StaticOrder, true, true>(L, g, S, E); }
        SEAM(pb + 2);
        if (IN(pb + 3)) { Gemm g{HB, Wpg, M, DM, DM}; StaticOrder S; S.init(M, DM, G, bx);
            EpiResid<1> E{args.out, args.out, HB, ss_next, ss_ple, PP};
            gemm_phase<EpiResid<1>, StaticOrder, true, true>(L, g, S, E); }
        if (layer == 0) SEAM(7);
    }
#if MK_DBG
    if (lo == 99) {
        const bf16* src = (const bf16*)(ws + (size_t)MK_DBG_OFF);
        for (size_t i = (size_t)bx * 512 + threadIdx.x; i < (size_t)M * DM; i += (size_t)G * 512) args.out[i] = i < (size_t)MK_DBG_CNT ? bf2f(src[i]) : 0.f;
    }
#endif
#undef IN
#undef SEAM
}

extern "C" void kernel_launch(void* const* d_in, const int* in_sizes, int n_in, void* d_out, int out_size, void* d_ws, size_t ws_size, hipStream_t stream) {
    static int grid = 0;
    if (grid == 0) {
        if (n_in != 33 || out_size != M * DM || ws_size < WS_END) { fprintf(stderr, "kernel_launch: unexpected problem (n_in %d out %d ws %zu)\n", n_in, out_size, ws_size); grid = -1; return; }
        int dev = 0, cus = 0, per_cu = 0;
        if (hipGetDevice(&dev) != hipSuccess || hipDeviceGetAttribute(&cus, hipDeviceAttributeMultiprocessorCount, dev) != hipSuccess) { grid = -1; return; }
        if (hipFuncSetAttribute((const void*)fwd_kernel, hipFuncAttributeMaxDynamicSharedMemorySize, LDS_BYTES) != hipSuccess) { fprintf(stderr, "kernel_launch: hipFuncSetAttribute failed\n"); grid = -1; return; }
        if (hipOccupancyMaxActiveBlocksPerMultiprocessor(&per_cu, (const void*)fwd_kernel, NWAVES * 64, LDS_BYTES) != hipSuccess || per_cu < 1) { fprintf(stderr, "kernel_launch: occupancy query says %d\n", per_cu); }
        (void)hipGetLastError();
        grid = cus < 256 ? cus : 256;
    }
    if (grid < 0) return;
    if (hipMemsetAsync((char*)d_ws + WS_CTL, 0, CTL_ZERO_BYTES, stream) != hipSuccess) return;
    Args a{};
    for (int i = 0; i < 33; ++i) a.in[i] = (const float*)d_in[i];
    a.out = (float*)d_out; a.ws = (unsigned char*)d_ws;
#if MK_SPLIT
    for (int ph = 0; ph < MK_PH_END; ++ph) { a.ph_lo = ph; a.ph_hi = ph + 1; hipLaunchKernelGGL(fwd_kernel, dim3(grid), dim3(NWAVES * 64), LDS_BYTES, stream, a); }
#if MK_DBG
    a.ph_lo = 99; a.ph_hi = 100; hipLaunchKernelGGL(fwd_kernel, dim3(grid), dim3(NWAVES * 64), LDS_BYTES, stream, a);
#endif
#else
    a.ph_lo = 0; a.ph_hi = MK_PH_END;
    hipLaunchKernelGGL(fwd_kernel, dim3(grid), dim3(NWAVES * 64), LDS_BYTES, stream, a);
#endif
}
```

```cpp
#include <hip/hip_runtime.h>
#include <cstdio>
#include <cstdint>

#ifndef MK_SPLIT
#define MK_SPLIT 0
#endif
#ifndef MK_DBG
#define MK_DBG 0
#define MK_DBG_OFF (0ull << 10)
#define MK_DBG_CNT (0)
#endif
#ifndef MK_REP
#define MK_REP 0
#endif
#ifndef MK_MASK
#define MK_MASK 0xFFFF
#endif
#ifndef MK_PH_END
#define MK_PH_END 16
#endif

namespace pg8 {
#define PG8_LAS __attribute__((address_space(3)))
typedef unsigned short bf16_t;
typedef short bf16x8 __attribute__((ext_vector_type(8)));
typedef float f32x4 __attribute__((ext_vector_type(4)));
typedef unsigned u32x4 __attribute__((ext_vector_type(4)));
constexpr int BM = 256, BK = 64, HALF = 128, HTB = HALF * BK * 2  , STAGE_BYTES = 8 * HTB, NXCD = 8, WGM = 8;

__host__ __device__ __forceinline__ int lds_byte(int r, int c) { const int st = (r >> 4) * 2 + (c >> 5), rr = r & 15, cc = c & 31, ob = rr * 64 + cc * 2; return st * 1024 + (ob ^ (((ob >> 9) & 1) << 5)); }
__host__ __device__ __forceinline__ void stage_rc(int b, int& R, int& C) { const int st = b / 1024, sb = b % 1024, swz = sb ^ (((sb >> 9) & 1) << 5); R = (st >> 1) * 16 + swz / 64; C = (st & 1) * 32 + (swz % 64) / 2; }
__host__ __device__ __forceinline__ int perm32(int rho) { const int n = rho >> 4, i = rho & 15; return 8 * (i >> 2) + 4 * n + (i & 3); }

struct Unit { int pm, pn; };
struct Gemm { const bf16_t* A; const bf16_t* Bt; int M, N, K; };

struct StaticOrder {
    int nM, nN, nwg, G, c;
    __host__ __device__ void init(int M, int N, int G_, int c_) { nM = M / BM; nN = N / BM; nwg = nM * nN; G = G_; c = c_; }
    __host__ __device__ bool next(int i, Unit& u) const {
        const long L = (long)i * G + c; if (L >= nwg) return false;
        int wgid = (int)L; { const int q = nwg / NXCD, r = nwg % NXCD, xcd = wgid % NXCD, off = wgid / NXCD; wgid = (xcd < r ? xcd * (q + 1) : r * (q + 1) + (xcd - r) * q) + off; }
        const int nig = WGM * nN, gid = wgid / nig, fm = gid * WGM, gsz = (nM - fm) < WGM ? (nM - fm) : WGM;
        u.pm = fm + ((wgid % nig) % gsz); u.pn = (wgid % nig) / gsz; return true;
    }
    __device__ __forceinline__ void a_ready(const Unit&) const {}
    __device__ __forceinline__ void done(const Unit&) const {}
};

__device__ __forceinline__ unsigned cvt_pk_bf16(float lo, float hi) { unsigned r; asm volatile("v_cvt_pk_bf16_f32 %0, %1, %2" : "=v"(r) : "v"(lo), "v"(hi)); return r; }
template <class Epi, class Sched, bool ALIGN_EPI = false, bool SP2 = false>
__device__ __forceinline__ void gemm_phase(PG8_LAS unsigned char* lds, const Gemm g, const Sched& S, const Epi& E) {
    int tid_ = threadIdx.x; asm volatile("" : "+v"(tid_));
    const int tid = tid_, wid = __builtin_amdgcn_readfirstlane(tid >> 6), lane = tid & 63, wr = wid >> 2, wc = wid & 3, fr = lane & 15, fq = lane >> 4;
    const int K = g.K, nt = K / BK;
    unsigned voffA[2], voffB[2];
#pragma unroll
    for (int i = 0; i < 2; ++i) { int R, C; stage_rc(tid * 16 + i * 8192, R, C); const int Rb = Epi::PERM ? ((R & ~31) + perm32(R & 31)) : R;
        voffA[i] = (unsigned)(R * K + C) * 2u; voffB[i] = (unsigned)(Rb * K + C) * 2u; }
    const size_t kstep = (size_t)(BK * 2);
    const size_t hstep = (size_t)HALF * K * 2;
    const size_t tstep = 2 * hstep;
    const unsigned ldsw = (unsigned)wid * 1024u;
    const int aoff = lds_byte(wr * 64 + fr, fq * 8), boff = lds_byte(wc * 32 + fr, fq * 8);
#define PG8_SA(b, h) (((b) * 2 + (h)) * HTB)
#define PG8_SB(b, h) ((4 + (b) * 2 + (h)) * HTB)
#define PG8_STAGE(bufoff, gbase, voff) do { _Pragma("unroll") for (int _i = 0; _i < 2; ++_i) \
        __builtin_amdgcn_global_load_lds((const unsigned*)((const char*)(gbase) + (voff)[_i]), (PG8_LAS unsigned*)(lds + (bufoff) + ldsw + _i * 8192), 16, 0, 0); } while (0)
#define PG8_LDA(dst, b, h) do { _Pragma("unroll") for (int m = 0; m < 4; ++m) _Pragma("unroll") for (int k = 0; k < 2; ++k) dst[m][k] = *(const PG8_LAS bf16x8*)(lds + PG8_SA(b, h) + aoff + m * 2048 + k * 1024); } while (0)
#define PG8_LDB(dst, b, h) do { _Pragma("unroll") for (int n = 0; n < 2; ++n) _Pragma("unroll") for (int k = 0; k < 2; ++k) dst[n][k] = *(const PG8_LAS bf16x8*)(lds + PG8_SB(b, h) + boff + n * 2048 + k * 1024); } while (0)
#define PG8_MMA(ai, bj, At, Bt) do { __builtin_amdgcn_s_setprio(1); _Pragma("unroll") for (int m = 0; m < 4; ++m) _Pragma("unroll") for (int n = 0; n < 2; ++n) _Pragma("unroll") for (int k = 0; k < 2; ++k) \
        acc[ai][bj][m][n] = __builtin_amdgcn_mfma_f32_16x16x32_bf16(Bt[n][k], At[m][k], acc[ai][bj][m][n], 0, 0, 0); __builtin_amdgcn_s_setprio(0); } while (0)
#define PG8_WAIT_V(n) asm volatile("s_waitcnt vmcnt(" #n ")" ::: "memory")
#define PG8_WAIT_L(n) asm volatile("s_waitcnt lgkmcnt(" #n ")" ::: "memory")
#define PG8_BAR __builtin_amdgcn_s_barrier()
#define PG8_SCHED __builtin_amdgcn_sched_barrier(0)
    Unit cur, nxt; int ui = 0;
    if (!S.next(0, cur)) return;
    f32x4 acc[2][2][4][2];
#pragma unroll
    for (int a = 0; a < 2; ++a)
#pragma unroll
        for (int b = 0; b < 2; ++b)
#pragma unroll
            for (int m = 0; m < 4; ++m)
#pragma unroll
                for (int n = 0; n < 2; ++n) acc[a][b][m][n] = (f32x4){0.f, 0.f, 0.f, 0.f};
    bf16x8 At[4][2], B0[2][2], B1[2][2];
    const char* cA = (const char*)g.A + (size_t)cur.pm * tstep; const char* cB = (const char*)g.Bt + (size_t)cur.pn * tstep;
    S.a_ready(cur);
    if constexpr (SP2) {
        PG8_STAGE(PG8_SB(0, 0), cB, voffB); PG8_STAGE(PG8_SB(0, 1), cB + hstep, voffB); PG8_STAGE(PG8_SA(0, 0), cA, voffA); PG8_STAGE(PG8_SA(0, 1), cA + hstep, voffA);
        if (wr == 1) PG8_BAR;
        PG8_WAIT_V(2); PG8_BAR;
        PG8_STAGE(PG8_SB(1, 0), cB + kstep, voffB); PG8_STAGE(PG8_SA(1, 0), cA + kstep, voffA); PG8_STAGE(PG8_SB(1, 1), cB + hstep + kstep, voffB);
        PG8_WAIT_V(6); PG8_BAR;
    } else {
        PG8_STAGE(PG8_SB(0, 0), cB, voffB); PG8_STAGE(PG8_SA(0, 0), cA, voffA); PG8_STAGE(PG8_SB(0, 1), cB + hstep, voffB); PG8_STAGE(PG8_SA(0, 1), cA + hstep, voffA);
        if (wr == 1) PG8_BAR;
        PG8_WAIT_V(4); PG8_BAR;
        PG8_STAGE(PG8_SB(1, 0), cB + kstep, voffB); PG8_STAGE(PG8_SA(1, 0), cA + kstep, voffA); PG8_STAGE(PG8_SB(1, 1), cB + hstep + kstep, voffB);
        PG8_WAIT_V(6); PG8_BAR;
    }
    for (;;) {
        const bool has_next = S.next(ui + 1, nxt);
        const char* nA = has_next ? (const char*)g.A + (size_t)nxt.pm * tstep : cA; const char* nB = has_next ? (const char*)g.Bt + (size_t)nxt.pn * tstep : cB;
        for (int t = 0; t < nt; t += 2) {
            const bool last = (t == nt - 2);
            const char* a1 = cA + (size_t)(t + 1) * kstep;
            const char* a2 = last ? nA : cA + (size_t)(t + 2) * kstep; const char* b2 = last ? nB : cB + (size_t)(t + 2) * kstep;
            const char* a3 = a2 + kstep; const char* b3 = b2 + kstep;
            if (last && has_next) S.a_ready(nxt);
            if constexpr (SP2) {
            PG8_LDB(B0, 0, 0); PG8_LDB(B1, 0, 1); PG8_SCHED; PG8_LDA(At, 0, 0); PG8_STAGE(PG8_SA(1, 1), a1 + hstep, voffA);
            PG8_WAIT_V(8); PG8_WAIT_L(0); PG8_BAR; PG8_MMA(0, 0, At, B0); PG8_MMA(0, 1, At, B1); PG8_BAR; PG8_SCHED;
            PG8_LDA(At, 0, 1); PG8_STAGE(PG8_SB(0, 0), b2, voffB); PG8_STAGE(PG8_SB(0, 1), b2 + hstep, voffB); PG8_STAGE(PG8_SA(0, 0), a2, voffA);
            PG8_WAIT_V(8); PG8_WAIT_L(0); PG8_BAR; PG8_MMA(1, 0, At, B0); PG8_MMA(1, 1, At, B1); PG8_BAR; PG8_SCHED;
            PG8_LDB(B0, 1, 0); PG8_LDB(B1, 1, 1); PG8_SCHED; PG8_LDA(At, 1, 0); PG8_STAGE(PG8_SA(0, 1), a2 + hstep, voffA);
            PG8_WAIT_V(8); PG8_WAIT_L(0); PG8_BAR; PG8_MMA(0, 0, At, B0); PG8_MMA(0, 1, At, B1); PG8_BAR; PG8_SCHED;
            PG8_LDA(At, 1, 1); PG8_STAGE(PG8_SB(1, 0), b3, voffB); PG8_STAGE(PG8_SB(1, 1), b3 + hstep, voffB); PG8_STAGE(PG8_SA(1, 0), a3, voffA);
            PG8_WAIT_V(8); PG8_WAIT_L(0); PG8_BAR; PG8_MMA(1, 0, At, B0); PG8_MMA(1, 1, At, B1); PG8_BAR; PG8_SCHED;
            } else {
            PG8_LDB(B0, 0, 0); PG8_SCHED; PG8_LDA(At, 0, 0); PG8_STAGE(PG8_SA(1, 1), a1 + hstep, voffA);
            PG8_WAIT_L(8); PG8_BAR; PG8_WAIT_L(0); PG8_MMA(0, 0, At, B0); PG8_BAR; PG8_SCHED;
            PG8_LDB(B1, 0, 1); PG8_STAGE(PG8_SB(0, 0), b2, voffB);
            PG8_BAR; PG8_WAIT_L(0); PG8_MMA(0, 1, At, B1); PG8_BAR;
            PG8_LDA(At, 0, 1); PG8_STAGE(PG8_SA(0, 0), a2, voffA);
            PG8_BAR; PG8_WAIT_L(0); PG8_MMA(1, 0, At, B0); PG8_BAR; PG8_SCHED;
            PG8_STAGE(PG8_SB(0, 1), b2 + hstep, voffB);
            PG8_WAIT_V(6); PG8_BAR; PG8_MMA(1, 1, At, B1); PG8_BAR;
            PG8_LDB(B0, 1, 0); PG8_SCHED; PG8_LDA(At, 1, 0); PG8_STAGE(PG8_SA(0, 1), a2 + hstep, voffA);
            PG8_WAIT_L(8); PG8_BAR; PG8_WAIT_L(0); PG8_MMA(0, 0, At, B0); PG8_BAR; PG8_SCHED;
            PG8_LDB(B1, 1, 1); PG8_STAGE(PG8_SB(1, 0), b3, voffB);
            PG8_BAR; PG8_WAIT_L(0); PG8_MMA(0, 1, At, B1); PG8_BAR;
            PG8_LDA(At, 1, 1); PG8_STAGE(PG8_SA(1, 0), a3, voffA);
            PG8_BAR; PG8_WAIT_L(0); PG8_MMA(1, 0, At, B0); PG8_BAR; PG8_SCHED;
            PG8_STAGE(PG8_SB(1, 1), b3 + hstep, voffB);
            PG8_WAIT_V(6); PG8_BAR; PG8_MMA(1, 1, At, B1); PG8_BAR;
            }
        }
        if constexpr (ALIGN_EPI) { if (wr == 0) PG8_BAR; }
        if constexpr (!Epi::AFTER_DRAIN) { E(acc, cur, wr, wc, fr, fq); S.done(cur); }
        if (!has_next) break;
#pragma unroll
        for (int a = 0; a < 2; ++a)
#pragma unroll
            for (int b = 0; b < 2; ++b)
#pragma unroll
                for (int m = 0; m < 4; ++m)
#pragma unroll
                    for (int n = 0; n < 2; ++n) acc[a][b][m][n] = (f32x4){0.f, 0.f, 0.f, 0.f};
        cur = nxt; cA = nA; cB = nB; ++ui;
        if constexpr (ALIGN_EPI) { if (wr == 1) PG8_BAR; }
    }
    PG8_WAIT_V(0);
    if constexpr (!ALIGN_EPI) { if (wr == 0) PG8_BAR; }
    PG8_BAR;
    if constexpr (Epi::AFTER_DRAIN) { E.fused(acc, cur, wr, wc, fr, fq, lds, wid, lane); S.done(cur); }
#undef PG8_SA
#undef PG8_SB
#undef PG8_STAGE
#undef PG8_LDA
#undef PG8_LDB
#undef PG8_MMA
#undef PG8_WAIT_V
#undef PG8_WAIT_L
#undef PG8_BAR
#undef PG8_SCHED
}
}

constexpr int BATCH = 8, SEQ = 2048, DM = 1024, M = BATCH * SEQ, FF = 2816, PLE = 256;
constexpr int NH = 16, HD = 64;
constexpr int N_IN0 = 3072, N_IN1 = 2608, N_IN1P = 2816, N_GU = 2 * FF;
constexpr float RMS_EPS = 1e-6f;
constexpr float LOG2E = 1.4426950408889634f;
constexpr float C2 = 0.125f * LOG2E;
constexpr int TABN = 2048;

constexpr size_t MiB = 1u << 20, KiB = 1u << 10;
constexpr size_t WS_CTL = 0, CTL_ZERO_BYTES = 2 * MiB;
constexpr size_t WS_SS = 256 * KiB;
constexpr size_t WS_KMEAN = 1280 * KiB;
constexpr size_t WS_W = 2 * MiB;
constexpr size_t WS_WIN0 = WS_W, WS_WOUT0 = WS_WIN0 + 6 * MiB, WS_WGU0 = WS_WOUT0 + 2 * MiB, WS_WD0 = WS_WGU0 + 11 * MiB,
                 WS_WPG0 = WS_WD0 + 5632 * KiB, WS_WPP0 = WS_WPG0 + 2 * MiB,
                 WS_WIN1 = WS_WPP0 + 512 * KiB, WS_WOUT1 = WS_WIN1 + 5632 * KiB, WS_WGU1 = WS_WOUT1 + 2 * MiB, WS_WD1 = WS_WGU1 + 11 * MiB,
                 WS_WPG1 = WS_WD1 + 5632 * KiB, WS_WPP1 = WS_WPG1 + 2 * MiB,
                 WS_CW1K = WS_WPP1 + 512 * KiB, WS_CW1V = WS_CW1K + 512 * KiB, WS_CW2K = WS_CW1V + 512 * KiB, WS_CW2V = WS_CW2K + 16 * KiB,
                 WS_WEND = WS_CW2V + 16 * KiB;
static_assert(WS_WEND <= 58 * MiB, "weights");
constexpr size_t WS_MISC = 58 * MiB;
constexpr size_t WS_BIASD = WS_MISC;
constexpr size_t WS_CB1 = WS_MISC + 128 * KiB;
constexpr size_t WS_GN = WS_MISC + 192 * KiB;
constexpr size_t WS_KC = WS_MISC + 256 * KiB, WS_VC = WS_KC + 512 * KiB;
constexpr size_t WS_HB = 60 * MiB;
constexpr size_t WS_PP = 92 * MiB;
constexpr size_t WS_O = 124 * MiB;
constexpr size_t WS_QKV = 156 * MiB;
constexpr size_t WS_Q = WS_QKV, WS_K0 = WS_QKV + 32 * MiB, WS_V0 = WS_QKV + 64 * MiB;
constexpr size_t WS_KV1 = WS_QKV + 32 * MiB;
constexpr size_t WS_HID = WS_QKV;
constexpr size_t WS_PB1 = WS_QKV + 88 * MiB;
constexpr size_t WS_PB0 = WS_O;
constexpr size_t WS_GATES = 252 * MiB;
constexpr size_t WS_END = 256 * MiB;
static_assert(WS_QKV + 96 * MiB <= WS_GATES && WS_GATES + 3 * MiB <= WS_END, "ws map");

constexpr int CW_BAR = 4096;

constexpr int WAVE_LDS = 16384;
constexpr int TAB0_OFF = 131072;
constexpr int KM_OFF = TAB0_OFF + 12288;
constexpr int TAB1_OFF = 100608;
constexpr int MISC_OFF = 146432;
constexpr int LDS_BYTES = MISC_OFF + 512;
static_assert(LDS_BYTES <= 163840 && KM_OFF + 2048 <= MISC_OFF && TAB1_OFF + (4 * 2112 + 4 * 704) * 4 <= MISC_OFF, "LDS map");

#define GAS __attribute__((address_space(1)))
#define LAS __attribute__((address_space(3)))
typedef unsigned short bf16;
typedef float f32x4 __attribute__((ext_vector_type(4)));
typedef float f32x16 __attribute__((ext_vector_type(16)));
typedef short bf16x8 __attribute__((ext_vector_type(8)));
typedef unsigned u32x4 __attribute__((ext_vector_type(4)));
typedef unsigned u32x2 __attribute__((ext_vector_type(2)));
typedef GAS unsigned gu32;

__device__ __forceinline__ unsigned f2bf(float f) { unsigned u = __builtin_bit_cast(unsigned, f); return (u + 0x7fffu + ((u >> 16) & 1u)) >> 16; }
__device__ __forceinline__ unsigned pk2(float lo, float hi) { return f2bf(lo) | (f2bf(hi) << 16); }
__device__ __forceinline__ float bf2f(unsigned short h) { return __builtin_bit_cast(float, (unsigned)h << 16); }
typedef float f32x2_t __attribute__((ext_vector_type(2))); typedef __bf16 bf16x2_t __attribute__((ext_vector_type(2)));
__device__ __forceinline__ unsigned cvtpk(float lo, float hi) { f32x2_t v = {lo, hi}; bf16x2_t b = __builtin_convertvector(v, bf16x2_t); return __builtin_bit_cast(unsigned, b); }
__device__ __forceinline__ float fast_exp2(float x) { return __builtin_amdgcn_exp2f(x); }
__device__ __forceinline__ float fast_rcp(float x) { return __builtin_amdgcn_rcpf(x); }
__device__ __forceinline__ float sigmoidf_(float x) { return fast_rcp(1.0f + fast_exp2(-x * LOG2E)); }

using pg8::Unit;
typedef float accf4 __attribute__((ext_vector_type(4)));
#define EPI_ARGS const accf4 (&acc)[2][2][4][2], const Unit& u, int wr, int wc, int fr_in, int fq_in
#define EPI_OPAQUE int fr = fr_in, fq = fq_in; asm volatile("" : "+v"(fr), "+v"(fq));
typedef unsigned long long ss_t;
constexpr float SS_SCALE = 16777216.0f;
__device__ __forceinline__ float rstd_row(const ss_t* ss, int row) { return rsqrtf((float)ss[row] * (1.0f / (SS_SCALE * DM)) + RMS_EPS); }

struct EpiStoreBf16 {
    static constexpr bool PERM = true, AFTER_DRAIN = false;
    bf16* O; int ldc;
    __device__ __forceinline__ void operator()(EPI_ARGS) const {
        EPI_OPAQUE
        const int row0 = u.pm * 256 + wr * 64 + fr, col0 = u.pn * 256 + wc * 32 + 8 * fq;
#pragma unroll
        for (int ai = 0; ai < 2; ++ai)
#pragma unroll
            for (int m = 0; m < 4; ++m) { bf16* rowp = O + (size_t)(row0 + ai * 128 + m * 16) * ldc + col0;
#pragma unroll
                for (int bj = 0; bj < 2; ++bj) { const accf4 v0 = acc[ai][bj][m][0], v1 = acc[ai][bj][m][1];
                    u32x4 w; w.x = cvtpk(v0[0], v0[1]); w.y = cvtpk(v0[2], v0[3]); w.z = cvtpk(v1[0], v1[1]); w.w = cvtpk(v1[2], v1[3]);
                    *(u32x4*)(rowp + bj * 128) = w; } }
    }
};

template <int MODE> struct EpiResid {
    static constexpr bool PERM = true, AFTER_DRAIN = false;
    const float* base; float* out; bf16* hb; ss_t* ss_out; const ss_t* ss_in; const bf16* pp;
    __device__ __forceinline__ void operator()(EPI_ARGS) const {
        EPI_OPAQUE
        const int row0 = u.pm * 256 + wr * 64 + fr, col0 = u.pn * 256 + wc * 32 + 8 * fq;
#pragma unroll
        for (int ai = 0; ai < 2; ++ai)
#pragma unroll
            for (int m = 0; m < 4; ++m) {
                const int row = row0 + ai * 128 + m * 16; const size_t off = (size_t)row * DM + col0;
                float rs = 1.f; if (MODE == 1) rs = rstd_row(ss_in, row);
                float sq = 0.f;
#pragma unroll
                for (int bj = 0; bj < 2; ++bj) {
                    accf4 v0 = acc[ai][bj][m][0], v1 = acc[ai][bj][m][1];
                    const f32x4 b0 = *(const f32x4*)(base + off + bj * 128), b1 = *(const f32x4*)(base + off + bj * 128 + 4);
                    if (MODE == 1) {
                        const u32x4 pw = *(const u32x4*)(pp + off + bj * 128);
                        const float p[8] = {__builtin_bit_cast(float, pw.x << 16), __builtin_bit_cast(float, pw.x & 0xffff0000u), __builtin_bit_cast(float, pw.y << 16), __builtin_bit_cast(float, pw.y & 0xffff0000u),
                                            __builtin_bit_cast(float, pw.z << 16), __builtin_bit_cast(float, pw.z & 0xffff0000u), __builtin_bit_cast(float, pw.w << 16), __builtin_bit_cast(float, pw.w & 0xffff0000u)};
#pragma unroll
                        for (int i = 0; i < 4; ++i) { v0[i] = sigmoidf_(v0[i] * rs) * p[i]; v1[i] = sigmoidf_(v1[i] * rs) * p[4 + i]; }
                    }
                    const f32x4 h0 = b0 + v0, h1 = b1 + v1;
                    *(f32x4*)(out + off + bj * 128) = h0; *(f32x4*)(out + off + bj * 128 + 4) = h1;
                    u32x4 w; w.x = cvtpk(h0[0], h0[1]); w.y = cvtpk(h0[2], h0[3]); w.z = cvtpk(h1[0], h1[1]); w.w = cvtpk(h1[2], h1[3]);
                    *(u32x4*)(hb + off + bj * 128) = w;
                    sq += (h0[0] * h0[0] + h0[1] * h0[1]) + (h0[2] * h0[2] + h0[3] * h0[3]) + (h1[0] * h1[0] + h1[1] * h1[1]) + (h1[2] * h1[2] + h1[3] * h1[3]);
                }
                sq += __shfl_xor(sq, 16); sq += __shfl_xor(sq, 32);
                if (ss_out && fq == 0) atomicAdd(ss_out + row, (ss_t)(sq * SS_SCALE));
            }
    }
};

struct EpiSwiglu {
    static constexpr bool PERM = true, AFTER_DRAIN = false;
    bf16* hid; const ss_t* ss_in;
    __device__ __forceinline__ void operator()(EPI_ARGS) const {
        EPI_OPAQUE
        const int row0 = u.pm * 256 + wr * 64 + fr, col0 = u.pn * 128 + wc * 32 + 8 * fq;
#pragma unroll
        for (int ai = 0; ai < 2; ++ai)
#pragma unroll
            for (int m = 0; m < 4; ++m) {
                const int row = row0 + ai * 128 + m * 16; const float rs = rstd_row(ss_in, row);
                float r[8];
#pragma unroll
                for (int n = 0; n < 2; ++n)
#pragma unroll
                    for (int i = 0; i < 4; ++i) { const float g = acc[ai][0][m][n][i] * rs, uu = acc[ai][1][m][n][i] * rs; r[4 * n + i] = g * sigmoidf_(g) * uu; }
                u32x4 w; w.x = cvtpk(r[0], r[1]); w.y = cvtpk(r[2], r[3]); w.z = cvtpk(r[4], r[5]); w.w = cvtpk(r[6], r[7]);
                *(u32x4*)(hid + (size_t)row * FF + col0) = w;
            }
    }
};

template <int LAYER> struct EpiInProj {
    static constexpr bool PERM = true, AFTER_DRAIN = false;
    const ss_t* ss_in; bf16* Q;
    const float* gains;
    float* kmean; float* gates;
    __device__ __forceinline__ void operator()(EPI_ARGS) const {
        EPI_OPAQUE
        const int pn = u.pn;
        const float* gain = gains; bool has_gain = false; bf16* dst = Q; int head, nheads; bool do_km = false;
        if (LAYER == 0) {
            const int t6 = pn >> 1, type = t6 % 3, grp = t6 / 3;
            head = grp * 8 + (pn & 1) * 4 + wc; nheads = 16;
            dst = Q + (size_t)type * ((size_t)M * DM);
            has_gain = type < 2; gain = gains + 64 * (grp * 2 + (type & 1)); do_km = (type == 1 && grp == 0);
        } else {
            if (pn < 4) { head = pn * 4 + wc; nheads = 16; has_gain = true; gain = gains + 64 * 4; }
            else { head = wc; nheads = 4; dst = Q + (size_t)M * DM + (size_t)(pn - 4) * ((size_t)BATCH * 4 * SEQ * HD); has_gain = (pn == 6) || (pn == 8); gain = gains + 64 * (pn == 6 ? 5 : 6); }
        }
        const int row0 = u.pm * 256 + wr * 64 + fr;
        if (LAYER == 1 && pn == 10) {
            if (wc == 0) {
#pragma unroll
                for (int ai = 0; ai < 2; ++ai)
#pragma unroll
                    for (int m = 0; m < 4; ++m) { const int row = row0 + ai * 128 + m * 16; const float rs = rstd_row(ss_in, row);
#pragma unroll
                        for (int bj = 0; bj < 2; ++bj) { const int j0 = 32 * bj + 8 * fq;
                            if (j0 < 48) { const accf4 v0 = acc[ai][bj][m][0], v1 = acc[ai][bj][m][1];
                                f32x4 g0, g1;
#pragma unroll
                                for (int i = 0; i < 4; ++i) { g0[i] = sigmoidf_(v0[i] * rs); g1[i] = sigmoidf_(v1[i] * rs); }
                                *(f32x4*)(gates + (size_t)row * 48 + j0) = g0; *(f32x4*)(gates + (size_t)row * 48 + j0 + 4) = g1; } } }
            }
            return;
        }
        float ksum[2][2][4];
#pragma unroll
        for (int bj = 0; bj < 2; ++bj)
#pragma unroll
            for (int n = 0; n < 2; ++n)
#pragma unroll
                for (int i = 0; i < 4; ++i) ksum[bj][n][i] = 0.f;
#pragma unroll
        for (int ai = 0; ai < 2; ++ai)
#pragma unroll
            for (int m = 0; m < 4; ++m) {
                const int row = row0 + ai * 128 + m * 16, b = row >> 11, s = row & (SEQ - 1); const float rs = rstd_row(ss_in, row);
                float v[2][2][4]; float sq = 0.f;
#pragma unroll
                for (int bj = 0; bj < 2; ++bj)
#pragma unroll
                    for (int n = 0; n < 2; ++n)
#pragma unroll
                        for (int i = 0; i < 4; ++i) { v[bj][n][i] = acc[ai][bj][m][n][i] * rs; sq += v[bj][n][i] * v[bj][n][i]; }
                if (has_gain) {
                    sq += __shfl_xor(sq, 16); sq += __shfl_xor(sq, 32);
                    const float r2 = rsqrtf(sq * (1.0f / HD) + RMS_EPS);
#pragma unroll
                    for (int bj = 0; bj < 2; ++bj)
#pragma unroll
                        for (int n = 0; n < 2; ++n) { const f32x4 gq = *(const f32x4*)(gain + 32 * bj + 8 * fq + 4 * n);
#pragma unroll
                            for (int i = 0; i < 4; ++i) v[bj][n][i] = v[bj][n][i] * r2 * gq[i]; }
                }
                if (LAYER == 0 && do_km) {
#pragma unroll
                    for (int bj = 0; bj < 2; ++bj)
#pragma unroll
                        for (int n = 0; n < 2; ++n)
#pragma unroll
                            for (int i = 0; i < 4; ++i) ksum[bj][n][i] += v[bj][n][i];
                }
                bf16* rowp = dst + ((size_t)(b * nheads + head) * SEQ + s) * HD + 8 * fq;
#pragma unroll
                for (int bj = 0; bj < 2; ++bj) { u32x4 w; w.x = cvtpk(v[bj][0][0], v[bj][0][1]); w.y = cvtpk(v[bj][0][2], v[bj][0][3]); w.z = cvtpk(v[bj][1][0], v[bj][1][1]); w.w = cvtpk(v[bj][1][2], v[bj][1][3]);
                    *(u32x4*)(rowp + 32 * bj) = w; }
                asm volatile("" ::: "memory");
            }
        if (LAYER == 0 && do_km) {
            const int b = u.pm >> 3, blk = u.pm & 7;
            float* kp = kmean + ((size_t)((b * 8 + head) * 8 + blk)) * HD + 8 * fq;
#pragma unroll
            for (int bj = 0; bj < 2; ++bj)
#pragma unroll
                for (int n = 0; n < 2; ++n)
#pragma unroll
                    for (int i = 0; i < 4; ++i) { float s = ksum[bj][n][i];
                        s += __shfl_xor(s, 1); s += __shfl_xor(s, 2); s += __shfl_xor(s, 4); s += __shfl_xor(s, 8);
                        if (fr == 0) atomicAdd(kp + 32 * bj + 4 * n + i, s); }
        }
    }
};
#define XB_TMO      128
#define XB_XCNT(j)  (256  + 64 * (j))
#define XB_XSUB(j)  (1280 + 64 * (j))
#define XB_XGEN(j)  (2304 + 64 * (j))
#define XB_TOP      3328
#define XB_TOPGEN   3392
#define XCD_BAR_WORDS 3456
#define XB_SPIN_CAP (1u << 18)

__device__ __forceinline__ unsigned xb_ld(unsigned* p)              { return __hip_atomic_load(p, __ATOMIC_RELAXED, __HIP_MEMORY_SCOPE_AGENT); }
__device__ __forceinline__ unsigned xb_add(unsigned* p, unsigned v) { return __hip_atomic_fetch_add(p, v, __ATOMIC_RELAXED, __HIP_MEMORY_SCOPE_AGENT); }
__device__ __forceinline__ unsigned xb_xcc_id() { return (unsigned)__builtin_amdgcn_s_getreg((3 << 11) | 20) & 0xFu; }
#define XB_SPIN(cond, bar) do { unsigned _sp = 0; while (cond) { __builtin_amdgcn_s_sleep(1); \
    if ((++_sp & 255u) == 0u) { if (xb_ld(&(bar)[XB_TMO])) break; if (_sp > XB_SPIN_CAP) { atomicAdd(&(bar)[XB_TMO], 1u); break; } } } } while (0)

struct XcdBarrier {
    unsigned* bar; unsigned x;
    volatile LAS unsigned* st;
};

__device__ __forceinline__ XcdBarrier xcd_barrier_post(unsigned* bar, volatile LAS unsigned* st) {
    XcdBarrier b; b.bar = bar; b.x = xb_xcc_id(); b.st = st;
    if (threadIdx.x == 0) (void)xb_add(&bar[XB_XCNT(b.x)], 1u);
    return b;
}
__device__ __forceinline__ void xcd_barrier_complete(unsigned* bar, unsigned x, unsigned& nloc, unsigned& nx) {
    const unsigned G = gridDim.x * gridDim.y * gridDim.z;
    unsigned sum, cnt, mine, sp = 0u;
    for (;;) {
        sum = 0u; cnt = 0u; mine = 0u;
#pragma unroll
        for (unsigned j = 0; j < 16; ++j) { const unsigned c = xb_ld(&bar[XB_XCNT(j)]); sum += c; cnt += (c > 0u) ? 1u : 0u; mine = (j == x) ? c : mine; }
        if (sum == G) break;
        __builtin_amdgcn_s_sleep(1);
        if ((++sp & 255u) == 0u) { if (xb_ld(&bar[XB_TMO])) break; if (sp > XB_SPIN_CAP) { atomicAdd(&bar[XB_TMO], 1u); break; } }
    }
    nloc = mine > 0u ? mine : 1u; nx = cnt > 0u ? cnt : 1u;
}

__device__ __forceinline__ void xcd_barrier(const XcdBarrier& b) {
    asm volatile("s_waitcnt vmcnt(0)" ::: "memory");
    __syncthreads();
    if (threadIdx.x == 0) {
        unsigned* bar = b.bar;
        __builtin_amdgcn_s_waitcnt(0);
        unsigned nloc = b.st[0], nx = b.st[1];
        if (nloc == 0u) { xcd_barrier_complete(bar, b.x, nloc, nx); b.st[0] = nloc; b.st[1] = nx; }
        const unsigned old = xb_add(&bar[XB_XSUB(b.x)], 1u);
        const unsigned gen = old / nloc;
        if (old + 1u == (gen + 1u) * nloc) {
            __builtin_amdgcn_fence(__ATOMIC_RELEASE, "agent");
            asm volatile("s_waitcnt vmcnt(0)" ::: "memory");
            const unsigned og = xb_add(&bar[XB_TOP], 1u);
            const unsigned tg = og / nx;
            if (og + 1u == (tg + 1u) * nx) xb_add(&bar[XB_TOPGEN], 1u);
            else XB_SPIN(xb_ld(&bar[XB_TOPGEN]) == tg, bar);
            __builtin_amdgcn_fence(__ATOMIC_ACQUIRE, "agent");
            xb_add(&bar[XB_XGEN(b.x)], 1u);
            asm volatile("s_waitcnt vmcnt(0)" ::: "memory");
        } else {
            XB_SPIN(xb_ld(&bar[XB_XGEN(b.x)]) == gen, bar);
            __builtin_amdgcn_fence(__ATOMIC_ACQUIRE, "agent");
            asm volatile("s_waitcnt vmcnt(0)" ::: "memory");
        }
    }
    __syncthreads();
}

__device__ __forceinline__ int crow(int r, int hi) { return (r & 3) + 8 * (r >> 2) + 4 * hi; }
__device__ __forceinline__ void glds16(const void* gsrc, unsigned lds_dst) { unsigned keep;
    asm volatile("s_mov_b32 %0, m0\n\ts_mov_b32 m0, %2\n\ts_nop 0\n\tglobal_load_lds_dwordx4 %1, off\n\ts_mov_b32 m0, %0" : "=&s"(keep) : "v"(gsrc), "s"(lds_dst) : "memory"); }
typedef short v4i16_t __attribute__((ext_vector_type(4)));
typedef LAS const char* lds_cptr;
__device__ __forceinline__ v4i16_t vtr(lds_cptr p) { return __builtin_amdgcn_ds_read_tr16_b64_v4i16((LAS v4i16_t*)p); }
constexpr int TILE_B = 16384;
constexpr float THR = 8.0f;
__device__ __forceinline__ int clampi(int v, int lo, int hi) { return v < lo ? lo : (v > hi ? hi : v); }

struct WCtx { int lane, r32, hi; unsigned lds0; lds_cptr ldsp; unsigned koff, voff; };
__device__ __forceinline__ WCtx make_ctx(LAS unsigned char* L) {
    int lane = threadIdx.x & 63; asm volatile("" : "+v"(lane));
    WCtx c; c.lane = lane; c.r32 = lane & 31; c.hi = lane >> 5; c.ldsp = (lds_cptr)L; c.lds0 = (unsigned)(uintptr_t)((unsigned char*)L);
    c.koff = c.r32 * 128 + (((c.r32 & 7) ^ c.hi) << 4);
    const int q = (lane & 15) >> 2, p = lane & 3, g1 = (lane >> 4) & 1;
    c.voff = 8192 + (4 * c.hi + q) * 128 + ((((g1 << 1) | (p >> 1)) ^ ((q >> 1) << 2)) << 4) + (p & 1) * 8;
    return c;
}
__device__ __forceinline__ void issue_piece(const WCtx& c, const bf16* Kb, const bf16* Vb, unsigned rowidx, unsigned tile_lds, int pc) {
    const unsigned cch = c.lane & 7, rl = c.lane >> 3;
    unsigned ko = rowidx * 128u + ((cch ^ rl) << 4); asm volatile("" : "+v"(ko));
    unsigned vo = rowidx * 128u + ((cch ^ (((rl >> 1) & 1) << 2)) << 4); asm volatile("" : "+v"(vo));
    glds16((const char*)Kb + ko, (unsigned)__builtin_amdgcn_readfirstlane(tile_lds + pc * 1024));
    glds16((const char*)Vb + vo, (unsigned)__builtin_amdgcn_readfirstlane(tile_lds + 8192 + pc * 1024));
}
__device__ __forceinline__ void vm_wait0() { asm volatile("s_waitcnt vmcnt(0)" ::: "memory"); }
__device__ __forceinline__ void lgkm_wait0() { asm volatile("s_waitcnt lgkmcnt(0)" ::: "memory"); }

__device__ __forceinline__ void tile_qk(const WCtx& c, lds_cptr kt, const bf16x8 (&qr)[4], f32x16& p0, f32x16& p1) {
#pragma unroll
    for (int d0 = 0; d0 < 4; ++d0) {
        const unsigned off = c.koff ^ (d0 << 5);
        const bf16x8 b0 = *(LAS const bf16x8*)(kt + off), b1 = *(LAS const bf16x8*)(kt + off + 4096);
        p0 = __builtin_amdgcn_mfma_f32_32x32x16_bf16(b0, qr[d0], p0, 0, 0, 0);
        p1 = __builtin_amdgcn_mfma_f32_32x32x16_bf16(b1, qr[d0], p1, 0, 0, 0);
    }
}
__device__ __forceinline__ void tile_pv(const WCtx& c, lds_cptr vt, f32x16& o0, f32x16& o1, const f32x16& p0, const f32x16& p1) {
    u32x4 pw[4];
#pragma unroll
    for (int k = 0; k < 2; ++k) {
        pw[k]     = (u32x4){cvtpk(p0[8 * k], p0[8 * k + 1]), cvtpk(p0[8 * k + 2], p0[8 * k + 3]), cvtpk(p0[8 * k + 4], p0[8 * k + 5]), cvtpk(p0[8 * k + 6], p0[8 * k + 7])};
        pw[2 + k] = (u32x4){cvtpk(p1[8 * k], p1[8 * k + 1]), cvtpk(p1[8 * k + 2], p1[8 * k + 3]), cvtpk(p1[8 * k + 4], p1[8 * k + 5]), cvtpk(p1[8 * k + 6], p1[8 * k + 7])};
    }
    lds_cptr v0p = vt + c.voff, v1p = vt + (c.voff ^ 64u);
#pragma unroll
    for (int ks = 0; ks < 4; ++ks) {
        const v4i16_t l0 = vtr(v0p + ks * 2048), h0 = vtr(v0p + ks * 2048 + 1024), l1 = vtr(v1p + ks * 2048), h1 = vtr(v1p + ks * 2048 + 1024);
        const bf16x8 v0 = (bf16x8){l0[0], l0[1], l0[2], l0[3], h0[0], h0[1], h0[2], h0[3]};
        const bf16x8 v1 = (bf16x8){l1[0], l1[1], l1[2], l1[3], h1[0], h1[1], h1[2], h1[3]};
        const bf16x8 pf = __builtin_bit_cast(bf16x8, pw[ks]);
        o0 = __builtin_amdgcn_mfma_f32_32x32x16_bf16(v0, pf, o0, 0, 0, 0);
        o1 = __builtin_amdgcn_mfma_f32_32x32x16_bf16(v1, pf, o1, 0, 0, 0);
        asm volatile("" ::: "memory");
    }
}
struct AState { f32x16 o0, o1; float mhat, l, negc; };
__device__ __forceinline__ void astate_init(AState& s) {
#pragma unroll
    for (int r = 0; r < 16; ++r) { s.o0[r] = 0.f; s.o1[r] = 0.f; }
    s.mhat = 0.f; s.l = 0.f; s.negc = 0.f;
}
template <class BiasF> __device__ __forceinline__ void tile_step(const WCtx& c, unsigned tile, AState& st, const bf16x8 (&qr)[4], BiasF biasf) {
    f32x16 p0, p1;
#pragma unroll
    for (int r = 0; r < 16; ++r) { p0[r] = st.negc; p1[r] = st.negc; }
    tile_qk(c, c.ldsp + tile, qr, p0, p1);
    float rm = -INFINITY;
#pragma unroll
    for (int r = 0; r < 16; ++r) { p0[r] = __builtin_fmaf(p0[r], C2, biasf(r, 0)); rm = fmaxf(rm, p0[r]); }
#pragma unroll
    for (int r = 0; r < 16; ++r) { p1[r] = __builtin_fmaf(p1[r], C2, biasf(r, 1)); rm = fmaxf(rm, p1[r]); }
    rm = fmaxf(rm, __shfl_xor(rm, 32));
    if (__any(rm > THR)) {
        const float dl = fmaxf(rm, 0.f);
        st.mhat += dl; st.negc = -st.mhat * (1.0f / C2);
        const float f = fast_exp2(-dl);
        st.l *= f;
#pragma unroll
        for (int r = 0; r < 16; ++r) { p0[r] -= dl; p1[r] -= dl; st.o0[r] *= f; st.o1[r] *= f; }
    }
    float sum = 0.f;
#pragma unroll
    for (int r = 0; r < 16; ++r) { p0[r] = fast_exp2(p0[r]); p1[r] = fast_exp2(p1[r]); sum += p0[r] + p1[r]; }
    st.l += sum;
    tile_pv(c, c.ldsp + tile, st.o0, st.o1, p0, p1);
}
#define FAST_BIAS(P0) [&](int r, int half) { return (P0)[63 - ((r & 3) + 8 * (r >> 2)) - 32 * half]; }
__device__ __forceinline__ void astate_fold(const AState& st, float w, f32x16& a0, f32x16& a1) {
    const float lt = st.l + __shfl_xor(st.l, 32);
    const float sc = lt > 0.f ? w / lt : 0.f;
#pragma unroll
    for (int r = 0; r < 16; ++r) { a0[r] += st.o0[r] * sc; a1[r] += st.o1[r] * sc; }
}
__device__ __forceinline__ void store_o(const WCtx& c, bf16* orow, const f32x16& a0, const f32x16& a1) {
#pragma unroll
    for (int g = 0; g < 4; ++g) {
        u32x2 w0, w1; w0.x = cvtpk(a0[4 * g], a0[4 * g + 1]); w0.y = cvtpk(a0[4 * g + 2], a0[4 * g + 3]); w1.x = cvtpk(a1[4 * g], a1[4 * g + 1]); w1.y = cvtpk(a1[4 * g + 2], a1[4 * g + 3]);
        *(u32x2*)(orow + 8 * g + 4 * c.hi) = w0; *(u32x2*)(orow + 32 + 8 * g + 4 * c.hi) = w1;
    }
}
__device__ __forceinline__ void load_q(bf16x8 (&qr)[4], const bf16* qrow, int hi) {
#pragma unroll
    for (int d0 = 0; d0 < 4; ++d0) qr[d0] = *(const bf16x8*)(qrow + d0 * 16 + hi * 8);
}
__device__ __forceinline__ unsigned wave_or(unsigned v) {
#pragma unroll
    for (int o = 1; o < 64; o <<= 1) v |= __shfl_xor(v, o);
    return v;
}
__device__ __forceinline__ void build_tab(LAS float* tab, const float* biasd_h, int n, int maxd, int tid) {
    for (int i = tid; i < n; i += 512) { const int d = i - 64; tab[i] = (d < 0 || d > maxd) ? -INFINITY : biasd_h[d]; }
}

constexpr int UW_OFF = 32768;
__device__ __forceinline__ void moba_unit(LAS unsigned char* L_, int wid, int b, int h, int j, const bf16* Q, const bf16* K, const bf16* V, bf16* O, LAS const float* tab, LAS const float* km) {
    const WCtx c = make_ctx(L_);
    const size_t hb = (size_t)(b * NH + h) * SEQ;
    const bf16* Kb = K + hb * HD; const bf16* Vb = V + hb * HD;
    const int t0 = 256 * j + 32 * wid, tq = t0 + c.r32;
    const bf16* qrow = Q + (hb + tq) * HD;
    bf16x8 qr[4]; load_q(qr, qrow, c.hi);
    unsigned sel = 0u;
    if (j > 0) {
        float g4[4] = {0.f, 0.f, 0.f, 0.f};
#pragma unroll
        for (int ch = 0; ch < 8; ++ch) {
            const u32x4 qq = *(const u32x4*)(qrow + 8 * ch);
            const float qf[8] = {__builtin_bit_cast(float, qq.x << 16), __builtin_bit_cast(float, qq.x & 0xffff0000u), __builtin_bit_cast(float, qq.y << 16), __builtin_bit_cast(float, qq.y & 0xffff0000u),
                                 __builtin_bit_cast(float, qq.z << 16), __builtin_bit_cast(float, qq.z & 0xffff0000u), __builtin_bit_cast(float, qq.w << 16), __builtin_bit_cast(float, qq.w & 0xffff0000u)};
#pragma unroll
            for (int k = 0; k < 4; ++k) { LAS const float* kr = km + (2 * k + c.hi) * 64 + 8 * ch;
                const f32x4 a = *(LAS const f32x4*)kr, bq = *(LAS const f32x4*)(kr + 4);
                g4[k] += (qf[0] * a[0] + qf[1] * a[1]) + (qf[2] * a[2] + qf[3] * a[3]) + (qf[4] * bq[0] + qf[5] * bq[1]) + (qf[6] * bq[2] + qf[7] * bq[3]); }
        }
        float ga[8];
#pragma unroll
        for (int k = 0; k < 4; ++k) { const float ot = __shfl_xor(g4[k], 32); ga[2 * k] = c.hi ? ot : g4[k]; ga[2 * k + 1] = c.hi ? g4[k] : ot; }
#pragma unroll
        for (int n = 0; n < 8; ++n) if (n >= j) ga[n] = -INFINITY;
#pragma unroll
        for (int n = 0; n < 8; ++n) { int rank = 0;
#pragma unroll
            for (int n2 = 0; n2 < 8; ++n2) if (n2 != n) rank += (n2 < n) ? (ga[n2] >= ga[n] ? 1 : 0) : (ga[n2] > ga[n] ? 1 : 0);
            if (rank < 3 && n < j) sel |= 1u << n; }
    }
    const unsigned wsel = wave_or(sel);
    LAS unsigned* UW = (LAS unsigned*)(L_ + UW_OFF);
    if (c.lane == 0) UW[wid] = wsel;
    __syncthreads();
    unsigned U = 0u;
#pragma unroll
    for (int w = 0; w < 8; ++w) U |= UW[w];
    U = __builtin_amdgcn_readfirstlane(U);
    AState st; astate_init(st);
    const int ntile = 4 + 4 * __builtin_popcount(U);
    int blk = j, kt = 0; unsigned rest = U; int slot = 0;
    issue_piece(c, Kb, Vb, (unsigned)(256 * blk + 64 * kt + 8 * wid + (c.lane >> 3)), c.lds0, wid);
    for (int it = 0; it < ntile; ++it) {
        int nblk = blk, nkt = kt + 1; unsigned nrest = rest;
        if (nkt == 4) { nkt = 0; nblk = __builtin_ctz(nrest | 0x80000000u); nrest &= nrest - 1; }
        vm_wait0(); __syncthreads();
        if (it + 1 < ntile) issue_piece(c, Kb, Vb, (unsigned)(256 * nblk + 64 * nkt + 8 * wid + (c.lane >> 3)), c.lds0 + (slot ^ 1) * TILE_B, wid);
        const int k0 = 256 * blk + 64 * kt;
        const bool own = (blk == j);
        const bool mine = own ? true : ((sel >> blk) & 1u);
        const bool active = own ? (kt <= (wid >> 1)) : ((wsel >> blk) & 1u);
        if (active) {
            LAS const float* P0 = mine ? tab + (tq - k0 + 1 - 4 * c.hi) : tab;
            tile_step(c, slot * TILE_B, st, qr, FAST_BIAS(P0));
        }
        blk = nblk; kt = nkt; rest = nrest; slot ^= 1;
    }
    f32x16 a0, a1;
#pragma unroll
    for (int r = 0; r < 16; ++r) { a0[r] = 0.f; a1[r] = 0.f; }
    astate_fold(st, 1.0f, a0, a1);
    store_o(c, O + ((size_t)b * SEQ + tq) * DM + h * HD, a0, a1);
    lgkm_wait0(); __syncthreads();
}

template <int R> __device__ __forceinline__ void dil_branch(const WCtx& c, unsigned tile, AState& st, const bf16x8 (&qr)[4], const bf16* Kb, const bf16* Vb, int t0, int tq, LAS const float* tb) {
    constexpr int maxd = 128 * R, top = maxd + 65;
    const int kbase = t0 - maxd;
    constexpr int ntile = (16 * 31 + maxd) / (64 * R) + 1;
#pragma unroll 1
    for (int kt = 0; kt < ntile; ++kt) {
        const int k0 = kbase + 64 * R * kt;
        if (k0 + 63 * R < 0) continue;
        lgkm_wait0();
#pragma unroll
        for (int pc = 0; pc < 8; ++pc) { const int kp = clampi(k0 + R * (8 * pc + (c.lane >> 3)), 0, SEQ - 1);
            issue_piece(c, Kb, Vb, (unsigned)kp, c.lds0 + tile, pc); }
        vm_wait0();
        int db = tq - k0 + 64 - 4 * R * c.hi; asm volatile("" : "+v"(db));
        if (k0 >= 0) {
            tile_step(c, tile, st, qr, [&](int rr, int half) { const int idx = db - R * ((rr & 3) + 8 * (rr >> 2) + 32 * half); return tb[clampi(idx, 0, top)]; });
        } else {
            const int lim = tq + 64;
            tile_step(c, tile, st, qr, [&](int rr, int half) { const int idx = db - R * ((rr & 3) + 8 * (rr >> 2) + 32 * half);
                return tb[idx > lim ? 0 : clampi(idx, 0, top)]; });
        }
    }
}
__device__ __forceinline__ void dil_wave(LAS unsigned char* L_, int wid, int b, int h, int chunk, int rho, const bf16* Q, const bf16* K, const bf16* V, bf16* O, LAS const float* tab) {
    const WCtx c = make_ctx(L_);
    const size_t hb = (size_t)(b * NH + h) * SEQ;
    const bf16* Kb = K + hb * HD; const bf16* Vb = V + hb * HD;
    const int t0 = 512 * chunk + rho, tq = t0 + 16 * c.r32;
    bf16x8 qr[4]; load_q(qr, Q + (hb + tq) * HD, c.hi);
    AState st; astate_init(st);
    const unsigned tile = wid * TILE_B;
    dil_branch<1>(c, tile, st, qr, Kb, Vb, t0, tq, tab);
    dil_branch<4>(c, tile, st, qr, Kb, Vb, t0, tq, tab + 256);
    dil_branch<16>(c, tile, st, qr, Kb, Vb, t0, tq, tab + 896);
    f32x16 a0, a1;
#pragma unroll
    for (int r = 0; r < 16; ++r) { a0[r] = 0.f; a1[r] = 0.f; }
    astate_fold(st, 1.0f, a0, a1);
    store_o(c, O + ((size_t)b * SEQ + tq) * DM + h * HD, a0, a1);
    lgkm_wait0();
}

constexpr int IMP_OFF = 33024, TABF = 2112, TABWN = 704;
__device__ __forceinline__ void nsa_unit(int wid, LAS unsigned char* lds, int b, int g, int chunk, const bf16* Q, const bf16* KV1, const bf16* KC, const bf16* VC,
                                         const float* gates, bf16* O, LAS const float* tabs) {
    const WCtx c = make_ctx(lds);
    const int hh = wid & 3, qt = wid >> 2, h = 4 * g + hh;
    LAS const float* tab = tabs + hh * TABF; LAS const float* tabw = tabs + 4 * TABF + hh * TABWN;
    const int t0 = 64 * chunk + 32 * qt, tq = t0 + c.r32, cur = chunk;
    const size_t qb = (size_t)(b * NH + h) * SEQ, gb = (size_t)(b * 4 + g) * SEQ, TS = (size_t)BATCH * 4 * SEQ * HD;
    bf16x8 qr[4]; load_q(qr, Q + (qb + tq) * HD, c.hi);
    const bf16* KCb = KC + (size_t)(b * 4 + g) * 128 * HD; const bf16* VCb = VC + (size_t)(b * 4 + g) * 128 * HD;
    const float* grow = gates + ((size_t)b * SEQ + tq) * 48 + 3 * h;
    const float g0 = grow[0], g1 = grow[1], g2 = grow[2];
    f32x16 a0, a1;
#pragma unroll
    for (int r = 0; r < 16; ++r) { a0[r] = 0.f; a1[r] = 0.f; }
    issue_piece(c, KCb, VCb, (unsigned)(8 * wid + (c.lane >> 3)), c.lds0, wid);
    issue_piece(c, KCb, VCb, (unsigned)(64 + 8 * wid + (c.lane >> 3)), c.lds0 + TILE_B, wid);
    vm_wait0(); __syncthreads();
    {
        f32x16 p[4];
#pragma unroll
        for (int T = 0; T < 4; ++T)
#pragma unroll
            for (int r = 0; r < 16; ++r) p[T][r] = 0.f;
        tile_qk(c, c.ldsp, qr, p[0], p[1]);
        tile_qk(c, c.ldsp + TILE_B, qr, p[2], p[3]);
        const int db = tq - 31 + 64 - 64 * c.hi;
        float rm = -INFINITY;
#pragma unroll
        for (int T = 0; T < 4; ++T)
#pragma unroll
            for (int r = 0; r < 16; ++r) { const int idx = db - 16 * (32 * T + (r & 3) + 8 * (r >> 2)); p[T][r] = __builtin_fmaf(p[T][r], C2, tab[clampi(idx, 0, TABF - 1)]); rm = fmaxf(rm, p[T][r]); }
        rm = fmaxf(rm, __shfl_xor(rm, 32));
        const float mu = fmaxf(rm, -1e30f);
        float lsum = 0.f;
#pragma unroll
        for (int T = 0; T < 4; ++T)
#pragma unroll
            for (int r = 0; r < 16; ++r) { p[T][r] = fast_exp2(p[T][r] - mu); lsum += p[T][r]; }
        lsum += __shfl_xor(lsum, 32);
        const float linv = lsum > 0.f ? 1.0f / lsum : 0.f;
#pragma unroll
        for (int T = 0; T < 4; ++T)
#pragma unroll
            for (int r = 0; r < 16; ++r) p[T][r] *= linv;
        tile_pv(c, c.ldsp, a0, a1, p[0], p[1]);
        tile_pv(c, c.ldsp + TILE_B, a0, a1, p[2], p[3]);
#pragma unroll
        for (int r = 0; r < 16; ++r) { a0[r] *= g0; a1[r] *= g0; }
        LAS float* IA = (LAS float*)(lds + IMP_OFF + wid * 8448); LAS float* IB = IA + 32 * 33;
#pragma unroll
        for (int T = 0; T < 4; ++T)
#pragma unroll
            for (int gq = 0; gq < 4; ++gq) { const int n = 8 * T + 2 * gq + c.hi; const float b3 = 16.f * p[T][4 * gq + 3];
                IA[c.r32 * 33 + n] = 32.f * (p[T][4 * gq] + p[T][4 * gq + 1] + p[T][4 * gq + 2]) + b3; IB[c.r32 * 33 + n] = b3; }
    }
    __syncthreads();
    float imp[16];
#pragma unroll
    for (int k = 0; k < 16; ++k) imp[k] = 0.f;
#pragma unroll
    for (int w4 = 0; w4 < 4; ++w4) { LAS const float* A = (LAS const float*)(lds + IMP_OFF + (w4 + 4 * qt) * 8448) + c.r32 * 33; LAS const float* Bq = A + 32 * 33;
#pragma unroll
        for (int k = 0; k < 16; ++k) { const int n = 16 * c.hi + k; imp[k] += A[n] + (n > 0 ? Bq[n - 1] : 0.f); } }
    int mine[16], oth[16];
#pragma unroll
    for (int k = 0; k < 16; ++k) { const int n = 16 * c.hi + k; const bool valid = n <= cur, forced = (n == 0) || (n == cur) || (n == cur - 1);
        mine[k] = !valid ? -2 : forced ? 0x7f000000 : __builtin_bit_cast(int, imp[k]);
        oth[k] = __shfl_xor(mine[k], 32); }
    unsigned selm = 0u;
#pragma unroll
    for (int k = 0; k < 16; ++k) { int rank = 0; const int me = mine[k], me1 = mine[k] - 1, meo = mine[k] - c.hi;
#pragma unroll
        for (int k2 = 0; k2 < 16; ++k2) { if (k2 < k) rank += mine[k2] > me1 ? 1 : 0; else if (k2 > k) rank += mine[k2] > me ? 1 : 0; rank += oth[k2] > meo ? 1 : 0; }
        if (rank < 16) selm |= 1u << k; }
    selm <<= 16 * c.hi;
    selm |= __shfl_xor(selm, 32);
    selm &= (cur >= 31) ? 0xffffffffu : ((2u << cur) - 1u);
    const unsigned wsel = wave_or(selm);
    LAS unsigned* UW = (LAS unsigned*)(lds + UW_OFF);
    if (c.lane == 0) UW[wid] = wsel;
    __syncthreads();
    unsigned U = 0u;
#pragma unroll
    for (int w = 0; w < 8; ++w) U |= UW[w];
    U = __builtin_amdgcn_readfirstlane(U);
    const bf16* Ks = KV1 + 2 * TS + gb * HD; const bf16* Vs = KV1 + 3 * TS + gb * HD;
    const bf16* Kw = KV1 + 4 * TS + gb * HD; const bf16* Vw = KV1 + 5 * TS + gb * HD;
    const int nsel = __builtin_popcount(U);
    int wlo = 64 * chunk - 511; wlo = wlo < 0 ? 0 : wlo; const int w0 = wlo >> 6, nwin = chunk - w0 + 1;
    const int ntile = nsel + nwin;
    AState st; astate_init(st);
    unsigned rest = U; int slot = 0;
    int tn = __builtin_ctz(rest | 0x80000000u); rest &= rest - 1;
    issue_piece(c, Ks, Vs, (unsigned)(64 * tn + 8 * wid + (c.lane >> 3)), c.lds0, wid);
    for (int it = 0; it < ntile; ++it) {
        const bool is_win = it >= nsel;
        const int nit = it + 1; const bool n_win = nit >= nsel;
        int ntn; unsigned nrest = rest;
        if (n_win) ntn = w0 + (nit - nsel); else { ntn = __builtin_ctz(nrest | 0x80000000u); nrest &= nrest - 1; }
        vm_wait0(); __syncthreads();
        if (nit < ntile) issue_piece(c, n_win ? Kw : Ks, n_win ? Vw : Vs, (unsigned)(64 * ntn + 8 * wid + (c.lane >> 3)), c.lds0 + (slot ^ 1) * TILE_B, wid);
        if (it == nsel) { astate_fold(st, g1, a0, a1); astate_init(st); }
        const int k0 = 64 * tn;
        if (!is_win) {
            if ((wsel >> tn) & 1u) { const bool mn = (selm >> tn) & 1u;
                LAS const float* P0 = mn ? tab + (tq - k0 + 1 - 4 * c.hi) : tab;
                tile_step(c, slot * TILE_B, st, qr, FAST_BIAS(P0)); }
        } else {
            if (k0 + 63 >= t0 - 511) { LAS const float* P0 = tabw + (tq - k0 + 1 - 4 * c.hi);
                tile_step(c, slot * TILE_B, st, qr, FAST_BIAS(P0)); }
        }
        tn = ntn; rest = nrest; slot ^= 1;
    }
    astate_fold(st, g2, a0, a1);
    store_o(c, O + ((size_t)b * SEQ + tq) * DM + h * HD, a0, a1);
    lgkm_wait0(); __syncthreads();
}

#define LDS_WAIT() asm volatile("s_waitcnt lgkmcnt(0)" ::: "memory")
#define VM_WAIT() asm volatile("s_waitcnt vmcnt(0)" ::: "memory")
constexpr int NWAVES = 8;
__device__ __forceinline__ float wave_sum(float v) {
#pragma unroll
    for (int o = 1; o < 64; o <<= 1) v += __shfl_xor(v, o);
    return v;
}

struct Args { const float* in[33]; float* out; unsigned char* ws; int ph_lo, ph_hi; };

__device__ __forceinline__ void tr_item(const float* src, int Nsrc, int srccol0, const float* gain, bf16* dst, int Kdst, int dstrow0, int k0, LAS float* scr, int lane) {
    const int col = srccol0 + (lane & 31); const bool ok = col < Nsrc;
#pragma unroll 8
    for (int i = 0; i < 32; ++i) { const int kk = 2 * i + (lane >> 5); float v = ok ? src[(size_t)(k0 + kk) * Nsrc + col] : 0.f; if (gain) v *= gain[k0 + kk]; scr[kk * 33 + (lane & 31)] = v; }
    LDS_WAIT(); asm volatile("" ::: "memory");
    const int c = lane & 7;
#pragma unroll
    for (int j = 0; j < 4; ++j) { const int n = (lane >> 3) + 8 * j; const LAS float* s = scr + (8 * c) * 33 + n;
        u32x4 o; o.x = pk2(s[0 * 33], s[1 * 33]); o.y = pk2(s[2 * 33], s[3 * 33]); o.z = pk2(s[4 * 33], s[5 * 33]); o.w = pk2(s[6 * 33], s[7 * 33]);
        *(GAS u32x4*)(dst + (size_t)(dstrow0 + n) * Kdst + k0 + 8 * c) = o; }
    LDS_WAIT(); asm volatile("" ::: "memory");
}
__device__ __forceinline__ void tr_matrix(int item, const float* src, const float* src2, int Ksrc, int Nsrc, int Ndst, int map, const float* gain, bf16* dst, LAS float* scr, int lane) {
    const int nblk = Ndst / 32, kb = item / nblk, nb = item % nblk;
    int srccol0 = 32 * nb; const float* s = src;
    if (map == 1) { const int pn = nb >> 3, pb = nb & 7, half = pb >> 2, hh = pb & 3; srccol0 = 256 * pn + 64 * hh + 32 * half; }
    else if (map == 2) { const int pn = nb >> 3, pb = nb & 7; srccol0 = 128 * pn + 32 * (pb & 3); s = (pb < 4) ? src : src2; }
    tr_item(s, Nsrc, srccol0, gain, dst, Ksrc, 32 * nb, 64 * kb, scr, lane);
}

__device__ __forceinline__ int rel_bucket(int d) {
    if (d < 16) return d;
    int b = 16;
    b += d >= 22; b += d >= 30; b += d >= 40; b += d >= 54; b += d >= 73; b += d >= 99; b += d >= 134; b += d >= 182;
    b += d >= 246; b += d >= 332; b += d >= 450; b += d >= 609; b += d >= 825; b += d >= 1117; b += d >= 1513;
    return b;
}

__device__ __forceinline__ bool in_phase(int k, int lo, int hi) { asm volatile("" : "+s"(lo), "+s"(hi)); return lo <= k && k < hi; }
__global__ void __launch_bounds__(NWAVES * 64, 2) fwd_kernel(Args args) {
    extern __shared__ __attribute__((aligned(16))) unsigned char lds[];
    LAS unsigned char* L = (LAS unsigned char*)lds;
    volatile LAS unsigned* MISC = (volatile LAS unsigned*)(L + MISC_OFF);
    const int tid = threadIdx.x, lane = tid & 63, wave = __builtin_amdgcn_readfirstlane(tid >> 6);
    const int G = gridDim.x; const int bx = blockIdx.x; const int vcu = (G % 8 == 0) ? (bx % 8) * (G / 8) + bx / 8 : bx;
    unsigned char* ws = args.ws;
    gu32* ctl = (gu32*)(ws + WS_CTL);
    for (int u = tid; u < 128; u += NWAVES * 64) ((LAS unsigned*)(L + MISC_OFF))[u] = 0u;
    __syncthreads();
    XcdBarrier bar = xcd_barrier_post((unsigned*)(ctl + CW_BAR), MISC + 8);
    const int lo = args.ph_lo, hi = args.ph_hi;
#define IN(k) (((MK_MASK >> (k)) & 1) && in_phase((k), lo, hi))
#define PHASE_IDS int tid_o = threadIdx.x; asm volatile("" : "+v"(tid_o)); const int tid = tid_o, lane = tid_o & 63; (void)tid; (void)lane;
#define PHASE_WS unsigned char* ws_o = args.ws; asm volatile("" : "+s"(ws_o)); unsigned char* const ws = ws_o; (void)ws; int bx_o = blockIdx.x; asm volatile("" : "+s"(bx_o)); const int bx = bx_o; (void)bx;
#define REPN(k) (1 + ((MK_REP >> (k)) & 1))
#define INR(k) in_phase((k), lo, hi)
#define SEAM(k) do { if (INR(k) && INR((k) + 1)) xcd_barrier(bar); } while (0)

#define ssb ((ss_t*)(ws + WS_SS))
#define kmean ((float*)(ws + WS_KMEAN))
#define biasd ((float*)(ws + WS_BIASD))
#define cb1 ((float*)(ws + WS_CB1))
#define HB ((bf16*)(ws + WS_HB))
#define PP ((bf16*)(ws + WS_PP))
#define OB ((bf16*)(ws + WS_O))
#define QB ((bf16*)(ws + WS_Q))
#define K0 ((bf16*)(ws + WS_K0))
#define V0 ((bf16*)(ws + WS_V0))
#define KV1 ((bf16*)(ws + WS_KV1))
#define HID ((bf16*)(ws + WS_HID))
#define PB0 ((bf16*)(ws + WS_PB0))
#define PB1 ((bf16*)(ws + WS_PB1))
#define KC ((bf16*)(ws + WS_KC))
#define VC ((bf16*)(ws + WS_VC))
#define GATES ((float*)(ws + WS_GATES))
    const int gw = vcu * NWAVES + wave, NGW = G * NWAVES;

for (int rep_ = 0; rep_ < REPN(0); ++rep_) { if (rep_) xcd_barrier(bar);
    if (IN(0)) { PHASE_WS
        PHASE_IDS
        LAS float* scr = (LAS float*)(L + wave * WAVE_LDS);
        const float* nmix = args.in[3]; const float* nffn = args.in[4]; const float* nple = args.in[5];
        constexpr int I_IN0 = 16 * (N_IN0 / 32), I_IN1 = 16 * (N_IN1P / 32), I_OUT = 16 * 32, I_GU = 16 * (N_GU / 32), I_D = (FF / 64) * 32, I_PG = 16 * 32, I_PP = 4 * 32, I_C1 = 32 * 4, I_C2 = 2 * 2;
        constexpr int NIT = I_IN0 + I_IN1 + 2 * I_OUT + 2 * I_GU + 2 * I_D + 2 * I_PG + 2 * I_PP + 2 * I_C1 + 2 * I_C2;
        for (int it = gw; it < NIT; it += NGW) {
            int r = it;
            if (r < I_IN0) { tr_matrix(r, args.in[11], nullptr, DM, N_IN0, N_IN0, 1, nmix, (bf16*)(ws + WS_WIN0), scr, lane); continue; } r -= I_IN0;
            if (r < I_IN1) { tr_matrix(r, args.in[17], nullptr, DM, N_IN1, N_IN1P, 1, nmix + DM, (bf16*)(ws + WS_WIN1), scr, lane); continue; } r -= I_IN1;
            if (r < I_OUT) { tr_matrix(r, args.in[12], nullptr, DM, DM, DM, 0, nullptr, (bf16*)(ws + WS_WOUT0), scr, lane); continue; } r -= I_OUT;
            if (r < I_OUT) { tr_matrix(r, args.in[18], nullptr, DM, DM, DM, 0, nullptr, (bf16*)(ws + WS_WOUT1), scr, lane); continue; } r -= I_OUT;
            if (r < I_GU) { tr_matrix(r, args.in[6], args.in[7], DM, FF, N_GU, 2, nffn, (bf16*)(ws + WS_WGU0), scr, lane); continue; } r -= I_GU;
            if (r < I_GU) { tr_matrix(r, args.in[6] + (size_t)DM * FF, args.in[7] + (size_t)DM * FF, DM, FF, N_GU, 2, nffn + DM, (bf16*)(ws + WS_WGU1), scr, lane); continue; } r -= I_GU;
            if (r < I_D) { tr_matrix(r, args.in[8], nullptr, FF, DM, DM, 0, nullptr, (bf16*)(ws + WS_WD0), scr, lane); continue; } r -= I_D;
            if (r < I_D) { tr_matrix(r, args.in[8] + (size_t)FF * DM, nullptr, FF, DM, DM, 0, nullptr, (bf16*)(ws + WS_WD1), scr, lane); continue; } r -= I_D;
            if (r < I_PG) { tr_matrix(r, args.in[10], nullptr, DM, DM, DM, 0, nple, (bf16*)(ws + WS_WPG0), scr, lane); continue; } r -= I_PG;
            if (r < I_PG) { tr_matrix(r, args.in[10] + (size_t)DM * DM, nullptr, DM, DM, DM, 0, nple + DM, (bf16*)(ws + WS_WPG1), scr, lane); continue; } r -= I_PG;
            if (r < I_PP) { tr_matrix(r, args.in[9], nullptr, PLE, DM, DM, 0, nullptr, (bf16*)(ws + WS_WPP0), scr, lane); continue; } r -= I_PP;
            if (r < I_PP) { tr_matrix(r, args.in[9] + (size_t)PLE * DM, nullptr, PLE, DM, DM, 0, nullptr, (bf16*)(ws + WS_WPP1), scr, lane); continue; } r -= I_PP;
            if (r < I_C1) { tr_matrix(r, args.in[24], nullptr, 2048, 128, 128, 0, nullptr, (bf16*)(ws + WS_CW1K), scr, lane); continue; } r -= I_C1;
            if (r < I_C1) { tr_matrix(r, args.in[29], nullptr, 2048, 128, 128, 0, nullptr, (bf16*)(ws + WS_CW1V), scr, lane); continue; } r -= I_C1;
            if (r < I_C2) { tr_matrix(r, args.in[26], nullptr, 128, 64, 64, 0, nullptr, (bf16*)(ws + WS_CW2K), scr, lane); continue; } r -= I_C2;
            tr_matrix(r, args.in[31], nullptr, 128, 64, 64, 0, nullptr, (bf16*)(ws + WS_CW2V), scr, lane);
        }
        const float* x = args.in[0];
        for (int m = gw; m < M; m += NGW) {
            const GAS f32x4* xr = (const GAS f32x4*)(x + (size_t)m * DM) + lane; f32x4 v[4]; float s = 0.f;
#pragma unroll
            for (int j = 0; j < 4; ++j) { v[j] = xr[64 * j]; s += (v[j].x * v[j].x + v[j].y * v[j].y) + (v[j].z * v[j].z + v[j].w * v[j].w); }
            s = wave_sum(s);
            GAS unsigned long long* o8 = (GAS unsigned long long*)(HB + (size_t)m * DM) + lane;
#pragma unroll
            for (int j = 0; j < 4; ++j) o8[64 * j] = (unsigned long long)pk2(v[j].x, v[j].y) | ((unsigned long long)pk2(v[j].z, v[j].w) << 32);
            if (lane == 0) ssb[m] = (ss_t)(s * SS_SCALE);
        }
        const float* p0 = args.in[1];
        for (int m = gw; m < M; m += NGW) { const f32x4 v = ((const GAS f32x4*)(p0 + (size_t)m * PLE))[lane];
            ((GAS unsigned long long*)(PB0 + (size_t)m * PLE))[lane] = (unsigned long long)pk2(v.x, v.y) | ((unsigned long long)pk2(v.z, v.w) << 32); }
        const float* relb = args.in[2];
        for (int i = bx * 512 + tid; i < NH * TABN; i += G * 512) { const int h = i / TABN, d = i % TABN; biasd[i] = relb[rel_bucket(d) * NH + h] * LOG2E; }
        for (int o = gw; o < 256; o += NGW) { const int kv = o >> 7, col = o & 127; const float* pos = args.in[kv ? 28 : 23]; const float* w1 = args.in[kv ? 29 : 24]; const float* b1 = args.in[kv ? 30 : 25];
            float s = 0.f; for (int k = lane; k < 2048; k += 64) s += pos[k] * w1[(size_t)k * 128 + col];
            s = wave_sum(s); if (lane == 0) cb1[o] = s + b1[col]; }
        if (bx == 0) { const int gi = tid >> 6; const int src_idx = gi < 4 ? 13 + gi : gi == 4 ? 19 : gi == 5 ? 21 : gi == 6 ? 22 : 20; ((float*)(ws + WS_GN))[tid] = args.in[src_idx][tid & 63]; }
        for (int i = bx * 512 + tid; i < 2 * 32 * 32; i += G * 512) { const int kv = i >> 10, bg = (i >> 5) & 31, w = i & 31; ((unsigned*)((kv ? VC : KC) + ((size_t)bg * 128 + 127) * HD))[w] = 0u; }
    }
}
    SEAM(0);
    using namespace pg8;
for (int rep_ = 0; rep_ < REPN(1); ++rep_) { if (rep_) xcd_barrier(bar);
    if (IN(1)) { PHASE_WS  int kk = PLE; asm volatile("" : "+s"(kk)); Gemm g{PB0, (const bf16*)(ws + WS_WPP0), M, DM, kk}; StaticOrder S; S.init(M, DM, G, bx); EpiStoreBf16 E{PP, DM};
        gemm_phase<EpiStoreBf16, StaticOrder, true, true>(L, g, S, E); }
}
    SEAM(1);
    if (IN(2)) { PHASE_WS  Gemm g{HB, (const bf16*)(ws + WS_WIN0), M, N_IN0, DM}; StaticOrder S; S.init(M, N_IN0, G, bx);
        EpiInProj<0> E{ssb, QB, (const float*)(ws + WS_GN), kmean, nullptr};
        gemm_phase<EpiInProj<0>, StaticOrder, true, true>(L, g, S, E); }
    SEAM(2);
for (int rep_ = 0; rep_ < REPN(3); ++rep_) { if (rep_) xcd_barrier(bar);
    if (IN(3)) { PHASE_WS
        PHASE_IDS
        LAS float* tab = (LAS float*)(L + TAB0_OFF); LAS float* km = (LAS float*)(L + KM_OFF);
        for (int v = vcu; v < 256; v += G) {
            const int bh = v >> 2, b = bh >> 3, h = bh & 7, sub = v & 3;
            __syncthreads();
            build_tab(tab, biasd + h * TABN, 2112, 2047, tid);
            km[tid] = kmean[(size_t)(b * 8 + h) * 512 + tid] * (1.0f / 256.0f);
            __syncthreads();
#ifndef NO_MOBA
#pragma unroll 1
            for (int uu = 0; uu < 2; ++uu) moba_unit(L, wave, b, h, uu ? 7 - sub : sub, QB, K0, V0, OB, tab, km);
#endif
            build_tab(tab, biasd + (8 + h) * TABN, 256, 128, tid);
            build_tab(tab + 256, biasd + (8 + h) * TABN, 640, 512, tid);
            build_tab(tab + 896, biasd + (8 + h) * TABN, 2176, 2047, tid);
            __syncthreads();
#ifndef NO_DIL
#pragma unroll 1
            for (int uu = 0; uu < 2; ++uu) dil_wave(L, wave, b, 8 + h, sub, 8 * uu + wave, QB, K0, V0, OB, tab);
#endif
        }
    }
}
    SEAM(3);
#pragma unroll 1
    for (int layer = 0; layer < 2; ++layer) {
        const int pb = layer ? 12 : 4;
#define Wout ((const bf16*)(ws + (layer ? WS_WOUT1 : WS_WOUT0)))
#define Wgu ((const bf16*)(ws + (layer ? WS_WGU1 : WS_WGU0)))
#define Wd ((const bf16*)(ws + (layer ? WS_WD1 : WS_WD0)))
#define Wpg ((const bf16*)(ws + (layer ? WS_WPG1 : WS_WPG0)))
#define ss_ffn (ssb + (size_t)(3 * layer + 1) * M)
#define ss_ple (ssb + (size_t)(3 * layer + 2) * M)
#define ss_next (layer ? (ss_t*)nullptr : ssb + (size_t)3 * M)
        if (layer == 1) {
for (int rep_ = 0; rep_ < REPN(8); ++rep_) { if (rep_) xcd_barrier(bar);
            if (IN(8)) { PHASE_WS  int kk = PLE; asm volatile("" : "+s"(kk)); Gemm g{PB1, (const bf16*)(ws + WS_WPP1), M, DM, kk}; StaticOrder S; S.init(M, DM, G, bx); EpiStoreBf16 E{PP, DM};
                gemm_phase<EpiStoreBf16, StaticOrder, true, true>(L, g, S, E); }
}
            SEAM(8);
for (int rep_ = 0; rep_ < REPN(9); ++rep_) { if (rep_) xcd_barrier(bar);
            if (IN(9)) { PHASE_WS  Gemm g{HB, (const bf16*)(ws + WS_WIN1), M, N_IN1P, DM}; StaticOrder S; S.init(M, N_IN1P, G, bx);
                EpiInProj<1> E{ssb + (size_t)3 * M, QB, (const float*)(ws + WS_GN), nullptr, GATES};
                gemm_phase<EpiInProj<1>, StaticOrder, true, true>(L, g, S, E); }
}
            SEAM(9);
for (int rep_ = 0; rep_ < REPN(10); ++rep_) { if (rep_) xcd_barrier(bar);
            if (IN(10)) { PHASE_WS
                PHASE_IDS
                for (int task = vcu; task < 256; task += G) {
                    const int kv = task >> 7, bg = (task >> 2) & 31, rt = task & 3, i0 = 32 * rt;
                    const bf16* T = KV1 + (size_t)kv * ((size_t)BATCH * 4 * SEQ * HD) + (size_t)bg * SEQ * HD;
                    const bf16* W1 = (const bf16*)(ws + (kv ? WS_CW1V : WS_CW1K)); const bf16* W2 = (const bf16*)(ws + (kv ? WS_CW2V : WS_CW2K));
                    const int r32 = lane & 31, hi5 = lane >> 5, nb = wave & 3, kh = wave >> 2;
                    f32x16 acc;
#pragma unroll
                    for (int r = 0; r < 16; ++r) acc[r] = 0.f;
                    int arow = i0 + r32; arow = arow > 126 ? 126 : arow;
                    const bf16* ap = T + (size_t)arow * 16 * HD + 1024 * kh + 8 * hi5;
                    const bf16* bp = W1 + (size_t)(32 * nb + r32) * 2048 + 1024 * kh + 8 * hi5;
#pragma unroll 8
                    for (int s = 0; s < 64; ++s) { const bf16x8 a = *(const bf16x8*)(ap + 16 * s), bb = *(const bf16x8*)(bp + 16 * s);
                        acc = __builtin_amdgcn_mfma_f32_32x32x16_bf16(a, bb, acc, 0, 0, 0); }
                    __syncthreads();
                    LAS float* part = (LAS float*)L;
#pragma unroll
                    for (int r = 0; r < 16; ++r) part[(kh * 32 + crow(r, hi5)) * 129 + 32 * nb + r32] = acc[r];
                    __syncthreads();
                    LAS bf16* H1 = (LAS bf16*)(L + 40960);
                    for (int e = tid; e < 32 * 128; e += 512) { const int row = e >> 7, col = e & 127;
                        const float v = part[row * 129 + col] + part[(32 + row) * 129 + col] + cb1[kv * 128 + col];
                        const float u2 = 0.7978845608028654f * (v + 0.044715f * v * v * v);
                        const float th = 1.0f - 2.0f * fast_rcp(1.0f + fast_exp2(2.0f * u2 * LOG2E));
                        H1[row * 136 + col] = (bf16)f2bf(0.5f * v * (1.0f + th)); }
                    __syncthreads();
                    LAS float* OUT = (LAS float*)(L + 57344);
                    if (wave < 2) {
                        f32x16 a2;
#pragma unroll
                        for (int r = 0; r < 16; ++r) a2[r] = 0.f;
#pragma unroll
                        for (int s = 0; s < 8; ++s) { const bf16x8 a = *(LAS const bf16x8*)(H1 + r32 * 136 + 16 * s + 8 * hi5);
                            const bf16x8 bb = *(const bf16x8*)(W2 + (size_t)(32 * wave + r32) * 128 + 16 * s + 8 * hi5);
                            a2 = __builtin_amdgcn_mfma_f32_32x32x16_bf16(a, bb, a2, 0, 0, 0); }
                        const float* b2 = args.in[kv ? 32 : 27];
#pragma unroll
                        for (int r = 0; r < 16; ++r) OUT[crow(r, hi5) * 65 + 32 * wave + r32] = a2[r] + b2[32 * wave + r32];
                    }
                    __syncthreads();
                    if (tid < 256) { const int row = tid >> 3, c8 = (tid & 7) * 8; float v[8]; float sq = 0.f;
#pragma unroll
                        for (int i = 0; i < 8; ++i) { v[i] = OUT[row * 65 + c8 + i]; sq += v[i] * v[i]; }
                        sq += __shfl_xor(sq, 1); sq += __shfl_xor(sq, 2); sq += __shfl_xor(sq, 4);
                        if (kv == 0) { const float r2 = rsqrtf(sq * (1.0f / HD) + RMS_EPS); const float* kn = (const float*)(ws + WS_GN) + 7 * 64;
#pragma unroll
                            for (int i = 0; i < 8; ++i) v[i] = v[i] * r2 * kn[c8 + i]; }
                        if (i0 + row < 127) { u32x4 w; w.x = pk2(v[0], v[1]); w.y = pk2(v[2], v[3]); w.z = pk2(v[4], v[5]); w.w = pk2(v[6], v[7]);
                            *(u32x4*)((kv ? VC : KC) + ((size_t)bg * 128 + i0 + row) * HD + c8) = w; } }
                    __syncthreads();
                }
            }
}
            SEAM(10);
for (int rep_ = 0; rep_ < REPN(11); ++rep_) { if (rep_) xcd_barrier(bar);
            if (IN(11)) { PHASE_WS
                PHASE_IDS
                LAS float* tabs = (LAS float*)(L + TAB1_OFF);
                for (int v = vcu; v < 256; v += G) {
                    const int bg = v >> 3, b = bg >> 2, g = bg & 3, sub = v & 7;
                    __syncthreads();
#pragma unroll 1
                    for (int hh = 0; hh < 4; ++hh) { build_tab(tabs + hh * TABF, biasd + (4 * g + hh) * TABN, TABF, 2047, tid); build_tab(tabs + 4 * TABF + hh * TABWN, biasd + (4 * g + hh) * TABN, TABWN, 511, tid); }
                    __syncthreads();
#pragma unroll 1
                    for (int k = 0; k < 4; ++k) { const int pr = 2 * sub + (k >> 1); const int chunk = (k & 1) ? 31 - pr : pr;
                        nsa_unit(wave, L, b, g, chunk, QB, KV1, KC, VC, GATES, OB, tabs); }
                }
            }
}
            SEAM(11);
        }
        if (IN(pb)) { PHASE_WS
            if (layer == 0) {
                PHASE_IDS
                const float* p1 = args.in[1] + (size_t)M * PLE;
                for (int m = gw; m < M; m += NGW) { const f32x4 v = ((const GAS f32x4*)(p1 + (size_t)m * PLE))[lane];
                    ((GAS unsigned long long*)(PB1 + (size_t)m * PLE))[lane] = (unsigned long long)pk2(v.x, v.y) | ((unsigned long long)pk2(v.z, v.w) << 32); }
            }
            Gemm g{OB, Wout, M, DM, DM}; StaticOrder S; S.init(M, DM, G, bx);
            EpiResid<0> E{layer ? args.out : args.in[0], args.out, HB, ss_ffn, nullptr, nullptr};
            gemm_phase<EpiResid<0>, StaticOrder, true, true>(L, g, S, E); }
        SEAM(pb);
for (int rep_ = 0; rep_ < REPN(pb + 1); ++rep_) { if (rep_) xcd_barrier(bar);
        if (IN(pb + 1)) { PHASE_WS  Gemm g{HB, Wgu, M, N_GU, DM}; StaticOrder S; S.init(M, N_GU, G, bx); EpiSwiglu E{HID, ss_ffn};
            gemm_phase<EpiSwiglu, StaticOrder, true, true>(L, g, S, E); }
}
        SEAM(pb + 1);
        if (IN(pb + 2)) { PHASE_WS  Gemm g{HID, Wd, M, DM, FF}; StaticOrder S; S.init(M, DM, G, bx);
            EpiResid<0> E{args.out, args.out, HB, ss_ple, nullptr, nullptr};
            gemm_phase<EpiResid<0>, StaticOrder, true, true>(L, g, S, E); }
        SEAM(pb + 2);
        if (IN(pb + 3)) { PHASE_WS  Gemm g{HB, Wpg, M, DM, DM}; StaticOrder S; S.init(M, DM, G, bx);
            EpiResid<1> E{args.out, args.out, HB, ss_next, ss_ple, PP};
            gemm_phase<EpiResid<1>, StaticOrder, true, true>(L, g, S, E); }
        if (layer == 0) SEAM(7);
    }
#if MK_DBG
    if (lo == 99) {
        const bf16* src = (const bf16*)(ws + (size_t)MK_DBG_OFF);
        for (size_t i = (size_t)bx * 512 + threadIdx.x; i < (size_t)M * DM; i += (size_t)G * 512) args.out[i] = i < (size_t)MK_DBG_CNT ? bf2f(src[i]) : 0.f;
    }
#endif
#undef IN
#undef SEAM
}

extern "C" void kernel_launch(void* const* d_in, const int* in_sizes, int n_in, void* d_out, int out_size, void* d_ws, size_t ws_size, hipStream_t stream) {
    static int grid = 0;
    if (grid == 0) {
        if (n_in != 33 || out_size != M * DM || ws_size < WS_END) { fprintf(stderr, "kernel_launch: unexpected problem (n_in %d out %d ws %zu)\n", n_in, out_size, ws_size); grid = -1; return; }
        int dev = 0, cus = 0, per_cu = 0;
        if (hipGetDevice(&dev) != hipSuccess || hipDeviceGetAttribute(&cus, hipDeviceAttributeMultiprocessorCount, dev) != hipSuccess) { grid = -1; return; }
        if (hipFuncSetAttribute((const void*)fwd_kernel, hipFuncAttributeMaxDynamicSharedMemorySize, LDS_BYTES) != hipSuccess) { fprintf(stderr, "kernel_launch: hipFuncSetAttribute failed\n"); grid = -1; return; }
        if (hipOccupancyMaxActiveBlocksPerMultiprocessor(&per_cu, (const void*)fwd_kernel, NWAVES * 64, LDS_BYTES) != hipSuccess || per_cu < 1) { fprintf(stderr, "kernel_launch: occupancy query says %d\n", per_cu); }
        (void)hipGetLastError();
        grid = cus < 256 ? cus : 256;
    }
    if (grid < 0) return;
    if (hipMemsetAsync((char*)d_ws + WS_CTL, 0, CTL_ZERO_BYTES, stream) != hipSuccess) return;
    Args a{};
    for (int i = 0; i < 33; ++i) a.in[i] = (const float*)d_in[i];
    a.out = (float*)d_out; a.ws = (unsigned char*)d_ws;
#if MK_SPLIT
    for (int ph = 0; ph < MK_PH_END; ++ph) { a.ph_lo = ph; a.ph_hi = ph + 1; hipLaunchKernelGGL(fwd_kernel, dim3(grid), dim3(NWAVES * 64), LDS_BYTES, stream, a); }
#if MK_DBG
    a.ph_lo = 99; a.ph_hi = 100; hipLaunchKernelGGL(fwd_kernel, dim3(grid), dim3(NWAVES * 64), LDS_BYTES, stream, a);
#endif
#else
    a.ph_lo = 0; a.ph_hi = MK_PH_END;
    hipLaunchKernelGGL(fwd_kernel, dim3(grid), dim3(NWAVES * 64), LDS_BYTES, stream, a);
#endif
}
```

```cpp
#include <hip/hip_runtime.h>
#include <cstdio>
#include <cstdint>

#ifndef MK_SPLIT
#define MK_SPLIT 0
#endif
#ifndef MK_DBG
#define MK_DBG 0
#define MK_DBG_OFF (0ull << 10)
#define MK_DBG_CNT (0)
#endif
#ifndef MK_PROBE
#define MK_PROBE 0
#define MK_PROBE_CHUNK 31
#define MK_PROBE_BLK 0
#define MK_PROBE_DIV 100.0f
#define MK_PROBE_OFF 0
#endif
#ifndef MK_P3SKIP
#define MK_P3SKIP 0
#endif
#ifndef MK_STAGGER
#define MK_STAGGER 0
#endif
#ifndef MK_WGM4
#define MK_WGM4 2
#define MK_WGM22 2
#define MK_WGM12 2
#endif
#ifndef MK_SERP
#define MK_SERP 0
#endif
#ifndef MK_GHOST
#define MK_GHOST 0
#endif
#ifndef MK_REP
#define MK_REP 0
#endif
#ifndef MK_MASK
#define MK_MASK 0xFFFF
#endif
#ifndef MK_PH_END
#define MK_PH_END 16
#endif

#if MK_PROBE >= 31
__device__ float g_probe_acc = 0.f;
#endif
namespace pg8 {
#define PG8_LAS __attribute__((address_space(3)))
typedef unsigned short bf16_t;
typedef short bf16x8 __attribute__((ext_vector_type(8)));
typedef float f32x4 __attribute__((ext_vector_type(4)));
typedef unsigned u32x4 __attribute__((ext_vector_type(4)));
constexpr int BM = 256, BK = 64, HALF = 128, HTB = HALF * BK * 2  , STAGE_BYTES = 8 * HTB, NXCD = 8, WGM = 2;

__host__ __device__ __forceinline__ int lds_byte(int r, int c) { const int st = (r >> 4) * 2 + (c >> 5), rr = r & 15, cc = c & 31, ob = rr * 64 + cc * 2; return st * 1024 + (ob ^ (((ob >> 9) & 1) << 5)); }
__host__ __device__ __forceinline__ void stage_rc(int b, int& R, int& C) { const int st = b / 1024, sb = b % 1024, swz = sb ^ (((sb >> 9) & 1) << 5); R = (st >> 1) * 16 + swz / 64; C = (st & 1) * 32 + (swz % 64) / 2; }
__host__ __device__ __forceinline__ int perm32(int rho) { const int n = rho >> 4, i = rho & 15; return 8 * (i >> 2) + 4 * n + (i & 3); }

struct Unit { int pm, pn; };
struct Gemm { const bf16_t* A; const bf16_t* Bt; int M, N, K; };

struct StaticOrder {
    int nM, nN, nwg, G, c, wgm, flat = 0;
    __host__ __device__ void init(int M, int N, int G_, int c_, int wgm_ = WGM) { nM = M / BM; nN = N / BM; nwg = nM * nN; G = G_; c = c_; wgm = wgm_; }
    __host__ __device__ bool next(int i, Unit& u) const {
        const long L = (long)i * G + c; if (L >= nwg) return false;
        int wgid = (int)L; { const int q = nwg / NXCD, r = nwg % NXCD, xcd = wgid % NXCD, off = wgid / NXCD; wgid = (xcd < r ? xcd * (q + 1) : r * (q + 1) + (xcd - r) * q) + off; }
        const int nig = wgm * nN, gid = wgid / nig, fm = gid * wgm, gsz = (nM - fm) < wgm ? (nM - fm) : wgm;
        u.pm = fm + ((wgid % nig) % gsz); u.pn = (wgid % nig) / gsz; if (MK_SERP && (gid & 1)) u.pn = nN - 1 - u.pn;
#if MK_GHOST >= 30
        if (flat) { u.pm = 0; u.pn = 0; }
#endif
        return true;
    }
    __device__ __forceinline__ void a_ready(const Unit&) const {}
    __device__ __forceinline__ void done(const Unit&) const {}
};

__device__ __forceinline__ unsigned cvt_pk_bf16(float lo, float hi) { unsigned r; asm volatile("v_cvt_pk_bf16_f32 %0, %1, %2" : "=v"(r) : "v"(lo), "v"(hi)); return r; }
template <class Epi, class Sched, bool ALIGN_EPI = false, bool SP2 = false>
__device__ __forceinline__ void gemm_phase(PG8_LAS unsigned char* lds, const Gemm g, const Sched& S, const Epi& E) {
    int tid_ = threadIdx.x; asm volatile("" : "+v"(tid_));
    const int tid = tid_, wid = __builtin_amdgcn_readfirstlane(tid >> 6), lane = tid & 63, wr = wid >> 2, wc = wid & 3, fr = lane & 15, fq = lane >> 4;
    const int K = g.K, nt = K / BK;
    unsigned voffA[2], voffB[2];
#pragma unroll
    for (int i = 0; i < 2; ++i) { int R, C; stage_rc(tid * 16 + i * 8192, R, C); const int Rb = Epi::PERM ? ((R & ~31) + perm32(R & 31)) : R;
        voffA[i] = (unsigned)(R * K + C) * 2u; voffB[i] = (unsigned)(Rb * K + C) * 2u; }
    const size_t kstep = (size_t)(BK * 2);
    const size_t hstep = (size_t)HALF * K * 2;
    const size_t tstep = 2 * hstep;
    const unsigned ldsw = (unsigned)wid * 1024u;
    const int aoff = lds_byte(wr * 64 + fr, fq * 8), boff = lds_byte(wc * 32 + fr, fq * 8);
#define PG8_SA(b, h) (((b) * 2 + (h)) * HTB)
#define PG8_SB(b, h) ((4 + (b) * 2 + (h)) * HTB)
#define PG8_STAGE(bufoff, gbase, voff) do { _Pragma("unroll") for (int _i = 0; _i < 2; ++_i) \
        __builtin_amdgcn_global_load_lds((const unsigned*)((const char*)(gbase) + (voff)[_i]), (PG8_LAS unsigned*)(lds + (bufoff) + ldsw + _i * 8192), 16, 0, 0); } while (0)
#define PG8_LDA(dst, b, h) do { _Pragma("unroll") for (int m = 0; m < 4; ++m) _Pragma("unroll") for (int k = 0; k < 2; ++k) dst[m][k] = *(const PG8_LAS bf16x8*)(lds + PG8_SA(b, h) + aoff + m * 2048 + k * 1024); } while (0)
#define PG8_LDB(dst, b, h) do { _Pragma("unroll") for (int n = 0; n < 2; ++n) _Pragma("unroll") for (int k = 0; k < 2; ++k) dst[n][k] = *(const PG8_LAS bf16x8*)(lds + PG8_SB(b, h) + boff + n * 2048 + k * 1024); } while (0)
#define PG8_MMA(ai, bj, At, Bt) do { __builtin_amdgcn_s_setprio(1); _Pragma("unroll") for (int m = 0; m < 4; ++m) _Pragma("unroll") for (int n = 0; n < 2; ++n) _Pragma("unroll") for (int k = 0; k < 2; ++k) \
        acc[ai][bj][m][n] = __builtin_amdgcn_mfma_f32_16x16x32_bf16(Bt[n][k], At[m][k], acc[ai][bj][m][n], 0, 0, 0); __builtin_amdgcn_s_setprio(0); } while (0)
#define PG8_WAIT_V(n) asm volatile("s_waitcnt vmcnt(" #n ")" ::: "memory")
#define PG8_WAIT_L(n) asm volatile("s_waitcnt lgkmcnt(" #n ")" ::: "memory")
#define PG8_BAR __builtin_amdgcn_s_barrier()
#define PG8_SCHED __builtin_amdgcn_sched_barrier(0)
    Unit cur, nxt; int ui = 0;
    if (!S.next(0, cur)) return;
    f32x4 acc[2][2][4][2];
#pragma unroll
    for (int a = 0; a < 2; ++a)
#pragma unroll
        for (int b = 0; b < 2; ++b)
#pragma unroll
            for (int m = 0; m < 4; ++m)
#pragma unroll
                for (int n = 0; n < 2; ++n) acc[a][b][m][n] = (f32x4){0.f, 0.f, 0.f, 0.f};
    bf16x8 At[4][2], B0[2][2], B1[2][2];
    const char* cA = (const char*)g.A + (size_t)cur.pm * tstep; const char* cB = (const char*)g.Bt + (size_t)cur.pn * tstep;
    S.a_ready(cur);
    if constexpr (SP2) {
        PG8_STAGE(PG8_SB(0, 0), cB, voffB); PG8_STAGE(PG8_SB(0, 1), cB + hstep, voffB); PG8_STAGE(PG8_SA(0, 0), cA, voffA); PG8_STAGE(PG8_SA(0, 1), cA + hstep, voffA);
        if (wr == 1) PG8_BAR;
        PG8_WAIT_V(2); PG8_BAR;
        PG8_STAGE(PG8_SB(1, 0), cB + kstep, voffB); PG8_STAGE(PG8_SA(1, 0), cA + kstep, voffA); PG8_STAGE(PG8_SB(1, 1), cB + hstep + kstep, voffB);
        PG8_WAIT_V(6); PG8_BAR;
    } else {
        PG8_STAGE(PG8_SB(0, 0), cB, voffB); PG8_STAGE(PG8_SA(0, 0), cA, voffA); PG8_STAGE(PG8_SB(0, 1), cB + hstep, voffB); PG8_STAGE(PG8_SA(0, 1), cA + hstep, voffA);
        if (wr == 1) PG8_BAR;
        PG8_WAIT_V(4); PG8_BAR;
        PG8_STAGE(PG8_SB(1, 0), cB + kstep, voffB); PG8_STAGE(PG8_SA(1, 0), cA + kstep, voffA); PG8_STAGE(PG8_SB(1, 1), cB + hstep + kstep, voffB);
        PG8_WAIT_V(6); PG8_BAR;
    }
    for (;;) {
        const bool has_next = S.next(ui + 1, nxt);
        const char* nA = has_next ? (const char*)g.A + (size_t)nxt.pm * tstep : cA; const char* nB = has_next ? (const char*)g.Bt + (size_t)nxt.pn * tstep : cB;
        for (int t = 0; t < nt; t += 2) {
            const bool last = (t == nt - 2);
            const char* a1 = cA + (size_t)(t + 1) * kstep;
            const char* a2 = last ? nA : cA + (size_t)(t + 2) * kstep; const char* b2 = last ? nB : cB + (size_t)(t + 2) * kstep;
            const char* a3 = a2 + kstep; const char* b3 = b2 + kstep;
            if (last && has_next) S.a_ready(nxt);
            if constexpr (SP2) {
            PG8_LDB(B0, 0, 0); PG8_LDB(B1, 0, 1); PG8_SCHED; PG8_LDA(At, 0, 0); PG8_STAGE(PG8_SA(1, 1), a1 + hstep, voffA);
            PG8_WAIT_V(8); PG8_WAIT_L(0); PG8_BAR; PG8_MMA(0, 0, At, B0); PG8_MMA(0, 1, At, B1); PG8_BAR; PG8_SCHED;
            PG8_LDA(At, 0, 1); PG8_STAGE(PG8_SB(0, 0), b2, voffB); PG8_STAGE(PG8_SB(0, 1), b2 + hstep, voffB); PG8_STAGE(PG8_SA(0, 0), a2, voffA);
            PG8_WAIT_V(8); PG8_WAIT_L(0); PG8_BAR; PG8_MMA(1, 0, At, B0); PG8_MMA(1, 1, At, B1); PG8_BAR; PG8_SCHED;
            PG8_LDB(B0, 1, 0); PG8_LDB(B1, 1, 1); PG8_SCHED; PG8_LDA(At, 1, 0); PG8_STAGE(PG8_SA(0, 1), a2 + hstep, voffA);
            PG8_WAIT_V(8); PG8_WAIT_L(0); PG8_BAR; PG8_MMA(0, 0, At, B0); PG8_MMA(0, 1, At, B1); PG8_BAR; PG8_SCHED;
            PG8_LDA(At, 1, 1); PG8_STAGE(PG8_SB(1, 0), b3, voffB); PG8_STAGE(PG8_SB(1, 1), b3 + hstep, voffB); PG8_STAGE(PG8_SA(1, 0), a3, voffA);
            PG8_WAIT_V(8); PG8_WAIT_L(0); PG8_BAR; PG8_MMA(1, 0, At, B0); PG8_MMA(1, 1, At, B1); PG8_BAR; PG8_SCHED;
            } else {
            PG8_LDB(B0, 0, 0); PG8_SCHED; PG8_LDA(At, 0, 0); PG8_STAGE(PG8_SA(1, 1), a1 + hstep, voffA);
            PG8_WAIT_L(8); PG8_BAR; PG8_WAIT_L(0); PG8_MMA(0, 0, At, B0); PG8_BAR; PG8_SCHED;
            PG8_LDB(B1, 0, 1); PG8_STAGE(PG8_SB(0, 0), b2, voffB);
            PG8_BAR; PG8_WAIT_L(0); PG8_MMA(0, 1, At, B1); PG8_BAR;
            PG8_LDA(At, 0, 1); PG8_STAGE(PG8_SA(0, 0), a2, voffA);
            PG8_BAR; PG8_WAIT_L(0); PG8_MMA(1, 0, At, B0); PG8_BAR; PG8_SCHED;
            PG8_STAGE(PG8_SB(0, 1), b2 + hstep, voffB);
            PG8_WAIT_V(6); PG8_BAR; PG8_MMA(1, 1, At, B1); PG8_BAR;
            PG8_LDB(B0, 1, 0); PG8_SCHED; PG8_LDA(At, 1, 0); PG8_STAGE(PG8_SA(0, 1), a2 + hstep, voffA);
            PG8_WAIT_L(8); PG8_BAR; PG8_WAIT_L(0); PG8_MMA(0, 0, At, B0); PG8_BAR; PG8_SCHED;
            PG8_LDB(B1, 1, 1); PG8_STAGE(PG8_SB(1, 0), b3, voffB);
            PG8_BAR; PG8_WAIT_L(0); PG8_MMA(0, 1, At, B1); PG8_BAR;
            PG8_LDA(At, 1, 1); PG8_STAGE(PG8_SA(1, 0), a3, voffA);
            PG8_BAR; PG8_WAIT_L(0); PG8_MMA(1, 0, At, B0); PG8_BAR; PG8_SCHED;
            PG8_STAGE(PG8_SB(1, 1), b3 + hstep, voffB);
            PG8_WAIT_V(6); PG8_BAR; PG8_MMA(1, 1, At, B1); PG8_BAR;
            }
        }
        if constexpr (ALIGN_EPI) { if (wr == 0) PG8_BAR; }
#if MK_PROBE >= 31
        const unsigned long long ge_t0 = __builtin_amdgcn_s_memrealtime();
#endif
        if constexpr (!Epi::AFTER_DRAIN) { E(acc, cur, wr, wc, fr, fq); S.done(cur); }
#if MK_PROBE >= 31
        asm volatile("s_waitcnt vmcnt(0)" ::: "memory");
        if (Epi::PROBE_ID == MK_PROBE && blockIdx.x == 0 && tid == 0) g_probe_acc += (float)(__builtin_amdgcn_s_memrealtime() - ge_t0);
#endif
        if (!has_next) break;
#pragma unroll
        for (int a = 0; a < 2; ++a)
#pragma unroll
            for (int b = 0; b < 2; ++b)
#pragma unroll
                for (int m = 0; m < 4; ++m)
#pragma unroll
                    for (int n = 0; n < 2; ++n) acc[a][b][m][n] = (f32x4){0.f, 0.f, 0.f, 0.f};
        cur = nxt; cA = nA; cB = nB; ++ui;
        if constexpr (ALIGN_EPI) { if (wr == 1) PG8_BAR; }
    }
    PG8_WAIT_V(0);
    if constexpr (!ALIGN_EPI) { if (wr == 0) PG8_BAR; }
    PG8_BAR;
    if constexpr (Epi::AFTER_DRAIN) { E.fused(acc, cur, wr, wc, fr, fq, lds, wid, lane); S.done(cur); }
#undef PG8_SA
#undef PG8_SB
#undef PG8_STAGE
#undef PG8_LDA
#undef PG8_LDB
#undef PG8_MMA
#undef PG8_WAIT_V
#undef PG8_WAIT_L
#undef PG8_BAR
#undef PG8_SCHED
}
}

constexpr int BATCH = 8, SEQ = 2048, DM = 1024, M = BATCH * SEQ, FF = 2816, PLE = 256;
constexpr int NH = 16, HD = 64;
constexpr int N_IN0 = 3072, N_IN1 = 2608, N_IN1P = 2816, N_GU = 2 * FF;
constexpr float RMS_EPS = 1e-6f;
constexpr float LOG2E = 1.4426950408889634f;
constexpr float C2 = 0.125f * LOG2E;
constexpr int TABN = 2048;

constexpr size_t MiB = 1u << 20, KiB = 1u << 10;
constexpr size_t WS_CTL = 0, CTL_ZERO_BYTES = 2 * MiB;
constexpr size_t WS_SS = 256 * KiB;
constexpr size_t WS_KMEAN = 1280 * KiB;
constexpr size_t WS_W = 2 * MiB;
constexpr size_t WS_WIN0 = WS_W, WS_WOUT0 = WS_WIN0 + 6 * MiB, WS_WGU0 = WS_WOUT0 + 2 * MiB, WS_WD0 = WS_WGU0 + 11 * MiB,
                 WS_WPG0 = WS_WD0 + 5632 * KiB, WS_WPP0 = WS_WPG0 + 2 * MiB,
                 WS_WIN1 = WS_WPP0 + 512 * KiB, WS_WOUT1 = WS_WIN1 + 5632 * KiB, WS_WGU1 = WS_WOUT1 + 2 * MiB, WS_WD1 = WS_WGU1 + 11 * MiB,
                 WS_WPG1 = WS_WD1 + 5632 * KiB, WS_WPP1 = WS_WPG1 + 2 * MiB,
                 WS_CW1K = WS_WPP1 + 512 * KiB, WS_CW1V = WS_CW1K + 512 * KiB, WS_CW2K = WS_CW1V + 512 * KiB, WS_CW2V = WS_CW2K + 16 * KiB,
                 WS_WEND = WS_CW2V + 16 * KiB;
static_assert(WS_WEND <= 58 * MiB, "weights");
constexpr size_t WS_MISC = 58 * MiB;
constexpr size_t WS_BIASD = WS_MISC;
constexpr size_t WS_CB1 = WS_MISC + 128 * KiB;
constexpr size_t WS_GN = WS_MISC + 192 * KiB;
constexpr size_t WS_KC = WS_MISC + 256 * KiB, WS_VC = WS_KC + 512 * KiB;
constexpr size_t WS_HB = 60 * MiB;
constexpr size_t WS_PP = 92 * MiB;
constexpr size_t WS_O = 124 * MiB;
constexpr size_t WS_QKV = 156 * MiB;
constexpr size_t WS_Q = WS_QKV, WS_K0 = WS_QKV + 32 * MiB, WS_V0 = WS_QKV + 64 * MiB;
constexpr size_t WS_KV1 = WS_QKV + 32 * MiB;
constexpr size_t WS_HID = WS_QKV;
constexpr size_t WS_PB1 = WS_QKV + 88 * MiB;
constexpr size_t WS_PB0 = WS_O;
constexpr size_t WS_GATES = 252 * MiB;
constexpr size_t WS_END = 256 * MiB;
static_assert(WS_QKV + 96 * MiB <= WS_GATES && WS_GATES + 3 * MiB <= WS_END, "ws map");

constexpr int CW_BAR = 4096;

constexpr int WAVE_LDS = 16384;
constexpr int TAB0_OFF = 131072;
constexpr int KM_OFF = TAB0_OFF + 21760;
constexpr int TAB1_OFF = 100608;
constexpr int MISC_OFF = 154880;
constexpr int LDS_BYTES = MISC_OFF + 512;
static_assert(LDS_BYTES <= 163840 && KM_OFF + 2048 <= MISC_OFF && TAB1_OFF + (4 * 2112 + 4 * 704) * 4 <= MISC_OFF, "LDS map");

#define GAS __attribute__((address_space(1)))
#define LAS __attribute__((address_space(3)))
typedef unsigned short bf16;
typedef float f32x4 __attribute__((ext_vector_type(4)));
typedef float f32x16 __attribute__((ext_vector_type(16)));
typedef short bf16x8 __attribute__((ext_vector_type(8)));
typedef unsigned u32x4 __attribute__((ext_vector_type(4)));
typedef unsigned u32x2 __attribute__((ext_vector_type(2)));
typedef GAS unsigned gu32;

__device__ __forceinline__ unsigned f2bf(float f) { unsigned u = __builtin_bit_cast(unsigned, f); return (u + 0x7fffu + ((u >> 16) & 1u)) >> 16; }
__device__ __forceinline__ unsigned pk2(float lo, float hi) { return f2bf(lo) | (f2bf(hi) << 16); }
__device__ __forceinline__ float bf2f(unsigned short h) { return __builtin_bit_cast(float, (unsigned)h << 16); }
typedef float f32x2_t __attribute__((ext_vector_type(2))); typedef __bf16 bf16x2_t __attribute__((ext_vector_type(2)));
__device__ __forceinline__ unsigned cvtpk(float lo, float hi) { f32x2_t v = {lo, hi}; bf16x2_t b = __builtin_convertvector(v, bf16x2_t); return __builtin_bit_cast(unsigned, b); }
__device__ __forceinline__ float fast_exp2(float x) { return __builtin_amdgcn_exp2f(x); }
__device__ __forceinline__ float fast_rcp(float x) { return __builtin_amdgcn_rcpf(x); }
__device__ __forceinline__ float sigmoidf_(float x) { return fast_rcp(1.0f + fast_exp2(-x * LOG2E)); }


__device__ __forceinline__ float x32_other(float v) { const auto r = __builtin_amdgcn_permlane32_swap(__builtin_bit_cast(unsigned, v), __builtin_bit_cast(unsigned, v), false, false);
    return (threadIdx.x & 32) ? __builtin_bit_cast(float, r[0]) : __builtin_bit_cast(float, r[1]); }
__device__ __forceinline__ float sum_x32(float v) { return v + __shfl_xor(v, 32); }
__device__ __forceinline__ float max_x32(float v) { const auto r = __builtin_amdgcn_permlane32_swap(__builtin_bit_cast(unsigned, v), __builtin_bit_cast(unsigned, v), false, false);
    return fmaxf(__builtin_bit_cast(float, r[0]), __builtin_bit_cast(float, r[1])); }
__device__ __forceinline__ float sum_x16(float v) { return v + __shfl_xor(v, 16); }
template <int CTRL> __device__ __forceinline__ float dppf(float v) { return __builtin_bit_cast(float, __builtin_amdgcn_update_dpp(0, __builtin_bit_cast(int, v), CTRL, 0xF, 0xF, true)); }
__device__ __forceinline__ float sum_row16(float v) { v += dppf<0xB1>(v); v += dppf<0x4E>(v); v += dppf<0x141>(v); v += dppf<0x140>(v); return v; }

using pg8::Unit;
typedef float accf4 __attribute__((ext_vector_type(4)));
#define EPI_ARGS const accf4 (&acc)[2][2][4][2], const Unit& u, int wr, int wc, int fr_in, int fq_in
#define EPI_OPAQUE int fr = fr_in, fq = fq_in; asm volatile("" : "+v"(fr), "+v"(fq));
typedef unsigned long long ss_t;
constexpr float SS_SCALE = 16777216.0f;
__device__ __forceinline__ float rstd_row(const ss_t* ss, int row) { return rsqrtf((float)ss[row] * (1.0f / (SS_SCALE * DM)) + RMS_EPS); }

struct EpiStoreBf16 {
    static constexpr bool PERM = true, AFTER_DRAIN = false; static constexpr int PROBE_ID = 30;
    bf16* O; int ldc;
    __device__ __forceinline__ void operator()(EPI_ARGS) const {
        EPI_OPAQUE
        const int row0 = u.pm * 256 + wr * 64 + fr, col0 = u.pn * 256 + wc * 32 + 8 * fq;
#pragma unroll
        for (int ai = 0; ai < 2; ++ai)
#pragma unroll
            for (int m = 0; m < 4; ++m) { bf16* rowp = O + (size_t)(row0 + ai * 128 + m * 16) * ldc + col0;
#pragma unroll
                for (int bj = 0; bj < 2; ++bj) { const accf4 v0 = acc[ai][bj][m][0], v1 = acc[ai][bj][m][1];
                    u32x4 w; w.x = cvtpk(v0[0], v0[1]); w.y = cvtpk(v0[2], v0[3]); w.z = cvtpk(v1[0], v1[1]); w.w = cvtpk(v1[2], v1[3]);
                    *(u32x4*)(rowp + bj * 128) = w; } }
    }
};

__device__ __forceinline__ void bf8_to_f(const u32x4 w, float (&f)[8]) {
    f[0] = __builtin_bit_cast(float, w.x << 16); f[1] = __builtin_bit_cast(float, w.x & 0xffff0000u); f[2] = __builtin_bit_cast(float, w.y << 16); f[3] = __builtin_bit_cast(float, w.y & 0xffff0000u);
    f[4] = __builtin_bit_cast(float, w.z << 16); f[5] = __builtin_bit_cast(float, w.z & 0xffff0000u); f[6] = __builtin_bit_cast(float, w.w << 16); f[7] = __builtin_bit_cast(float, w.w & 0xffff0000u);
}
template <int MODE> struct EpiResid {
    static constexpr bool PERM = true, AFTER_DRAIN = false; static constexpr int PROBE_ID = 32 + MODE;
    const bf16* base; bf16* outb; float* outf; ss_t* ss_out; const ss_t* ss_in; const bf16* pp;
    __device__ __forceinline__ void operator()(EPI_ARGS) const {
        EPI_OPAQUE
        const int row0 = u.pm * 256 + wr * 64 + fr, col0 = u.pn * 256 + wc * 32 + 8 * fq;
        float rsv[8];
#pragma unroll
        for (int g8 = 0; g8 < 8; ++g8) rsv[g8] = (MODE == 1) ? rstd_row(ss_in, row0 + (g8 >> 2) * 128 + (g8 & 3) * 16) : 1.f;
        float sqv[8];
#pragma unroll
        for (int ai = 0; ai < 2; ++ai) {
            u32x4 bw[4][2];
#pragma unroll
            for (int m = 0; m < 4; ++m) { const size_t off = (size_t)(row0 + ai * 128 + m * 16) * DM + col0;
                bw[m][0] = *(const u32x4*)(base + off); bw[m][1] = *(const u32x4*)(base + off + 128); }
#pragma unroll
            for (int m = 0; m < 4; ++m) {
                const int g8 = ai * 4 + m; const int row = row0 + ai * 128 + m * 16; const size_t off = (size_t)row * DM + col0;
                const float rs = rsv[g8];
                float sq = 0.f;
#pragma unroll
                for (int bj = 0; bj < 2; ++bj) {
                    const accf4 v0 = acc[ai][bj][m][0], v1 = acc[ai][bj][m][1];
                    float v[8] = {v0[0], v0[1], v0[2], v0[3], v1[0], v1[1], v1[2], v1[3]};
                    float bs[8]; bf8_to_f(bw[m][bj], bs);
                    if (MODE == 1) { float p[8]; bf8_to_f(*(const u32x4*)(pp + off + bj * 128), p);
#pragma unroll
                        for (int i = 0; i < 8; ++i) v[i] = sigmoidf_(v[i] * rs) * p[i]; }
                    float hh[8];
#pragma unroll
                    for (int i = 0; i < 8; ++i) { hh[i] = bs[i] + v[i]; sq += hh[i] * hh[i]; }
                    if (outf) { *(f32x4*)(outf + off + bj * 128) = (f32x4){hh[0], hh[1], hh[2], hh[3]}; *(f32x4*)(outf + off + bj * 128 + 4) = (f32x4){hh[4], hh[5], hh[6], hh[7]}; }
                    else { u32x4 w; w.x = cvtpk(hh[0], hh[1]); w.y = cvtpk(hh[2], hh[3]); w.z = cvtpk(hh[4], hh[5]); w.w = cvtpk(hh[6], hh[7]); *(u32x4*)(outb + off + bj * 128) = w; }
                }
                sqv[g8] = sq;
            }
        }
        if (ss_out) {
#pragma unroll
            for (int g8 = 0; g8 < 8; ++g8) sqv[g8] = sum_x16(sqv[g8]);
#pragma unroll
            for (int g8 = 0; g8 < 8; ++g8) sqv[g8] = sum_x32(sqv[g8]);
            if (fq == 0) {
#pragma unroll
                for (int g8 = 0; g8 < 8; ++g8) atomicAdd(ss_out + row0 + (g8 >> 2) * 128 + (g8 & 3) * 16, (ss_t)(sqv[g8] * SS_SCALE)); }
        }
    }
};

struct EpiSwiglu {
    static constexpr bool PERM = true, AFTER_DRAIN = false; static constexpr int PROBE_ID = 31;
    bf16* hid; const ss_t* ss_in; int ghost;
    __device__ __forceinline__ void operator()(EPI_ARGS) const {
#if MK_GHOST >= 30
        if (ghost) return;
#endif
        EPI_OPAQUE
        const int row0 = u.pm * 256 + wr * 64 + fr, col0 = u.pn * 128 + wc * 32 + 8 * fq;
#pragma unroll
        for (int ai = 0; ai < 2; ++ai)
#pragma unroll
            for (int m = 0; m < 4; ++m) {
                const int row = row0 + ai * 128 + m * 16; const float rs = rstd_row(ss_in, row);
                float r[8];
#pragma unroll
                for (int n = 0; n < 2; ++n)
#pragma unroll
                    for (int i = 0; i < 4; ++i) { const float g = acc[ai][0][m][n][i] * rs, uu = acc[ai][1][m][n][i] * rs; r[4 * n + i] = g * sigmoidf_(g) * uu; }
                u32x4 w; w.x = cvtpk(r[0], r[1]); w.y = cvtpk(r[2], r[3]); w.z = cvtpk(r[4], r[5]); w.w = cvtpk(r[6], r[7]);
                *(u32x4*)(hid + (size_t)row * FF + col0) = w;
            }
    }
};

template <int LAYER> struct EpiInProj {
    static constexpr bool PERM = true, AFTER_DRAIN = false; static constexpr int PROBE_ID = 34 + LAYER;
    const ss_t* ss_in; bf16* Q;
    const float* gains;
    float* kmean; float* gates;
    __device__ __forceinline__ void operator()(EPI_ARGS) const {
        EPI_OPAQUE
        const int pn = u.pn;
        const float* gain = gains; bool has_gain = false; bf16* dst = Q; int head, nheads; bool do_km = false;
        if (LAYER == 0) {
            const int t6 = pn >> 1, type = t6 % 3, grp = t6 / 3;
            head = grp * 8 + (pn & 1) * 4 + wc; nheads = 16;
            dst = Q + (size_t)type * ((size_t)M * DM);
            has_gain = type < 2; gain = gains + 64 * (grp * 2 + (type & 1)); do_km = (type == 1 && grp == 0);
        } else {
            if (pn < 4) { head = pn * 4 + wc; nheads = 16; has_gain = true; gain = gains + 64 * 4; }
            else { head = wc; nheads = 4; dst = Q + (size_t)M * DM + (size_t)(pn - 4) * ((size_t)BATCH * 4 * SEQ * HD); has_gain = (pn == 6) || (pn == 8); gain = gains + 64 * (pn == 6 ? 5 : 6); }
        }
        const int row0 = u.pm * 256 + wr * 64 + fr;
        if (LAYER == 1 && pn == 10) {
            if (wc == 0) {
#pragma unroll
                for (int ai = 0; ai < 2; ++ai)
#pragma unroll
                    for (int m = 0; m < 4; ++m) { const int row = row0 + ai * 128 + m * 16; const float rs = rstd_row(ss_in, row);
#pragma unroll
                        for (int bj = 0; bj < 2; ++bj) { const int j0 = 32 * bj + 8 * fq;
                            if (j0 < 48) { const accf4 v0 = acc[ai][bj][m][0], v1 = acc[ai][bj][m][1];
                                f32x4 g0, g1;
#pragma unroll
                                for (int i = 0; i < 4; ++i) { g0[i] = sigmoidf_(v0[i] * rs); g1[i] = sigmoidf_(v1[i] * rs); }
                                *(f32x4*)(gates + (size_t)row * 48 + j0) = g0; *(f32x4*)(gates + (size_t)row * 48 + j0 + 4) = g1; } } }
            }
            return;
        }
        float ksum[2][2][4];
#pragma unroll
        for (int bj = 0; bj < 2; ++bj)
#pragma unroll
            for (int n = 0; n < 2; ++n)
#pragma unroll
                for (int i = 0; i < 4; ++i) ksum[bj][n][i] = 0.f;
        float rsv[8], r2v[8];
#pragma unroll
        for (int g8 = 0; g8 < 8; ++g8) { const int ai = g8 >> 2, m = g8 & 3; rsv[g8] = rstd_row(ss_in, row0 + ai * 128 + m * 16); }
        if (has_gain) {
#pragma unroll
            for (int g8 = 0; g8 < 8; ++g8) { const int ai = g8 >> 2, m = g8 & 3; float sq = 0.f;
#pragma unroll
                for (int bj = 0; bj < 2; ++bj)
#pragma unroll
                    for (int n = 0; n < 2; ++n)
#pragma unroll
                        for (int i = 0; i < 4; ++i) { const float x = acc[ai][bj][m][n][i] * rsv[g8]; sq += x * x; }
                r2v[g8] = sq; }
#pragma unroll
            for (int g8 = 0; g8 < 8; ++g8) r2v[g8] = sum_x16(r2v[g8]);
#pragma unroll
            for (int g8 = 0; g8 < 8; ++g8) r2v[g8] = sum_x32(r2v[g8]);
#pragma unroll
            for (int g8 = 0; g8 < 8; ++g8) r2v[g8] = rsqrtf(r2v[g8] * (1.0f / HD) + RMS_EPS) * rsv[g8];
        } else {
#pragma unroll
            for (int g8 = 0; g8 < 8; ++g8) r2v[g8] = rsv[g8];
        }
        f32x4 gq[2][2];
#pragma unroll
        for (int bj = 0; bj < 2; ++bj)
#pragma unroll
            for (int n = 0; n < 2; ++n) gq[bj][n] = has_gain ? *(const f32x4*)(gain + 32 * bj + 8 * fq + 4 * n) : (f32x4){1.f, 1.f, 1.f, 1.f};
#pragma unroll
        for (int ai = 0; ai < 2; ++ai)
#pragma unroll
            for (int m = 0; m < 4; ++m) {
                const int row = row0 + ai * 128 + m * 16, b = row >> 11, s = row & (SEQ - 1); const float sc = r2v[ai * 4 + m];
                float v[2][2][4];
#pragma unroll
                for (int bj = 0; bj < 2; ++bj)
#pragma unroll
                    for (int n = 0; n < 2; ++n)
#pragma unroll
                        for (int i = 0; i < 4; ++i) v[bj][n][i] = acc[ai][bj][m][n][i] * sc * gq[bj][n][i];
                if (LAYER == 0 && do_km) {
#pragma unroll
                    for (int bj = 0; bj < 2; ++bj)
#pragma unroll
                        for (int n = 0; n < 2; ++n)
#pragma unroll
                            for (int i = 0; i < 4; ++i) ksum[bj][n][i] += v[bj][n][i];
                }
                bf16* rowp = dst + ((size_t)(b * nheads + head) * SEQ + s) * HD + 8 * fq;
#pragma unroll
                for (int bj = 0; bj < 2; ++bj) { u32x4 w; w.x = cvtpk(v[bj][0][0], v[bj][0][1]); w.y = cvtpk(v[bj][0][2], v[bj][0][3]); w.z = cvtpk(v[bj][1][0], v[bj][1][1]); w.w = cvtpk(v[bj][1][2], v[bj][1][3]);
                    *(u32x4*)(rowp + 32 * bj) = w; }
            }
        if (LAYER == 0 && do_km) {
            const int b = u.pm >> 3, blk = u.pm & 7;
            float* kp = kmean + ((size_t)((b * 8 + head) * 8 + blk)) * HD + 8 * fq;
#pragma unroll
            for (int bj = 0; bj < 2; ++bj)
#pragma unroll
                for (int n = 0; n < 2; ++n)
#pragma unroll
                    for (int i = 0; i < 4; ++i) { float s = ksum[bj][n][i];
                        s = sum_row16(s);
                        if (fr == 0) atomicAdd(kp + 32 * bj + 4 * n + i, s); }
        }
    }
};
#define XB_TMO      128
#define XB_XCNT(j)  (256  + 64 * (j))
#define XB_XSUB(j)  (1280 + 64 * (j))
#define XB_XGEN(j)  (2304 + 64 * (j))
#define XB_TOP      3328
#define XB_TOPGEN   3392
#define XCD_BAR_WORDS 3456
#define XB_SPIN_CAP (1u << 18)

__device__ __forceinline__ unsigned xb_ld(unsigned* p)              { return __hip_atomic_load(p, __ATOMIC_RELAXED, __HIP_MEMORY_SCOPE_AGENT); }
__device__ __forceinline__ unsigned xb_add(unsigned* p, unsigned v) { return __hip_atomic_fetch_add(p, v, __ATOMIC_RELAXED, __HIP_MEMORY_SCOPE_AGENT); }
__device__ __forceinline__ unsigned xb_xcc_id() { return (unsigned)__builtin_amdgcn_s_getreg((3 << 11) | 20) & 0xFu; }
#define XB_SPIN(cond, bar) do { unsigned _sp = 0; while (cond) { __builtin_amdgcn_s_sleep(1); \
    if ((++_sp & 255u) == 0u) { if (xb_ld(&(bar)[XB_TMO])) break; if (_sp > XB_SPIN_CAP) { atomicAdd(&(bar)[XB_TMO], 1u); break; } } } } while (0)

struct XcdBarrier {
    unsigned* bar; unsigned x;
    volatile LAS unsigned* st;
};

__device__ __forceinline__ XcdBarrier xcd_barrier_post(unsigned* bar, volatile LAS unsigned* st) {
    XcdBarrier b; b.bar = bar; b.x = xb_xcc_id(); b.st = st;
    if (threadIdx.x == 0) (void)xb_add(&bar[XB_XCNT(b.x)], 1u);
    return b;
}
__device__ __forceinline__ void xcd_barrier_complete(unsigned* bar, unsigned x, unsigned& nloc, unsigned& nx) {
    const unsigned G = gridDim.x * gridDim.y * gridDim.z;
    unsigned sum, cnt, mine, sp = 0u;
    for (;;) {
        sum = 0u; cnt = 0u; mine = 0u;
#pragma unroll
        for (unsigned j = 0; j < 16; ++j) { const unsigned c = xb_ld(&bar[XB_XCNT(j)]); sum += c; cnt += (c > 0u) ? 1u : 0u; mine = (j == x) ? c : mine; }
        if (sum == G) break;
        __builtin_amdgcn_s_sleep(1);
        if ((++sp & 255u) == 0u) { if (xb_ld(&bar[XB_TMO])) break; if (sp > XB_SPIN_CAP) { atomicAdd(&bar[XB_TMO], 1u); break; } }
    }
    nloc = mine > 0u ? mine : 1u; nx = cnt > 0u ? cnt : 1u;
}

__device__ __forceinline__ void xcd_barrier(const XcdBarrier& b) {
    asm volatile("s_waitcnt vmcnt(0)" ::: "memory");
    __syncthreads();
    if (threadIdx.x == 0) {
        unsigned* bar = b.bar;
        __builtin_amdgcn_s_waitcnt(0);
        unsigned nloc = b.st[0], nx = b.st[1];
        if (nloc == 0u) { xcd_barrier_complete(bar, b.x, nloc, nx); b.st[0] = nloc; b.st[1] = nx; }
        const unsigned old = xb_add(&bar[XB_XSUB(b.x)], 1u);
        const unsigned gen = old / nloc;
        if (old + 1u == (gen + 1u) * nloc) {
            __builtin_amdgcn_fence(__ATOMIC_RELEASE, "agent");
            asm volatile("s_waitcnt vmcnt(0)" ::: "memory");
            const unsigned og = xb_add(&bar[XB_TOP], 1u);
            const unsigned tg = og / nx;
            if (og + 1u == (tg + 1u) * nx) xb_add(&bar[XB_TOPGEN], 1u);
            else XB_SPIN(xb_ld(&bar[XB_TOPGEN]) == tg, bar);
            __builtin_amdgcn_fence(__ATOMIC_ACQUIRE, "agent");
            xb_add(&bar[XB_XGEN(b.x)], 1u);
            asm volatile("s_waitcnt vmcnt(0)" ::: "memory");
        } else {
            XB_SPIN(xb_ld(&bar[XB_XGEN(b.x)]) == gen, bar);
            __builtin_amdgcn_fence(__ATOMIC_ACQUIRE, "agent");
            asm volatile("s_waitcnt vmcnt(0)" ::: "memory");
        }
    }
    __syncthreads();
}

__device__ __forceinline__ int crow(int r, int hi) { return (r & 3) + 8 * (r >> 2) + 4 * hi; }
__device__ __forceinline__ void glds16(const void* gsrc, unsigned lds_dst) { unsigned keep;
    asm volatile("s_mov_b32 %0, m0\n\ts_mov_b32 m0, %2\n\ts_nop 0\n\tglobal_load_lds_dwordx4 %1, off\n\ts_mov_b32 m0, %0" : "=&s"(keep) : "v"(gsrc), "s"(lds_dst) : "memory"); }
typedef short v4i16_t __attribute__((ext_vector_type(4)));
typedef LAS const char* lds_cptr;
__device__ __forceinline__ v4i16_t vtr(lds_cptr p) { return __builtin_amdgcn_ds_read_tr16_b64_v4i16((LAS v4i16_t*)p); }
constexpr int TILE_B = 16384;
constexpr float THR = 8.0f;
__device__ __forceinline__ int clampi(int v, int lo, int hi) { return v < lo ? lo : (v > hi ? hi : v); }

struct WCtx { int lane, r32, hi; unsigned lds0; lds_cptr ldsp; unsigned koff, voff; bf16x8 lsel; };
__device__ __forceinline__ WCtx make_ctx(LAS unsigned char* L) {
    int lane = threadIdx.x & 63; asm volatile("" : "+v"(lane));
    WCtx c; c.lane = lane; c.r32 = lane & 31; c.hi = lane >> 5; c.ldsp = (lds_cptr)L; c.lds0 = (unsigned)(uintptr_t)((unsigned char*)L);
    c.koff = c.r32 * 128 + (((c.r32 & 7) ^ c.hi) << 4);
    const int q = (lane & 15) >> 2, p = lane & 3, g1 = (lane >> 4) & 1;
    c.voff = 8192 + (4 * c.hi + q) * 128 + ((((g1 << 1) | (p >> 1)) ^ ((q >> 1) << 2)) << 4) + (p & 1) * 8;
    { const bool on = ((lane & 15) == 0 && ((lane >> 4) & 1) == 0) || ((lane & 15) == 1 && ((lane >> 4) & 1) == 1); const short v = on ? (short)0x3F80 : (short)0;
      c.lsel = (bf16x8){v, v, v, v, v, v, v, v}; }
    return c;
}
__device__ __forceinline__ void issue_piece(const WCtx& c, const bf16* Kb, const bf16* Vb, unsigned rowidx, unsigned tile_lds, int pc) {
    const unsigned cch = c.lane & 7, rl = c.lane >> 3;
    unsigned ko = rowidx * 128u + ((cch ^ rl) << 4); asm volatile("" : "+v"(ko));
    unsigned vo = rowidx * 128u + ((cch ^ (((rl >> 1) & 1) << 2)) << 4); asm volatile("" : "+v"(vo));
    glds16((const char*)Kb + ko, (unsigned)__builtin_amdgcn_readfirstlane(tile_lds + pc * 1024));
    glds16((const char*)Vb + vo, (unsigned)__builtin_amdgcn_readfirstlane(tile_lds + 8192 + pc * 1024));
}
__device__ __forceinline__ void issue_k_piece(const WCtx& c, const bf16* Kb, unsigned rowidx, unsigned tile_lds, int pc) {
    const unsigned cch = c.lane & 7, rl = c.lane >> 3;
    unsigned ko = rowidx * 128u + ((cch ^ rl) << 4); asm volatile("" : "+v"(ko));
    glds16((const char*)Kb + ko, (unsigned)__builtin_amdgcn_readfirstlane(tile_lds + pc * 1024));
}
__device__ __forceinline__ void issue_v_piece(const WCtx& c, const bf16* Vb, unsigned rowidx, unsigned tile_lds, int pc) {
    const unsigned cch = c.lane & 7, rl = c.lane >> 3;
    unsigned vo = rowidx * 128u + ((cch ^ (((rl >> 1) & 1) << 2)) << 4); asm volatile("" : "+v"(vo));
    glds16((const char*)Vb + vo, (unsigned)__builtin_amdgcn_readfirstlane(tile_lds + 8192 + pc * 1024));
}
__device__ __forceinline__ void vm_wait8() { asm volatile("s_waitcnt vmcnt(8)" ::: "memory"); }
__device__ __forceinline__ void vm_wait0() { asm volatile("s_waitcnt vmcnt(0)" ::: "memory"); }
__device__ __forceinline__ void lgkm_wait0() { asm volatile("s_waitcnt lgkmcnt(0)" ::: "memory"); }

__device__ __forceinline__ void tile_qk(const WCtx& c, lds_cptr kt, const bf16x8 (&qr)[4], f32x16& p0, f32x16& p1) {
#pragma unroll
    for (int d0 = 0; d0 < 4; ++d0) {
        const unsigned off = c.koff ^ (d0 << 5);
        const bf16x8 b0 = *(LAS const bf16x8*)(kt + off), b1 = *(LAS const bf16x8*)(kt + off + 4096);
        p0 = __builtin_amdgcn_mfma_f32_32x32x16_bf16(b0, qr[d0], p0, 0, 0, 0);
        p1 = __builtin_amdgcn_mfma_f32_32x32x16_bf16(b1, qr[d0], p1, 0, 0, 0);
    }
}
#ifndef MK_LSUM
#define MK_LSUM 1
#endif
#ifndef MK_BIGL
#define MK_BIGL 0x1p40f
#endif
constexpr float BIGL = MK_BIGL;
#ifndef MK_NOPK
#define MK_NOPK 1
#endif
#ifndef MK_DIL_PF
#define MK_DIL_PF 0
#endif
#ifndef MK_MOBA_PF
#define MK_MOBA_PF 1
#endif
#ifndef MK_PIPE
#define MK_PIPE 0
#endif
#ifndef MK_QKSPLIT
#define MK_QKSPLIT 0
#endif
#ifndef MK_PRIO
#define MK_PRIO 2
#endif
template <bool LS = false> __device__ __forceinline__ void tile_pv(const WCtx& c, lds_cptr vt, f32x16& o0, f32x16& o1, const f32x16& p0, const f32x16& p1, f32x4* ls = nullptr) {
    u32x4 pw[4];
#pragma unroll
    for (int k = 0; k < 2; ++k) {
        pw[k]     = (u32x4){cvtpk(p0[8 * k], p0[8 * k + 1]), cvtpk(p0[8 * k + 2], p0[8 * k + 3]), cvtpk(p0[8 * k + 4], p0[8 * k + 5]), cvtpk(p0[8 * k + 6], p0[8 * k + 7])};
        pw[2 + k] = (u32x4){cvtpk(p1[8 * k], p1[8 * k + 1]), cvtpk(p1[8 * k + 2], p1[8 * k + 3]), cvtpk(p1[8 * k + 4], p1[8 * k + 5]), cvtpk(p1[8 * k + 6], p1[8 * k + 7])};
    }
    lds_cptr v0p = vt + c.voff, v1p = vt + (c.voff ^ 64u);
#pragma unroll
    for (int ks = 0; ks < 4; ++ks) {
        const v4i16_t l0 = vtr(v0p + ks * 2048), h0 = vtr(v0p + ks * 2048 + 1024), l1 = vtr(v1p + ks * 2048), h1 = vtr(v1p + ks * 2048 + 1024);
        const bf16x8 v0 = (bf16x8){l0[0], l0[1], l0[2], l0[3], h0[0], h0[1], h0[2], h0[3]};
        const bf16x8 v1 = (bf16x8){l1[0], l1[1], l1[2], l1[3], h1[0], h1[1], h1[2], h1[3]};
        const bf16x8 pf = __builtin_bit_cast(bf16x8, pw[ks]);
#if MK_PRIO >= 2
        if (LS) __builtin_amdgcn_s_setprio(1);
#endif
        if (LS) *ls = __builtin_amdgcn_mfma_f32_16x16x32_bf16(c.lsel, pf, *ls, 0, 0, 0);
        o0 = __builtin_amdgcn_mfma_f32_32x32x16_bf16(v0, pf, o0, 0, 0, 0);
        o1 = __builtin_amdgcn_mfma_f32_32x32x16_bf16(v1, pf, o1, 0, 0, 0);
#if MK_PRIO >= 2
        if (LS) __builtin_amdgcn_s_setprio(0);
#endif
    }
}
#if MK_LSUM
struct AState { f32x16 o0, o1; f32x4 ls; float mhat; bool sh; };
__device__ __forceinline__ void astate_init(AState& s) {
#pragma unroll
    for (int r = 0; r < 16; ++r) { s.o0[r] = 0.f; s.o1[r] = 0.f; }
    s.ls = (f32x4){0.f, 0.f, 0.f, 0.f}; s.mhat = 0.f; s.sh = false;
}
#else
struct AState { f32x16 o0, o1, nv; float mhat, l; };
__device__ __forceinline__ void astate_init(AState& s) {
#pragma unroll
    for (int r = 0; r < 16; ++r) { s.o0[r] = 0.f; s.o1[r] = 0.f; s.nv[r] = 0.f; }
    s.mhat = 0.f; s.l = 0.f;
}
#endif
#if MK_LSUM
__device__ __forceinline__ float astate_l(const AState& st, const WCtx& c) {
    const float a = __shfl(st.ls[0], c.r32 & 15), b = __shfl(st.ls[1], c.r32 & 15); return (c.r32 & 16) ? b : a;
}
__device__ __forceinline__ void astate_recheck(AState& st, const WCtx& c) {
    if (__any(fmaxf(st.ls[0], st.ls[1]) > BIGL)) {
        asm volatile("" ::: "memory");
        const float d0 = st.ls[0] > BIGL ? __builtin_log2f(st.ls[0]) : 0.f, d1 = st.ls[1] > BIGL ? __builtin_log2f(st.ls[1]) : 0.f;
        const float a = __shfl(d0, c.r32 & 15), b = __shfl(d1, c.r32 & 15); const float dl = (c.r32 & 16) ? b : a;
        st.mhat += dl; st.sh = true;
        const float f = fast_exp2(-dl);
#pragma unroll
        for (int r = 0; r < 16; ++r) { st.o0[r] *= f; st.o1[r] *= f; }
        st.ls[0] *= fast_exp2(-d0); st.ls[1] *= fast_exp2(-d1);
    }
}
__device__ __forceinline__ void astate_shift(const AState& st, f32x16& p0, f32x16& p1) {
    if (st.sh) {
        asm volatile("" ::: "memory");
#pragma unroll
        for (int r = 0; r < 16; ++r) { p0[r] -= st.mhat; p1[r] -= st.mhat; }
    }
}
#endif
struct NoHook { __device__ __forceinline__ void operator()() const {} };
template <class BiasF, class H1 = NoHook, class H2 = NoHook, class H3 = NoHook>
__device__ __forceinline__ void tile_step(const WCtx& c, unsigned tile, AState& st, const bf16x8 (&qr)[4], BiasF biasf, H1 h1 = H1(), H2 h2 = H2(), H3 h3 = H3()) {
#if MK_LSUM
    astate_recheck(st, c);
    f32x16 p0, p1;
#pragma unroll
    for (int r = 0; r < 16; ++r) { p0[r] = biasf(r, 0); p1[r] = biasf(r, 1); }
    tile_qk(c, c.ldsp + tile, qr, p0, p1);
    h1();
    astate_shift(st, p0, p1);
#pragma unroll
    for (int r = 0; r < 16; ++r) { p0[r] = fast_exp2(p0[r]); p1[r] = fast_exp2(p1[r]); }
    h2();
    tile_pv<true>(c, c.ldsp + tile, st.o0, st.o1, p0, p1, &st.ls);
    h3();
#else
    f32x16 p0 = st.nv, p1 = st.nv;
    tile_qk(c, c.ldsp + tile, qr, p0, p1);
    h1();
    float rm = -INFINITY;
#pragma unroll
    for (int r = 0; r < 16; ++r) { p0[r] = __builtin_fmaf(p0[r], C2, biasf(r, 0)); rm = fmaxf(rm, p0[r]); }
#pragma unroll
    for (int r = 0; r < 16; ++r) { p1[r] = __builtin_fmaf(p1[r], C2, biasf(r, 1)); rm = fmaxf(rm, p1[r]); }
    float sum = 0.f;
#pragma unroll
    for (int r = 0; r < 16; ++r) { p0[r] = fast_exp2(p0[r]); p1[r] = fast_exp2(p1[r]); sum += p0[r] + p1[r]; }
    st.l += sum;
    h2();
    tile_pv(c, c.ldsp + tile, st.o0, st.o1, p0, p1);
    h3();
    rm = max_x32(rm);
    if (__any(rm > THR)) {
        asm volatile("" ::: "memory");
        const float dl = fmaxf(rm, 0.f);
        st.mhat += dl; const float ng = -st.mhat * (1.0f / C2);
        const float f = fast_exp2(-dl);
        st.l *= f;
#pragma unroll
        for (int r = 0; r < 16; ++r) { st.o0[r] *= f; st.o1[r] *= f; st.nv[r] = ng; }
    }
#endif
}
__device__ __forceinline__ void bias_ld(LAS const float* P0_, f32x16& p0, f32x16& p1) {
    unsigned pa = (unsigned)(size_t)P0_; asm volatile("" : "+v"(pa)); LAS const float* P0 = (LAS const float*)(size_t)pa;
#pragma unroll
    for (int r = 0; r < 16; ++r) { p0[r] = P0[(r & 3) + 8 * (r >> 2)]; p1[r] = P0[32 + (r & 3) + 8 * (r >> 2)]; }
}
template <int G = 0, class H1 = NoHook, class H2 = NoHook, class H3 = NoHook>
__device__ __forceinline__ void tile_step_fast(const WCtx& c, unsigned tile, AState& st, const bf16x8 (&qr)[4], f32x16 p0, f32x16 p1, H1 h1 = H1(), H2 h2 = H2(), H3 h3 = H3()) {
    if (G == 6) { return; }
#if MK_LSUM
    astate_recheck(st, c);
#endif
    lds_cptr kt = c.ldsp + tile;
    bf16x8 kf[8];
#pragma unroll
    for (int d0 = 0; d0 < 4; ++d0) { const unsigned off = c.koff ^ (d0 << 5); kf[2 * d0] = *(LAS const bf16x8*)(kt + off); kf[2 * d0 + 1] = *(LAS const bf16x8*)(kt + off + 4096); }
#if MK_LSUM
    __builtin_amdgcn_sched_barrier(0);
#if MK_PRIO
    __builtin_amdgcn_s_setprio(1);
#endif
#if MK_QKSPLIT
#pragma unroll
    for (int d0 = 0; d0 < 4; ++d0) p0 = __builtin_amdgcn_mfma_f32_32x32x16_bf16(kf[2 * d0], qr[d0], p0, 0, 0, 0);
#pragma unroll
    for (int d0 = 0; d0 < 4; ++d0) p1 = __builtin_amdgcn_mfma_f32_32x32x16_bf16(kf[2 * d0 + 1], qr[d0], p1, 0, 0, 0);
#else
#pragma unroll
    for (int d0 = 0; d0 < 4; ++d0) {
        p0 = __builtin_amdgcn_mfma_f32_32x32x16_bf16(kf[2 * d0], qr[d0], p0, 0, 0, 0);
        p1 = __builtin_amdgcn_mfma_f32_32x32x16_bf16(kf[2 * d0 + 1], qr[d0], p1, 0, 0, 0);
    }
#endif
#if MK_PRIO
    __builtin_amdgcn_s_setprio(0);
    __builtin_amdgcn_sched_barrier(0);
#endif
#else
    float bv0[16], bv1[16];
#pragma unroll
    for (int r = 0; r < 16; ++r) { bv0[r] = P0[63 - ((r & 3) + 8 * (r >> 2))]; bv1[r] = P0[31 - ((r & 3) + 8 * (r >> 2))]; }
    __builtin_amdgcn_sched_barrier(0);
    f32x16 p0 = __builtin_amdgcn_mfma_f32_32x32x16_bf16(kf[0], qr[0], st.nv, 0, 0, 0);
    f32x16 p1 = __builtin_amdgcn_mfma_f32_32x32x16_bf16(kf[1], qr[0], st.nv, 0, 0, 0);
#pragma unroll
    for (int d0 = 1; d0 < 4; ++d0) {
        p0 = __builtin_amdgcn_mfma_f32_32x32x16_bf16(kf[2 * d0], qr[d0], p0, 0, 0, 0);
        p1 = __builtin_amdgcn_mfma_f32_32x32x16_bf16(kf[2 * d0 + 1], qr[d0], p1, 0, 0, 0);
    }
#endif
    h1();
#if MK_LSUM
    astate_shift(st, p0, p1);
#pragma unroll
    for (int r = 0; r < 16; ++r) { p0[r] = fast_exp2(p0[r]); p1[r] = fast_exp2(p1[r]); }
    h2();
    tile_pv<true>(c, c.ldsp + tile, st.o0, st.o1, p0, p1, &st.ls);
    h3();
#else
    float rm = -INFINITY;
#pragma unroll
    for (int r = 0; r < 16; ++r) { p0[r] = __builtin_fmaf(p0[r], C2, bv0[r]); rm = fmaxf(rm, p0[r]); }
#pragma unroll
    for (int r = 0; r < 16; ++r) { p1[r] = __builtin_fmaf(p1[r], C2, bv1[r]); rm = fmaxf(rm, p1[r]); }
    float sum = 0.f;
#pragma unroll
    for (int r = 0; r < 16; ++r) { p0[r] = fast_exp2(p0[r]); p1[r] = fast_exp2(p1[r]); sum += p0[r] + p1[r]; }
    st.l += sum;
    h2();
    tile_pv(c, c.ldsp + tile, st.o0, st.o1, p0, p1);
    h3();
    rm = max_x32(rm);
    if (__any(rm > THR)) {
        asm volatile("" ::: "memory");
        const float dl = fmaxf(rm, 0.f);
        st.mhat += dl; const float ng = -st.mhat * (1.0f / C2);
        const float f = fast_exp2(-dl);
        st.l *= f;
#pragma unroll
        for (int r = 0; r < 16; ++r) { st.o0[r] *= f; st.o1[r] *= f; st.nv[r] = ng; }
    }
#endif
}
__device__ __forceinline__ void qk_issue(const WCtx& c, unsigned ktile, const bf16x8 (&qr)[4], f32x16& p0, f32x16& p1) {
    lds_cptr kt = c.ldsp + ktile;
    bf16x8 kf[8];
#pragma unroll
    for (int d0 = 0; d0 < 4; ++d0) { const unsigned off = c.koff ^ (d0 << 5); kf[2 * d0] = *(LAS const bf16x8*)(kt + off); kf[2 * d0 + 1] = *(LAS const bf16x8*)(kt + off + 4096); }
    __builtin_amdgcn_sched_barrier(0);
    __builtin_amdgcn_s_setprio(1);
#pragma unroll
    for (int d0 = 0; d0 < 4; ++d0) {
        p0 = __builtin_amdgcn_mfma_f32_32x32x16_bf16(kf[2 * d0], qr[d0], p0, 0, 0, 0);
        p1 = __builtin_amdgcn_mfma_f32_32x32x16_bf16(kf[2 * d0 + 1], qr[d0], p1, 0, 0, 0);
    }
    __builtin_amdgcn_s_setprio(0);
}
__device__ __forceinline__ void sm_pv(const WCtx& c, unsigned vtile, AState& st, f32x16 p0, f32x16 p1) {
    astate_recheck(st, c);
    astate_shift(st, p0, p1);
#pragma unroll
    for (int r = 0; r < 16; ++r) { p0[r] = fast_exp2(p0[r]); p1[r] = fast_exp2(p1[r]); }
    tile_pv<true>(c, c.ldsp + vtile, st.o0, st.o1, p0, p1, &st.ls);
}
__device__ __forceinline__ void issue_piece_kv(const WCtx& c, const bf16* Kb, const bf16* Vb, unsigned rowidx, unsigned kt_off, unsigned vt_off, int pc) {
    issue_k_piece(c, Kb, rowidx, c.lds0 + kt_off, pc); issue_v_piece(c, Vb, rowidx, c.lds0 + vt_off, pc);
}
__device__ __forceinline__ void astate_fold(const AState& st, const WCtx& c, float w, f32x16& a0, f32x16& a1) {
#if MK_LSUM
    const float lt = astate_l(st, c);
#else
    const float lt = sum_x32(st.l);
#endif
    const float sc = lt > 0.f ? w / lt : 0.f;
#pragma unroll
    for (int r = 0; r < 16; ++r) { a0[r] += st.o0[r] * sc; a1[r] += st.o1[r] * sc; }
}
__device__ __forceinline__ void store_o(const WCtx& c, bf16* orow, const f32x16& a0, const f32x16& a1) {
#pragma unroll
    for (int g = 0; g < 4; ++g) {
        u32x2 w0, w1; w0.x = cvtpk(a0[4 * g], a0[4 * g + 1]); w0.y = cvtpk(a0[4 * g + 2], a0[4 * g + 3]); w1.x = cvtpk(a1[4 * g], a1[4 * g + 1]); w1.y = cvtpk(a1[4 * g + 2], a1[4 * g + 3]);
        *(u32x2*)(orow + 8 * g + 4 * c.hi) = w0; *(u32x2*)(orow + 32 + 8 * g + 4 * c.hi) = w1;
    }
}
__device__ __forceinline__ void load_q(bf16x8 (&qr)[4], const bf16* qrow, int hi) {
#pragma unroll
    for (int d0 = 0; d0 < 4; ++d0) qr[d0] = *(const bf16x8*)(qrow + d0 * 16 + hi * 8);
}
__device__ __forceinline__ void lds_or(LAS unsigned* p, unsigned v) { __hip_atomic_fetch_or(p, v, __ATOMIC_RELAXED, __HIP_MEMORY_SCOPE_WORKGROUP); }
template <int N> __device__ __forceinline__ void build_tab_ld(float (&v)[(N + 511) / 512], const float* biasd_h, int maxd, int tid) {
    asm volatile("" : "+v"(tid));
#pragma unroll
    for (int j = 0; j < (N + 511) / 512; ++j) { const int d = tid + 512 * j - 64; v[j] = biasd_h[clampi(d, 0, maxd)]; }
}
template <int N> __device__ __forceinline__ void build_tab_st(LAS float* tab, const float (&v)[(N + 511) / 512], int maxd, int tid) {
    asm volatile("" : "+v"(tid));
#pragma unroll
    for (int j = 0; j < (N + 511) / 512; ++j) { const int i = tid + 512 * j, d = i - 64; if (i < N) tab[N - 1 - i] = (d < 0 || d > maxd) ? -INFINITY : v[j]; }
}
template <int N> __device__ __forceinline__ void build_tab(LAS float* tab, const float* biasd_h, int maxd, int tid) {
    float v[(N + 511) / 512]; build_tab_ld<N>(v, biasd_h, maxd, tid); build_tab_st<N>(tab, v, maxd, tid);
}

constexpr int UW_OFF = 32768, TABF = 2112, TABWN = 704, MOBA_BUF1 = 49152;
#ifndef MK_TWO
#define MK_TWO 0
#endif
template <int GH = 0> __device__ __forceinline__ void moba_unit(LAS unsigned char* L_, int wid, int b, int h, int j, const bf16* Q, const bf16* K, const bf16* V, bf16* O, LAS const float* tab, LAS const float* km, float* probe_out = nullptr) {
    const WCtx c = make_ctx(L_);
#if MK_PROBE >= 11
    const unsigned long long mp_t0 = __builtin_amdgcn_s_memrealtime(); unsigned long long mp_acc = 0; unsigned mp_n = 0;
#endif
    const size_t hb = (size_t)(b * NH + h) * SEQ;
    const bf16* Kb = K + hb * HD; const bf16* Vb = V + hb * HD;
    const int t0 = 256 * j + 32 * wid, tq = t0 + c.r32;
    const bf16* qrow = Q + (hb + tq) * HD;
    if (GH != 1) issue_piece(c, Kb, Vb, (unsigned)(256 * j + 8 * wid + (c.lane >> 3)), c.lds0, wid);
#if MK_TWO
    issue_piece(c, Kb, Vb, (unsigned)(256 * j + 64 + 8 * wid + (c.lane >> 3)), c.lds0 + TILE_B, wid);
#endif
    bf16x8 qr[4]; load_q(qr, qrow, c.hi);
    unsigned sel = 0u;
    if (j > 0) {
        float g4[4] = {0.f, 0.f, 0.f, 0.f};
#pragma unroll
        for (int ch = 0; ch < 8; ++ch) {
            const u32x4 qq = *(const u32x4*)(qrow + 8 * ch);
            const float qf[8] = {__builtin_bit_cast(float, qq.x << 16), __builtin_bit_cast(float, qq.x & 0xffff0000u), __builtin_bit_cast(float, qq.y << 16), __builtin_bit_cast(float, qq.y & 0xffff0000u),
                                 __builtin_bit_cast(float, qq.z << 16), __builtin_bit_cast(float, qq.z & 0xffff0000u), __builtin_bit_cast(float, qq.w << 16), __builtin_bit_cast(float, qq.w & 0xffff0000u)};
#pragma unroll
            for (int k = 0; k < 4; ++k) { LAS const float* kr = km + (2 * k + c.hi) * 64 + 8 * ch;
                const f32x4 a = *(LAS const f32x4*)kr, bq = *(LAS const f32x4*)(kr + 4);
                g4[k] += (qf[0] * a[0] + qf[1] * a[1]) + (qf[2] * a[2] + qf[3] * a[3]) + (qf[4] * bq[0] + qf[5] * bq[1]) + (qf[6] * bq[2] + qf[7] * bq[3]); }
        }
        float ga[8];
#pragma unroll
        for (int k = 0; k < 4; ++k) { const float ot = __shfl_xor(g4[k], 32); ga[2 * k] = c.hi ? ot : g4[k]; ga[2 * k + 1] = c.hi ? g4[k] : ot; }
#pragma unroll
        for (int n = 0; n < 8; ++n) if (n >= j) ga[n] = -INFINITY;
#pragma unroll
        for (int n = 0; n < 8; ++n) { int rank = 0;
#pragma unroll
            for (int n2 = 0; n2 < 8; ++n2) if (n2 != n) rank += (n2 < n) ? (ga[n2] >= ga[n] ? 1 : 0) : (ga[n2] > ga[n] ? 1 : 0);
            if (rank < 3 && n < j) sel |= 1u << n; }
    }
    LAS unsigned* UW = (LAS unsigned*)(L_ + UW_OFF);
    if (j > 0) { lds_or(UW, sel); lds_or(UW + 1 + wid, sel); }
    vm_wait0(); __syncthreads();
    const unsigned U = __builtin_amdgcn_readfirstlane(UW[0]), wsel = __builtin_amdgcn_readfirstlane(UW[1 + wid]);
    AState st; astate_init(st);
    const int ntile = 4 + 4 * __builtin_popcount(U);
    int blk = j, kt = 0; unsigned rest = U; int slot = 0;
#if MK_TWO
    int pblk = j; unsigned prest = U;
#endif
#if MK_PROBE >= 11
    const unsigned long long mp_t1 = __builtin_amdgcn_s_memrealtime();
#endif
#if MK_PIPE
    {
        constexpr unsigned TV2 = 32768;
        auto tv_off = [](int s) -> unsigned { return s == 2 ? TV2 : (unsigned)s * TILE_B; };
        auto is_active = [&](int bk, int k) { return (bk == j) ? (k <= (wid >> 1)) : (((wsel >> bk) & 1u) != 0u); };
        auto bias_ptr = [&](int bk, int k) { const bool mn = (bk == j) ? true : (((sel >> bk) & 1u) != 0u); return tab + (TABF - 64 - (mn ? (tq - (256 * bk + 64 * k) + 1 - 4 * c.hi) : 0)); };
        int b1 = j, k1 = 1, b2 = j, k2 = 2; unsigned r2 = U;
        issue_piece_kv(c, Kb, Vb, (unsigned)(256 * b1 + 64 * k1 + 8 * wid + (c.lane >> 3)), TILE_B, tv_off(1), wid);
        f32x16 p0, p1, n0, n1;
        bias_ld(bias_ptr(j, 0), p0, p1);
        qk_issue(c, 0u, qr, p0, p1);
        if (is_active(b1, k1)) bias_ld(bias_ptr(b1, k1), n0, n1);
        int vs = 0;
        for (int it = 0; it < ntile; ++it) {
            if (it + 1 < ntile) { vm_wait0(); __syncthreads(); }
            if (it + 2 < ntile) issue_piece_kv(c, Kb, Vb, (unsigned)(256 * b2 + 64 * k2 + 8 * wid + (c.lane >> 3)), (unsigned)(it & 1) * TILE_B, tv_off(vs == 0 ? 2 : vs - 1), wid);
            const bool act = is_active(blk, kt), actn = (it + 1 < ntile) && is_active(b1, k1);
            if (actn) qk_issue(c, (unsigned)((it + 1) & 1) * TILE_B, qr, n0, n1);
            if (act) sm_pv(c, tv_off(vs), st, p0, p1);
            p0 = n0; p1 = n1;
            if (it + 2 < ntile && is_active(b2, k2)) bias_ld(bias_ptr(b2, k2), n0, n1);
            blk = b1; kt = k1; b1 = b2; k1 = k2;
            if (++k2 == 4) { k2 = 0; b2 = __builtin_ctz(r2 | 0x80000000u); r2 &= r2 - 1; }
            vs = vs == 2 ? 0 : vs + 1;
        }
    }
#else
    f32x16 bb0, bb1;
#if MK_MOBA_PF
    bias_ld(tab + (TABF - 64 - (tq - 256 * j + 1 - 4 * c.hi)), bb0, bb1);
#endif
    for (int it = 0; it < ntile; ++it) {
#if MK_PROBE >= 15
        const unsigned long long mp_b = __builtin_amdgcn_s_memrealtime();
#endif
        int nblk = blk, nkt = kt + 1; unsigned nrest = rest;
        if (nkt == 4) { nkt = 0; nblk = __builtin_ctz(nrest | 0x80000000u); nrest &= nrest - 1; }
#if MK_TWO
        if ((it & 1) == 0) {
            if (it) { vm_wait0(); __syncthreads(); }
            if (it + 2 < ntile) {
                if (((it + 2) & 3) == 0) { pblk = __builtin_ctz(prest | 0x80000000u); prest &= prest - 1; }
                const unsigned nb_off = (((it >> 1) + 1) & 1) ? (unsigned)MOBA_BUF1 : 0u; const int pk = (it + 2) & 3;
                issue_piece(c, Kb, Vb, (unsigned)(256 * pblk + 64 * pk + 8 * wid + (c.lane >> 3)), c.lds0 + nb_off, wid);
                issue_piece(c, Kb, Vb, (unsigned)(256 * pblk + 64 * (pk + 1) + 8 * wid + (c.lane >> 3)), c.lds0 + nb_off + TILE_B, wid);
            }
        }
        const unsigned tile_off = (((it >> 1) & 1) ? (unsigned)MOBA_BUF1 : 0u) + (unsigned)(it & 1) * TILE_B;
#else
        if (it) { vm_wait0(); if (GH != 2) __syncthreads(); }
        if (GH != 1 && it + 1 < ntile) issue_piece(c, Kb, Vb, (unsigned)(256 * nblk + 64 * nkt + 8 * wid + (c.lane >> 3)), c.lds0 + (slot ^ 1) * TILE_B, wid);
        const unsigned tile_off = (unsigned)slot * TILE_B;
#endif
        const int k0 = 256 * blk + 64 * kt;
        const bool own = (blk == j);
        const bool mine = own ? true : ((sel >> blk) & 1u);
        const bool active = own ? (kt <= (wid >> 1)) : ((wsel >> blk) & 1u);
#if MK_PROBE == 15
        mp_acc += __builtin_amdgcn_s_memrealtime() - mp_b; ++mp_n;
#endif
        if (active) {
            if (MK_STAGGER && wid >= 4) __builtin_amdgcn_s_sleep(MK_STAGGER);
#if MK_PROBE >= 11 && MK_PROBE < 15
            const unsigned long long mp_a = __builtin_amdgcn_s_memrealtime();
#endif
#if !MK_MOBA_PF
            bias_ld(tab + (TABF - 64 - (mine ? (tq - k0 + 1 - 4 * c.hi) : 0)), bb0, bb1);
#endif
            tile_step_fast(c, tile_off, st, qr, bb0, bb1);
#if MK_PROBE >= 11 && MK_PROBE < 15
            asm volatile("s_nop 0" :: "v"(st.o0[0]), "v"(st.o1[15])); mp_acc += __builtin_amdgcn_s_memrealtime() - mp_a; ++mp_n;
#endif
        }
#if MK_PROBE == 16
        asm volatile("s_nop 0" :: "v"(st.o0[0]), "v"(st.o1[15])); mp_acc += __builtin_amdgcn_s_memrealtime() - mp_b; ++mp_n;
#endif
        if (MK_MOBA_PF && it + 1 < ntile) {
            const bool nown = (nblk == j);
            const bool nmine = nown ? true : ((sel >> nblk) & 1u);
            const bool nactive = nown ? (nkt <= (wid >> 1)) : ((wsel >> nblk) & 1u);
            if (nactive) bias_ld(tab + (TABF - 64 - (nmine ? (tq - (256 * nblk + 64 * nkt) + 1 - 4 * c.hi) : 0)), bb0, bb1);
        }
        blk = nblk; kt = nkt; rest = nrest; slot ^= 1;
    }
#endif
    f32x16 a0, a1;
#pragma unroll
    for (int r = 0; r < 16; ++r) { a0[r] = 0.f; a1[r] = 0.f; }
    astate_fold(st, c, 1.0f, a0, a1);
    if (GH == 0 || a0[0] == 123456.789f) store_o(c, O + ((size_t)b * SEQ + tq) * DM + h * HD, a0, a1);
#if MK_PROBE >= 11
    if (MK_PROBE < 20 && blockIdx.x == 0 && threadIdx.x == 0 && j == 7 && probe_out) { const unsigned long long mp_t2 = __builtin_amdgcn_s_memrealtime();
        probe_out[0] = (MK_PROBE == 11 || MK_PROBE >= 15) ? (float)mp_acc / (float)(mp_n ? mp_n : 1) : (MK_PROBE == 12) ? (float)(mp_t1 - mp_t0) : (MK_PROBE == 13) ? (float)(mp_t2 - mp_t0) : (float)mp_n; }
#endif
    if (threadIdx.x < 9) UW[threadIdx.x] = 0u;
    lgkm_wait0(); __syncthreads();
}

constexpr int DT_LEN = 258, DT1_OFF = 0, DT4_OFF = 16 * DT_LEN, DT16_OFF = 20 * DT_LEN, DT_TOTAL = 21 * DT_LEN;
__device__ __forceinline__ void build_dil_tabs(LAS float* tab, const float* biasd_h, int tid) {
    constexpr int IT = (DT_TOTAL + 511) / 512;
    float v[IT];
    asm volatile("" : "+v"(tid));
#pragma unroll
    for (int j = 0; j < IT; ++j) { const int i = tid + 512 * j, cp = i / DT_LEN, e = i - cp * DT_LEN, step = e - 64;
        const int r = cp < 16 ? 1 : cp < 20 ? 4 : 16, maxstep = r == 16 ? 127 : 128;
        v[j] = biasd_h[r * clampi(step, 0, maxstep)]; }
#pragma unroll
    for (int j = 0; j < IT; ++j) { const int i = tid + 512 * j, cp = i / DT_LEN, e = i - cp * DT_LEN, step = e - 64;
        const int r = cp < 16 ? 1 : cp < 20 ? 4 : 16, maxstep = r == 16 ? 127 : 128;
        if (i < DT_TOTAL) tab[cp * DT_LEN + (DT_LEN - 1 - e)] = (step < 0 || step > maxstep) ? -INFINITY : v[j]; }
}
template <int PASS> __device__ __forceinline__ void dil_wave(LAS unsigned char* L_, int wid, int b, int h, int chunk, int idx, const bf16* Q, const bf16* K, const bf16* V, bf16* O, LAS const float* tab,
                                                             bf16* SO, float* SM, float* SL) {
    const WCtx c = make_ctx(L_);
    const size_t hb = (size_t)(b * NH + h) * SEQ;
    const bf16* Kb = K + hb * HD; const bf16* Vb = V + hb * HD;
    const int t0 = 512 * chunk + (PASS == 0 ? 32 * idx : idx), tq = t0 + (PASS == 0 ? c.r32 : 16 * c.r32);
    const size_t srow = (size_t)(b * 8 + (h - 8)) * SEQ + tq;
    bf16x8 qr[4]; load_q(qr, Q + (hb + tq) * HD, c.hi);
    AState st; astate_init(st);
    if (PASS == 1) {
        const bf16* sp = SO + srow * HD + 4 * c.hi;
#pragma unroll
        for (int g = 0; g < 4; ++g) { const u32x2 w0 = __builtin_nontemporal_load((const u32x2*)(sp + 8 * g)), w1 = __builtin_nontemporal_load((const u32x2*)(sp + 32 + 8 * g));
            st.o0[4 * g] = __builtin_bit_cast(float, w0.x << 16); st.o0[4 * g + 1] = __builtin_bit_cast(float, w0.x & 0xffff0000u); st.o0[4 * g + 2] = __builtin_bit_cast(float, w0.y << 16); st.o0[4 * g + 3] = __builtin_bit_cast(float, w0.y & 0xffff0000u);
            st.o1[4 * g] = __builtin_bit_cast(float, w1.x << 16); st.o1[4 * g + 1] = __builtin_bit_cast(float, w1.x & 0xffff0000u); st.o1[4 * g + 2] = __builtin_bit_cast(float, w1.y << 16); st.o1[4 * g + 3] = __builtin_bit_cast(float, w1.y & 0xffff0000u); }
        st.mhat = __builtin_nontemporal_load(SM + srow);
        const float lt = __builtin_nontemporal_load(SL + srow);
#if MK_LSUM
        st.sh = __any(st.mhat != 0.f);
        { const float lo = __shfl(lt, (c.lane & 15) + 16); st.ls[0] = c.lane < 16 ? lt : 0.f; st.ls[1] = c.lane < 16 ? lo : 0.f; }
#else
        { const float ng = -st.mhat * (1.0f / C2);
#pragma unroll
            for (int r = 0; r < 16; ++r) st.nv[r] = ng; }
        st.l = c.hi ? 0.f : lt;
#endif
    }
    const unsigned tile = wid * TILE_B, tile_lds = c.lds0 + tile;
    auto k0_of = [&](int br, int kt) { const int sh = 2 * br; return t0 - (128 << sh) + ((64 * kt) << sh); };
    auto advance = [&](int& br, int& kt) { for (;;) { ++kt; if (kt == (br == 0 ? 3 : br == 1 ? 4 : 3)) { kt = 0; ++br; if (PASS == 0) br = 3; } if (br >= 3) return; if (k0_of(br, kt) + (63 << (2 * br)) >= 0) return; } };
    auto issue_k = [&](int br, int kt) { const int sh = 2 * br, k0 = k0_of(br, kt);
#pragma unroll
        for (int pc = 0; pc < 8; ++pc) issue_k_piece(c, Kb, (unsigned)clampi(k0 + ((8 * pc + (c.lane >> 3)) << sh), 0, SEQ - 1), tile_lds, pc); };
    auto issue_v = [&](int br, int kt) { const int sh = 2 * br, k0 = k0_of(br, kt);
#pragma unroll
        for (int pc = 0; pc < 8; ++pc) issue_v_piece(c, Vb, (unsigned)clampi(k0 + ((8 * pc + (c.lane >> 3)) << sh), 0, SEQ - 1), tile_lds, pc); };
    int br = (PASS == 0) ? 0 : 1, kt = -1; advance(br, kt);
    lgkm_wait0();
    if (br < 3) { issue_k(br, kt); issue_v(br, kt); }
#pragma unroll 1
    while (br < 3) {
        int nbr = br, nkt = kt; advance(nbr, nkt);
        const bool has_next = nbr < 3;
        const int sh = 2 * br, k0 = k0_of(br, kt);
        LAS const float* tb = tab + (br == 0 ? DT1_OFF : br == 1 ? DT4_OFF : DT16_OFF);
        LAS const float* tcopy = tb + (br == 0 ? 0 : br == 1 ? ((c.r32 >> 3) & 3) : 0) * DT_LEN;
        const int sb = (tq - k0) >> sh;
        const bool fastp = k0 >= 0, inr = (sb >= -1) && (sb <= 128 + 63);
        f32x16 bb0, bb1;
#if MK_DIL_PF
        if (fastp) bias_ld(inr ? tcopy + (DT_LEN - 64 - (sb + 1 - 4 * c.hi)) : tb + (DT_LEN - 64), bb0, bb1);
#endif
        vm_wait8();
#if !MK_DIL_PF
        if (fastp) bias_ld(inr ? tcopy + (DT_LEN - 64 - (sb + 1 - 4 * c.hi)) : tb + (DT_LEN - 64), bb0, bb1);
#endif
        auto h1 = [&]() { lgkm_wait0(); if (has_next) issue_k(nbr, nkt); };
        auto h2 = [&]() { if (has_next) vm_wait8(); else vm_wait0(); };
        auto h3 = [&]() { lgkm_wait0(); if (has_next) issue_v(nbr, nkt); };
        if (fastp) {
            tile_step_fast<0>(c, tile, st, qr, bb0, bb1, h1, h2, h3);
        } else {
            const int lim = tq >> sh;
            tile_step(c, tile, st, qr, [&](int rr, int half) { const int s = sb - ((rr & 3) + 8 * (rr >> 2) + 4 * c.hi + 32 * half);
                return tb[DT_LEN - 1 - ((s > lim) ? 0 : clampi(s + 64, 0, DT_LEN - 1))]; }, h1, h2, h3);
        }
        br = nbr; kt = nkt;
    }
    if (PASS == 0) {
        store_o(c, SO + srow * HD, st.o0, st.o1);
#if MK_LSUM
        const float lt = astate_l(st, c);
#else
        const float lt = sum_x32(st.l);
#endif
        if (c.hi == 0) { SM[srow] = st.mhat; SL[srow] = lt; }
    } else {
        f32x16 a0, a1;
#pragma unroll
        for (int r = 0; r < 16; ++r) { a0[r] = 0.f; a1[r] = 0.f; }
        astate_fold(st, c, 1.0f, a0, a1);
        store_o(c, O + ((size_t)b * SEQ + tq) * DM + h * HD, a0, a1);
    }
    lgkm_wait0();
}

constexpr int IMP_OFF = 33024, SELW_OFF = 145664;
template <int GHOST> __device__ __forceinline__ void nsa_unit(int wid, LAS unsigned char* lds, int b, int g, int chunk, const bf16* Q, const bf16* KV1, const bf16* KC, const bf16* VC,
                                         const float* gates, bf16* O, LAS const float* tabs, float* probe_out = nullptr) {
    const WCtx c = make_ctx(lds);
#if MK_PROBE >= 3
    const unsigned long long pu_t0 = __builtin_amdgcn_s_memrealtime();
#endif
    const int hh = wid & 3, qt = wid >> 2, h = 4 * g + hh;
    LAS const float* tab = tabs + hh * TABF; LAS const float* tabw = tabs + 4 * TABF + hh * TABWN;
    const int t0 = 64 * chunk + 32 * qt, tq = t0 + c.r32, cur = chunk;
    const bool late = cur >= 16;
    const size_t qb = (size_t)(b * NH + h) * SEQ, gb = (size_t)(b * 4 + g) * SEQ, TS = (size_t)BATCH * 4 * SEQ * HD;
    const bf16* KCb = KC + (size_t)(b * 4 + g) * 128 * HD; const bf16* VCb = VC + (size_t)(b * 4 + g) * 128 * HD;
    issue_piece(c, KCb, VCb, (unsigned)(8 * wid + (c.lane >> 3)), c.lds0, wid);
    if (late) issue_piece(c, KCb, VCb, (unsigned)(64 + 8 * wid + (c.lane >> 3)), c.lds0 + TILE_B, wid);
    bf16x8 qr[4]; load_q(qr, Q + (qb + tq) * HD, c.hi);
    const float* grow = gates + ((size_t)b * SEQ + tq) * 48 + 3 * h;
    const float g0 = grow[0], g1 = grow[1], g2 = grow[2];
    f32x16 a0, a1;
#pragma unroll
    for (int r = 0; r < 16; ++r) { a0[r] = 0.f; a1[r] = 0.f; }
    vm_wait0(); __syncthreads();
#if MK_PROBE >= 3
    const unsigned long long pu_ta = __builtin_amdgcn_s_memrealtime();
#endif
    LAS float* IA = (LAS float*)(lds + IMP_OFF + wid * 8448); LAS float* IB = IA + 32 * 33;
    {
        f32x16 p[4];
        const int db = tq - 31 + 64 - 64 * c.hi;
#pragma unroll
        for (int T = 0; T < 4; ++T)
#pragma unroll
            for (int r = 0; r < 16; ++r) { const int idx = db - 16 * (32 * T + (r & 3) + 8 * (r >> 2)); p[T][r] = (T < 2 || late) ? tab[TABF - 1 - clampi(idx, 0, TABF - 1)] : 0.f; }
        tile_qk(c, c.ldsp, qr, p[0], p[1]);
        if (late) tile_qk(c, c.ldsp + TILE_B, qr, p[2], p[3]);
        float rm = -INFINITY;
#pragma unroll
        for (int T = 0; T < 4; ++T) { if (T < 2 || late) {
#pragma unroll
            for (int r = 0; r < 16; ++r) rm = fmaxf(rm, p[T][r]); } }
        rm = max_x32(rm);
        const float mu = fmaxf(rm, -1e30f);
        float lsum = 0.f;
#pragma unroll
        for (int T = 0; T < 4; ++T) { if (T < 2 || late) {
#pragma unroll
            for (int r = 0; r < 16; ++r) { p[T][r] = fast_exp2(p[T][r] - mu); lsum += p[T][r]; } } }
        lsum = sum_x32(lsum);
        const float linv = lsum > 0.f ? 1.0f / lsum : 0.f;
#pragma unroll
        for (int T = 0; T < 4; ++T)
#pragma unroll
            for (int r = 0; r < 16; ++r) p[T][r] *= linv;
        tile_pv(c, c.ldsp, a0, a1, p[0], p[1]);
        if (late) tile_pv(c, c.ldsp + TILE_B, a0, a1, p[2], p[3]);
#pragma unroll
        for (int r = 0; r < 16; ++r) { a0[r] *= g0; a1[r] *= g0; }
        if (late) {
#pragma unroll
            for (int T = 0; T < 4; ++T)
#pragma unroll
                for (int gq = 0; gq < 4; ++gq) { const int n = 8 * T + 2 * gq + c.hi; const float b3 = 16.f * p[T][4 * gq + 3];
                    IA[c.r32 * 33 + n] = 32.f * (p[T][4 * gq] + p[T][4 * gq + 1] + p[T][4 * gq + 2]) + b3; IB[c.r32 * 33 + n] = b3; }
        }
    }
    lgkm_wait0(); __syncthreads();
    const bf16* Ks = KV1 + 2 * TS + gb * HD; const bf16* Vs = KV1 + 3 * TS + gb * HD;
    const bf16* Kw = KV1 + 4 * TS + gb * HD; const bf16* Vw = KV1 + 5 * TS + gb * HD;
    if (GHOST != 1) issue_piece(c, Ks, Vs, (unsigned)(8 * wid + (c.lane >> 3)), c.lds0, wid);
    unsigned selm = (cur >= 31) ? 0xffffffffu : ((2u << cur) - 1u);
    LAS unsigned* UW = (LAS unsigned*)(lds + UW_OFF);
    if (late) {
        float imp[16];
#pragma unroll
        for (int k = 0; k < 16; ++k) imp[k] = 0.f;
#pragma unroll
        for (int w4 = 0; w4 < 4; ++w4) { LAS const float* A = (LAS const float*)(lds + IMP_OFF + (w4 + 4 * qt) * 8448) + c.r32 * 33; LAS const float* Bq = A + 32 * 33;
#pragma unroll
            for (int k = 0; k < 16; ++k) { const int n = 16 * c.hi + k; imp[k] += A[n] + (n > 0 ? Bq[n - 1] : 0.f); } }
        int mine[16], oth[16];
#pragma unroll
        for (int k = 0; k < 16; ++k) { const int n = 16 * c.hi + k; const bool valid = n <= cur, forced = (n == 0) || (n == cur) || (n == cur - 1);
            mine[k] = !valid ? -2 : forced ? 0x7f000000 : __builtin_bit_cast(int, imp[k]);
            oth[k] = __shfl_xor(mine[k], 32); }
        unsigned sm = 0u;
#pragma unroll
        for (int k = 0; k < 16; ++k) { if ((k >> 2) == hh) { int rank = 0; const int me = mine[k], me1 = mine[k] - 1, meo = mine[k] - c.hi;
#pragma unroll
            for (int k2 = 0; k2 < 16; ++k2) { if (k2 < k) rank += mine[k2] > me1 ? 1 : 0; else if (k2 > k) rank += mine[k2] > me ? 1 : 0; rank += oth[k2] > meo ? 1 : 0; }
            if (rank < 16) sm |= 1u << k; } }
        sm <<= 16 * c.hi;
        LAS unsigned* SELW = (LAS unsigned*)(lds + SELW_OFF) + 32 * qt + c.r32;
        lds_or(SELW, sm);
        lgkm_wait0(); __syncthreads();
        selm &= *SELW;
        lds_or(UW, selm); lds_or(UW + 1 + wid, selm);
        lgkm_wait0(); __syncthreads();
    }
    const unsigned U = late ? __builtin_amdgcn_readfirstlane(UW[0]) : ((cur >= 31) ? 0xffffffffu : ((2u << cur) - 1u)), wsel = late ? __builtin_amdgcn_readfirstlane(UW[1 + wid]) : U;
    LAS float* stash = (LAS float*)(lds + IMP_OFF + wid * 8448);
#pragma unroll
    for (int r = 0; r < 16; ++r) { stash[r * 64 + c.lane] = a0[r]; stash[(16 + r) * 64 + c.lane] = a1[r]; }
    const int nsel = __builtin_popcount(U);
    int wlo = 64 * chunk - 511; wlo = wlo < 0 ? 0 : wlo; const int w0 = wlo >> 6, nwin = chunk - w0 + 1;
    const int ntile = nsel + nwin;
    AState st; astate_init(st);
    unsigned rest = U & (U - 1); int slot = 0; int tn = 0;
    auto tile_bias = [&](int itx, int tnx, f32x16& b0, f32x16& b1) { const int k0x = 64 * tnx;
        if (itx < nsel) { if ((wsel >> tnx) & 1u) { const bool mn = (selm >> tnx) & 1u; bias_ld(tab + (TABF - 64 - (mn ? (tq - k0x + 1 - 4 * c.hi) : 0)), b0, b1); } }
        else if (k0x + 63 >= t0 - 511) bias_ld(tabw + (TABWN - 64 - (tq - k0x + 1 - 4 * c.hi)), b0, b1); };
    f32x16 bb0, bb1; tile_bias(0, 0, bb0, bb1);
#if MK_PROBE
    unsigned long long pr_acc = 0; unsigned pr_n = 0;
#endif
#if MK_PROBE >= 3
    const unsigned long long pu_t1 = __builtin_amdgcn_s_memrealtime();
#endif
    for (int it = 0; it < ntile; ++it) {
        const bool is_win = it >= nsel;
        const int nit = it + 1; const bool n_win = nit >= nsel;
        int ntn; unsigned nrest = rest;
        if (n_win) ntn = w0 + (nit - nsel); else { ntn = __builtin_ctz(nrest | 0x80000000u); nrest &= nrest - 1; }
#if MK_PROBE == 8 || MK_PROBE == 9
        const unsigned long long pw_t0 = __builtin_amdgcn_s_memrealtime();
        vm_wait0();
        const unsigned long long pw_t1 = __builtin_amdgcn_s_memrealtime();
        __syncthreads();
        const unsigned long long pw_t2 = __builtin_amdgcn_s_memrealtime();
        pr_acc += (MK_PROBE == 8) ? (pw_t1 - pw_t0) : (pw_t2 - pw_t1); ++pr_n;
#else
        vm_wait0(); if (GHOST != 2) __syncthreads();
#endif
        if (GHOST != 1 && nit < ntile) issue_piece(c, n_win ? Kw : Ks, n_win ? Vw : Vs, (unsigned)(64 * ntn + 8 * wid + (c.lane >> 3)), c.lds0 + (slot ^ 1) * TILE_B, wid);
        if (it == nsel) {
#pragma unroll
            for (int r = 0; r < 16; ++r) { a0[r] = stash[r * 64 + c.lane]; a1[r] = stash[(16 + r) * 64 + c.lane]; }
            astate_fold(st, c, g1, a0, a1); astate_init(st);
#pragma unroll
            for (int r = 0; r < 16; ++r) { stash[r * 64 + c.lane] = a0[r]; stash[(16 + r) * 64 + c.lane] = a1[r]; } }
        const int k0 = 64 * tn;
        if (!is_win) {
            if ((wsel >> tn) & 1u) {
#if MK_PROBE == 1 || MK_PROBE == 2
                const unsigned long long pr_t0 = (MK_PROBE == 1) ? __builtin_amdgcn_s_memtime() : __builtin_amdgcn_s_memrealtime();
#endif
                tile_step_fast<GHOST>(c, slot * TILE_B, st, qr, bb0, bb1);
#if MK_PROBE == 1 || MK_PROBE == 2
                asm volatile("s_nop 0" :: "v"(st.o0[0]), "v"(st.o1[15]));
                pr_acc += ((MK_PROBE == 1) ? __builtin_amdgcn_s_memtime() : __builtin_amdgcn_s_memrealtime()) - pr_t0; ++pr_n;
#endif
            }
        } else {
            if (k0 + 63 >= t0 - 511) {
                if (MK_STAGGER && wid >= 4) __builtin_amdgcn_s_sleep(MK_STAGGER);
                tile_step_fast<GHOST>(c, slot * TILE_B, st, qr, bb0, bb1); }
        }
        if (nit < ntile) tile_bias(nit, ntn, bb0, bb1);
        tn = ntn; rest = nrest; slot ^= 1;
    }
#pragma unroll
    for (int r = 0; r < 16; ++r) { a0[r] = stash[r * 64 + c.lane]; a1[r] = stash[(16 + r) * 64 + c.lane]; }
    astate_fold(st, c, g2, a0, a1);
    if (GHOST == 0 || a0[0] == 123456.789f) store_o(c, O + ((size_t)b * SEQ + tq) * DM + h * HD, a0, a1);
    if (threadIdx.x < 9) UW[threadIdx.x] = 0u;
    if (late && threadIdx.x < 64) ((LAS unsigned*)(lds + SELW_OFF))[threadIdx.x] = 0u;
#if MK_PROBE
#if MK_PROBE >= 3 && MK_PROBE <= 6
    { const unsigned long long pu_t2 = __builtin_amdgcn_s_memrealtime(); pr_acc = (MK_PROBE == 3) ? (pu_t1 - pu_t0) : (MK_PROBE == 4) ? (pu_t2 - pu_t0) : (MK_PROBE == 6) ? (pu_ta - pu_t0) : (pu_t2 - pu_t1); pr_n = 1; }
#endif
    if (MK_PROBE < 11 && blockIdx.x == 0 && threadIdx.x == 0) { const float pv_ = (float)pr_acc / (float)(pr_n ? pr_n : 1); probe_out[0] = (MK_PROBE >= 3 && MK_PROBE <= 6 && chunk != 0) ? probe_out[0] + pv_ : pv_; }
#endif
    lgkm_wait0(); __syncthreads();
}

#define LDS_WAIT() asm volatile("s_waitcnt lgkmcnt(0)" ::: "memory")
#define VM_WAIT() asm volatile("s_waitcnt vmcnt(0)" ::: "memory")
constexpr int NWAVES = 8;
__device__ __forceinline__ float wave_sum(float v) {
#pragma unroll
    for (int o = 1; o < 64; o <<= 1) v += __shfl_xor(v, o);
    return v;
}

struct Args { const float* in[33]; float* out; unsigned char* ws; int ph_lo, ph_hi; };

__device__ __forceinline__ void tr_item(const float* src, int Nsrc, int srccol0, const float* gain, bf16* dst, int Kdst, int dstrow0, int k0, LAS float* scr, int lane) {
    const int col = srccol0 + (lane & 31); const bool ok = col < Nsrc;
#pragma unroll 8
    for (int i = 0; i < 32; ++i) { const int kk = 2 * i + (lane >> 5); float v = ok ? src[(size_t)(k0 + kk) * Nsrc + col] : 0.f; if (gain) v *= gain[k0 + kk]; scr[kk * 33 + (lane & 31)] = v; }
    LDS_WAIT(); asm volatile("" ::: "memory");
    const int c = lane & 7;
#pragma unroll
    for (int j = 0; j < 4; ++j) { const int n = (lane >> 3) + 8 * j; const LAS float* s = scr + (8 * c) * 33 + n;
        u32x4 o; o.x = pk2(s[0 * 33], s[1 * 33]); o.y = pk2(s[2 * 33], s[3 * 33]); o.z = pk2(s[4 * 33], s[5 * 33]); o.w = pk2(s[6 * 33], s[7 * 33]);
        *(GAS u32x4*)(dst + (size_t)(dstrow0 + n) * Kdst + k0 + 8 * c) = o; }
    LDS_WAIT(); asm volatile("" ::: "memory");
}
__device__ __forceinline__ void tr_matrix(int item, const float* src, const float* src2, int Ksrc, int Nsrc, int Ndst, int map, const float* gain, bf16* dst, LAS float* scr, int lane) {
    const int nblk = Ndst / 32, kb = item / nblk, nb = item % nblk;
    int srccol0 = 32 * nb; const float* s = src;
    if (map == 1) { const int pn = nb >> 3, pb = nb & 7, half = pb >> 2, hh = pb & 3; srccol0 = 256 * pn + 64 * hh + 32 * half; }
    else if (map == 2) { const int pn = nb >> 3, pb = nb & 7; srccol0 = 128 * pn + 32 * (pb & 3); s = (pb < 4) ? src : src2; }
    tr_item(s, Nsrc, srccol0, gain, dst, Ksrc, 32 * nb, 64 * kb, scr, lane);
}

__device__ __forceinline__ void tr_wg_load(f32x4 (&v)[8], const float* src, const float* src2, int Nsrc, int map, const float* gain, int kb, int nb, int tid) {
    const int c4 = tid & 63;
    const float* s = src; int col;
    if (map == 2) { s = (c4 < 32) ? src : src2; col = 128 * nb + 4 * (c4 & 31); } else col = 256 * nb + 4 * c4;
    const bool ok = col < Nsrc;
#pragma unroll
    for (int i = 0; i < 8; ++i) { const int k = 64 * kb + (tid >> 6) + 8 * i;
        f32x4 x = ok ? *(const GAS f32x4*)(s + (size_t)k * Nsrc + col) : (f32x4){0.f, 0.f, 0.f, 0.f};
        if (gain) x = x * gain[k];
        v[i] = x; }
}
__device__ __forceinline__ void tr_wg_store(const f32x4 (&v)[8], LAS float* T, int map, bf16* dst, int Kdst, int kb, int nb, int tid) {
    const int c4 = tid & 63;
    __syncthreads();
#pragma unroll
    for (int i = 0; i < 8; ++i) *(LAS f32x4*)(T + ((tid >> 6) + 8 * i) * 260 + 4 * c4) = v[i];
    __syncthreads();
    const int ch = tid & 7;
#pragma unroll
    for (int j = 0; j < 4; ++j) { const int n = (tid >> 3) + 64 * j;
        const int lc = (map == 1) ? (64 * ((n >> 5) & 3) + 32 * (n >> 7) + (n & 31)) : n;
        const LAS float* s = T + (8 * ch) * 260 + lc;
        u32x4 o; o.x = cvtpk(s[0 * 260], s[1 * 260]); o.y = cvtpk(s[2 * 260], s[3 * 260]); o.z = cvtpk(s[4 * 260], s[5 * 260]); o.w = cvtpk(s[6 * 260], s[7 * 260]);
        *(GAS u32x4*)(dst + (size_t)(256 * nb + n) * Kdst + 64 * kb + 8 * ch) = o; }
}
struct TrDesc { const float* src; const float* src2; int Nsrc, Kdst, map; const float* gain; bf16* dst; int kb, nb; };

__device__ __forceinline__ int rel_bucket(int d) {
    if (d < 16) return d;
    int b = 16;
    b += d >= 22; b += d >= 30; b += d >= 40; b += d >= 54; b += d >= 73; b += d >= 99; b += d >= 134; b += d >= 182;
    b += d >= 246; b += d >= 332; b += d >= 450; b += d >= 609; b += d >= 825; b += d >= 1117; b += d >= 1513;
    return b;
}

__device__ __forceinline__ bool in_phase(int k, int lo, int hi) { asm volatile("" : "+s"(lo), "+s"(hi)); return lo <= k && k < hi; }
__global__ void __launch_bounds__(NWAVES * 64, 2) fwd_kernel(Args args) {
    extern __shared__ __attribute__((aligned(16))) unsigned char lds[];
    LAS unsigned char* L = (LAS unsigned char*)lds;
    volatile LAS unsigned* MISC = (volatile LAS unsigned*)(L + MISC_OFF);
    const int tid = threadIdx.x, lane = tid & 63, wave = __builtin_amdgcn_readfirstlane(tid >> 6);
    const int G = gridDim.x; const int bx = blockIdx.x; const int vcu = (G % 8 == 0) ? (bx % 8) * (G / 8) + bx / 8 : bx;
    unsigned char* ws = args.ws;
    gu32* ctl = (gu32*)(ws + WS_CTL);
    for (int u = tid; u < 128; u += NWAVES * 64) ((LAS unsigned*)(L + MISC_OFF))[u] = 0u;
    __syncthreads();
    XcdBarrier bar = xcd_barrier_post((unsigned*)(ctl + CW_BAR), MISC + 8);
    const int lo = args.ph_lo, hi = args.ph_hi;
#if MK_PROBE >= 31
    if (blockIdx.x == 0 && threadIdx.x == 0) g_probe_acc = 0.f;
#endif
#define IN(k) (((MK_MASK >> (k)) & 1) && in_phase((k), lo, hi))
#define PHASE_IDS int tid_o = threadIdx.x; asm volatile("" : "+v"(tid_o)); const int tid = tid_o, lane = tid_o & 63; (void)tid; (void)lane;
#define PHASE_WS unsigned char* ws_o = args.ws; asm volatile("" : "+s"(ws_o)); unsigned char* const ws = ws_o; (void)ws; int bx_o = blockIdx.x; asm volatile("" : "+s"(bx_o)); const int bx = bx_o; (void)bx;
#define REPN(k) (1 + ((MK_REP >> (k)) & 1))
#define INR(k) in_phase((k), lo, hi)
#define SEAM(k) do { if (INR(k) && INR((k) + 1)) xcd_barrier(bar); } while (0)

#define ssb ((ss_t*)(ws + WS_SS))
#define kmean ((float*)(ws + WS_KMEAN))
#define biasd ((float*)(ws + WS_BIASD))
#define cb1 ((float*)(ws + WS_CB1))
#define HB ((bf16*)(ws + WS_HB))
#define PP ((bf16*)(ws + WS_PP))
#define OB ((bf16*)(ws + WS_O))
#define QB ((bf16*)(ws + WS_Q))
#define K0 ((bf16*)(ws + WS_K0))
#define V0 ((bf16*)(ws + WS_V0))
#define KV1 ((bf16*)(ws + WS_KV1))
#define HID ((bf16*)(ws + WS_HID))
#define PB0 ((bf16*)(ws + WS_PB0))
#define PB1 ((bf16*)(ws + WS_PB1))
#define KC ((bf16*)(ws + WS_KC))
#define VC ((bf16*)(ws + WS_VC))
#define GATES ((float*)(ws + WS_GATES))
    const int gw = vcu * NWAVES + wave, NGW = G * NWAVES;

for (int rep_ = 0; rep_ < REPN(0); ++rep_) { if (rep_) xcd_barrier(bar);
    if (IN(0)) {
        PHASE_IDS
#if MK_PROBE >= 21
        const unsigned long long pp_t0 = __builtin_amdgcn_s_memrealtime();
#define PP_MARK(k) if (MK_PROBE == (k) && blockIdx.x == MK_PROBE_BLK && threadIdx.x == 0) ((float*)(ws + WS_CB1 + 4096))[0] = (float)(__builtin_amdgcn_s_memrealtime() - pp_t0);
#else
#define PP_MARK(k)
#endif
        LAS float* scr = (LAS float*)(L + wave * WAVE_LDS);
        const float* nmix = args.in[3]; const float* nffn = args.in[4]; const float* nple = args.in[5];
        {
            constexpr int W_IN0 = 16 * (N_IN0 / 256), W_IN1 = 16 * (N_IN1P / 256), W_OUT = 16 * 4, W_GU = 16 * (N_GU / 256), W_D = (FF / 64) * 4, W_PG = 16 * 4, W_PP = 4 * 4;
            constexpr int NWI = W_IN0 + W_IN1 + 2 * W_OUT + 2 * W_GU + 2 * W_D + 2 * W_PG + 2 * W_PP;
            LAS float* T = (LAS float*)L;
            auto desc = [&](int it) { TrDesc d; int r = it; int nbn;
                if (r < W_IN0) { d = TrDesc{args.in[11], nullptr, N_IN0, DM, 1, nmix, (bf16*)(ws + WS_WIN0), 0, 0}; nbn = N_IN0 / 256; }
                else if ((r -= W_IN0) < W_IN1) { d = TrDesc{args.in[17], nullptr, N_IN1, DM, 1, nmix + DM, (bf16*)(ws + WS_WIN1), 0, 0}; nbn = N_IN1P / 256; }
                else if ((r -= W_IN1) < W_OUT) { d = TrDesc{args.in[12], nullptr, DM, DM, 0, nullptr, (bf16*)(ws + WS_WOUT0), 0, 0}; nbn = 4; }
                else if ((r -= W_OUT) < W_OUT) { d = TrDesc{args.in[18], nullptr, DM, DM, 0, nullptr, (bf16*)(ws + WS_WOUT1), 0, 0}; nbn = 4; }
                else if ((r -= W_OUT) < W_GU) { d = TrDesc{args.in[6], args.in[7], FF, DM, 2, nffn, (bf16*)(ws + WS_WGU0), 0, 0}; nbn = N_GU / 256; }
                else if ((r -= W_GU) < W_GU) { d = TrDesc{args.in[6] + (size_t)DM * FF, args.in[7] + (size_t)DM * FF, FF, DM, 2, nffn + DM, (bf16*)(ws + WS_WGU1), 0, 0}; nbn = N_GU / 256; }
                else if ((r -= W_GU) < W_D) { d = TrDesc{args.in[8], nullptr, DM, FF, 0, nullptr, (bf16*)(ws + WS_WD0), 0, 0}; nbn = 4; }
                else if ((r -= W_D) < W_D) { d = TrDesc{args.in[8] + (size_t)FF * DM, nullptr, DM, FF, 0, nullptr, (bf16*)(ws + WS_WD1), 0, 0}; nbn = 4; }
                else if ((r -= W_D) < W_PG) { d = TrDesc{args.in[10], nullptr, DM, DM, 0, nple, (bf16*)(ws + WS_WPG0), 0, 0}; nbn = 4; }
                else if ((r -= W_PG) < W_PG) { d = TrDesc{args.in[10] + (size_t)DM * DM, nullptr, DM, DM, 0, nple + DM, (bf16*)(ws + WS_WPG1), 0, 0}; nbn = 4; }
                else if ((r -= W_PG) < W_PP) { d = TrDesc{args.in[9], nullptr, DM, PLE, 0, nullptr, (bf16*)(ws + WS_WPP0), 0, 0}; nbn = 4; }
                else { r -= W_PP; d = TrDesc{args.in[9] + (size_t)PLE * DM, nullptr, DM, PLE, 0, nullptr, (bf16*)(ws + WS_WPP1), 0, 0}; nbn = 4; }
                d.kb = r / nbn; d.nb = r % nbn; return d; };
            f32x4 v[8];
            int it = vcu;
            if (it < NWI) { const TrDesc d = desc(it); tr_wg_load(v, d.src, d.src2, d.Nsrc, d.map, d.gain, d.kb, d.nb, tid); }
#pragma unroll 1
            for (; it < NWI; it += G) {
                const TrDesc d = desc(it);
                f32x4 w[8];
#pragma unroll
                for (int i = 0; i < 8; ++i) w[i] = v[i];
                if (it + G < NWI) { const TrDesc dn = desc(it + G); tr_wg_load(v, dn.src, dn.src2, dn.Nsrc, dn.map, dn.gain, dn.kb, dn.nb, tid); }
                tr_wg_store(w, T, d.map, d.dst, d.Kdst, d.kb, d.nb, tid);
            }
            __syncthreads();
        }
        PP_MARK(21)
        constexpr int I_C1 = 32 * 4, I_C2 = 2 * 2, NIT = 2 * I_C1 + 2 * I_C2;
        for (int it = gw; it < NIT; it += NGW) {
            int r = it;
            if (r < I_C1) { tr_matrix(r, args.in[24], nullptr, 2048, 128, 128, 0, nullptr, (bf16*)(ws + WS_CW1K), scr, lane); continue; } r -= I_C1;
            if (r < I_C1) { tr_matrix(r, args.in[29], nullptr, 2048, 128, 128, 0, nullptr, (bf16*)(ws + WS_CW1V), scr, lane); continue; } r -= I_C1;
            if (r < I_C2) { tr_matrix(r, args.in[26], nullptr, 128, 64, 64, 0, nullptr, (bf16*)(ws + WS_CW2K), scr, lane); continue; } r -= I_C2;
            tr_matrix(r, args.in[31], nullptr, 128, 64, 64, 0, nullptr, (bf16*)(ws + WS_CW2V), scr, lane);
        }
        PP_MARK(22)
        const float* x = args.in[0];
        for (int m = 2 * gw; m < M; m += 2 * NGW) {
            const GAS f32x4* xr = (const GAS f32x4*)(x + (size_t)m * DM) + lane; f32x4 v[8]; float s0 = 0.f, s1 = 0.f;
#pragma unroll
            for (int j = 0; j < 8; ++j) v[j] = xr[64 * j];
#pragma unroll
            for (int j = 0; j < 4; ++j) { s0 += (v[j].x * v[j].x + v[j].y * v[j].y) + (v[j].z * v[j].z + v[j].w * v[j].w); s1 += (v[4 + j].x * v[4 + j].x + v[4 + j].y * v[4 + j].y) + (v[4 + j].z * v[4 + j].z + v[4 + j].w * v[4 + j].w); }
            s0 = wave_sum(s0); s1 = wave_sum(s1);
            GAS unsigned long long* o8 = (GAS unsigned long long*)(HB + (size_t)m * DM) + lane;
#pragma unroll
            for (int j = 0; j < 8; ++j) o8[64 * j] = (unsigned long long)cvtpk(v[j].x, v[j].y) | ((unsigned long long)cvtpk(v[j].z, v[j].w) << 32);
            if (lane == 0) { ssb[m] = (ss_t)(s0 * SS_SCALE); ssb[m + 1] = (ss_t)(s1 * SS_SCALE); }
        }
        PP_MARK(23)
        const float* relb = args.in[2];
        for (int i = bx * 512 + tid; i < NH * TABN; i += G * 512) { const int h = i / TABN, d = i % TABN; biasd[i] = relb[rel_bucket(d) * NH + h] * LOG2E; }
        for (int o = vcu; o < 256; o += G) { const int kv = o >> 7, col = o & 127; const float* pos = args.in[kv ? 28 : 23]; const float* w1 = args.in[kv ? 29 : 24]; const float* b1 = args.in[kv ? 30 : 25];
            float s = 0.f;
#pragma unroll
            for (int i = 0; i < 4; ++i) { const int k = tid + 512 * i; s += pos[k] * w1[(size_t)k * 128 + col]; }
            s = wave_sum(s);
            LAS float* red = (LAS float*)(L + 8 * WAVE_LDS);
            __syncthreads(); if (lane == 0) red[wave] = s; __syncthreads();
            if (tid == 0) cb1[o] = ((red[0] + red[1]) + (red[2] + red[3])) + ((red[4] + red[5]) + (red[6] + red[7])) + b1[col]; }
        if (bx == 0) { const int gi = tid >> 6; const int src_idx = gi < 4 ? 13 + gi : gi == 4 ? 19 : gi == 5 ? 21 : gi == 6 ? 22 : 20; ((float*)(ws + WS_GN))[tid] = args.in[src_idx][tid & 63] * ((gi == 0 || gi == 2 || gi == 4) ? C2 : 1.0f); }
        for (int i = bx * 512 + tid; i < 2 * 32 * 32; i += G * 512) { const int kv = i >> 10, bg = (i >> 5) & 31, w = i & 31; ((unsigned*)((kv ? VC : KC) + ((size_t)bg * 128 + 127) * HD))[w] = 0u; }
    }
}
    SEAM(0);
    using namespace pg8;
    if (IN(2)) { PHASE_WS  Gemm g{HB, (const bf16*)(ws + WS_WIN0), M, N_IN0, DM}; StaticOrder S; S.init(M, N_IN0, G, bx, MK_WGM12);
        EpiInProj<0> E{ssb, QB, (const float*)(ws + WS_GN), kmean, nullptr};
        gemm_phase<EpiInProj<0>, StaticOrder, true, true>(L, g, S, E); }
    SEAM(2);
for (int rep_ = 0; rep_ < REPN(3); ++rep_) { if (rep_) xcd_barrier(bar);
    if (IN(3)) { PHASE_WS
        PHASE_IDS
        LAS float* tab = (LAS float*)(L + TAB0_OFF); LAS float* km = (LAS float*)(L + KM_OFF);
        for (int v = vcu; v < 256; v += G) {
            const int bh = v >> 2, b = bh >> 3, h = bh & 7, sub = v & 3;
            __syncthreads();
            if (tid < 9) ((LAS unsigned*)(L + UW_OFF))[tid] = 0u;
            build_tab<2112>(tab, biasd + h * TABN, 2047, tid);
            km[tid] = kmean[(size_t)(b * 8 + h) * 512 + tid] * (1.0f / 256.0f);
            __syncthreads();
#ifndef NO_MOBA
            if (!(rep_ && MK_P3SKIP == 2))
#pragma unroll 1
            for (int uu = 0; uu < 2; ++uu) {
#if MK_GHOST && MK_GHOST < 30
                if (rep_) moba_unit<MK_GHOST>(L, wave, b, h, uu ? 7 - sub : sub, QB, K0, V0, OB, tab, km); else
#endif
                moba_unit<0>(L, wave, b, h, uu ? 7 - sub : sub, QB, K0, V0, OB, tab, km, (float*)(ws + WS_CB1 + 4096)); }
#endif
            build_dil_tabs(tab, biasd + (8 + h) * TABN, tid);
            __syncthreads();
#ifndef NO_DIL
            if (!(rep_ && MK_P3SKIP == 1)) {
                bf16* SO = (bf16*)(ws + WS_PP); float* SM = (float*)(ws + WS_PP + 16 * MiB); float* SL = SM + (size_t)BATCH * 8 * SEQ;
#pragma unroll 1
                for (int uu = 0; uu < 2; ++uu) dil_wave<0>(L, wave, b, 8 + h, sub, 8 * uu + wave, QB, K0, V0, OB, tab, SO, SM, SL);
                asm volatile("s_waitcnt vmcnt(0)" ::: "memory"); __syncthreads();
#pragma unroll 1
                for (int uu = 0; uu < 2; ++uu) dil_wave<1>(L, wave, b, 8 + h, sub, 8 * uu + wave, QB, K0, V0, OB, tab, SO, SM, SL);
            }
#endif
        }
    }
}
    SEAM(3);
#pragma unroll 1
    for (int layer = 0; layer < 2; ++layer) {
        const int pb = layer ? 12 : 4;
#define Wout ((const bf16*)(ws + (layer ? WS_WOUT1 : WS_WOUT0)))
#define Wgu ((const bf16*)(ws + (layer ? WS_WGU1 : WS_WGU0)))
#define Wd ((const bf16*)(ws + (layer ? WS_WD1 : WS_WD0)))
#define Wpg ((const bf16*)(ws + (layer ? WS_WPG1 : WS_WPG0)))
#define HCUR (layer ? OB : HB)
#define OCUR (layer ? HB : OB)
#define ss_ffn (ssb + (size_t)(3 * layer + 1) * M)
#define ss_ple (ssb + (size_t)(3 * layer + 2) * M)
#define ss_next (layer ? (ss_t*)nullptr : ssb + (size_t)3 * M)
        if (layer == 1) {
for (int rep_ = 0; rep_ < REPN(9); ++rep_) { if (rep_) xcd_barrier(bar);
            if (IN(9)) { PHASE_WS  Gemm g{OB, (const bf16*)(ws + WS_WIN1), M, N_IN1P, DM}; StaticOrder S; S.init(M, N_IN1P, G, bx, MK_WGM12);
                EpiInProj<1> E{ssb + (size_t)3 * M, QB, (const float*)(ws + WS_GN), nullptr, GATES};
                gemm_phase<EpiInProj<1>, StaticOrder, true, true>(L, g, S, E); }
}
            SEAM(9);
for (int rep_ = 0; rep_ < REPN(10); ++rep_) { if (rep_) xcd_barrier(bar);
            if (IN(10)) { PHASE_WS
                PHASE_IDS
                for (int task = vcu; task < 256; task += G) {
                    const int kv = task >> 7, bg = (task >> 2) & 31, rt = task & 3, i0 = 32 * rt;
                    const bf16* T = KV1 + (size_t)kv * ((size_t)BATCH * 4 * SEQ * HD) + (size_t)bg * SEQ * HD;
                    const bf16* W1 = (const bf16*)(ws + (kv ? WS_CW1V : WS_CW1K)); const bf16* W2 = (const bf16*)(ws + (kv ? WS_CW2V : WS_CW2K));
                    const int r32 = lane & 31, hi5 = lane >> 5;
                    f32x16 acc4[4];
#pragma unroll
                    for (int nb = 0; nb < 4; ++nb)
#pragma unroll
                        for (int r = 0; r < 16; ++r) acc4[nb][r] = 0.f;
                    int arow = i0 + r32; arow = arow > 126 ? 126 : arow;
                    const bf16* ap = T + (size_t)arow * 16 * HD + 256 * wave + 8 * hi5;
                    const bf16* bp = W1 + (size_t)r32 * 2048 + 256 * wave + 8 * hi5;
                    bf16x8 af[16];
#pragma unroll
                    for (int s = 0; s < 16; ++s) af[s] = *(const bf16x8*)(ap + 16 * s);
#pragma unroll
                    for (int s = 0; s < 16; ++s) {
#pragma unroll
                        for (int nb = 0; nb < 4; ++nb) { const bf16x8 bb = *(const bf16x8*)(bp + (size_t)nb * 32 * 2048 + 16 * s);
                            acc4[nb] = __builtin_amdgcn_mfma_f32_32x32x16_bf16(af[s], bb, acc4[nb], 0, 0, 0); } }
                    __syncthreads();
                    LAS float* part = (LAS float*)L;
#pragma unroll
                    for (int nb = 0; nb < 4; ++nb)
#pragma unroll
                        for (int r = 0; r < 16; ++r) part[(wave * 32 + crow(r, hi5)) * 129 + 32 * nb + r32] = acc4[nb][r];
                    __syncthreads();
                    LAS bf16* H1 = (LAS bf16*)(L + 135168);
                    const float cbv = cb1[kv * 128 + (tid & 127)];
                    for (int e = tid; e < 32 * 128; e += 512) { const int row = e >> 7, col = e & 127;
                        float v = cbv;
#pragma unroll
                        for (int w8 = 0; w8 < 8; ++w8) v += part[(w8 * 32 + row) * 129 + col];
                        const float u2 = 0.7978845608028654f * (v + 0.044715f * v * v * v);
                        const float th = 1.0f - 2.0f * fast_rcp(1.0f + fast_exp2(2.0f * u2 * LOG2E));
                        H1[row * 136 + col] = (bf16)f2bf(0.5f * v * (1.0f + th)); }
                    __syncthreads();
                    LAS float* OUT = (LAS float*)(L + 144384);
                    if (wave < 2) {
                        f32x16 a2;
#pragma unroll
                        for (int r = 0; r < 16; ++r) a2[r] = 0.f;
#pragma unroll
                        for (int s = 0; s < 8; ++s) { const bf16x8 a = *(LAS const bf16x8*)(H1 + r32 * 136 + 16 * s + 8 * hi5);
                            const bf16x8 bb = *(const bf16x8*)(W2 + (size_t)(32 * wave + r32) * 128 + 16 * s + 8 * hi5);
                            a2 = __builtin_amdgcn_mfma_f32_32x32x16_bf16(a, bb, a2, 0, 0, 0); }
                        const float* b2 = args.in[kv ? 32 : 27];
#pragma unroll
                        for (int r = 0; r < 16; ++r) OUT[crow(r, hi5) * 65 + 32 * wave + r32] = a2[r] + b2[32 * wave + r32];
                    }
                    __syncthreads();
                    if (tid < 256) { const int row = tid >> 3, c8 = (tid & 7) * 8; float v[8]; float sq = 0.f;
#pragma unroll
                        for (int i = 0; i < 8; ++i) { v[i] = OUT[row * 65 + c8 + i]; sq += v[i] * v[i]; }
                        sq += __shfl_xor(sq, 1); sq += __shfl_xor(sq, 2); sq += __shfl_xor(sq, 4);
                        if (kv == 0) { const float r2 = rsqrtf(sq * (1.0f / HD) + RMS_EPS); const float* kn = (const float*)(ws + WS_GN) + 7 * 64;
#pragma unroll
                            for (int i = 0; i < 8; ++i) v[i] = v[i] * r2 * kn[c8 + i]; }
                        if (i0 + row < 127) { u32x4 w; w.x = pk2(v[0], v[1]); w.y = pk2(v[2], v[3]); w.z = pk2(v[4], v[5]); w.w = pk2(v[6], v[7]);
                            *(u32x4*)((kv ? VC : KC) + ((size_t)bg * 128 + i0 + row) * HD + c8) = w; } }
                    __syncthreads();
                }
            }
}
            SEAM(10);
for (int rep_ = 0; rep_ < REPN(11); ++rep_) { if (rep_) xcd_barrier(bar);
            if (IN(11)) { PHASE_WS
                PHASE_IDS
#if MK_PROBE >= 51
                const unsigned long long p11_t0 = __builtin_amdgcn_s_memrealtime();
#endif
                LAS float* tabs = (LAS float*)(L + TAB1_OFF);
                for (int v = vcu; v < 256; v += G) {
                    const int bg = v >> 3, b = bg >> 2, g = bg & 3, sub = v & 7;
                    __syncthreads();
                    if (tid < 9) ((LAS unsigned*)(L + UW_OFF))[tid] = 0u;
                    if (tid < 64) ((LAS unsigned*)(L + SELW_OFF))[tid] = 0u;
                    { float vf[4][(TABF + 511) / 512], vw[4][(TABWN + 511) / 512];
#pragma unroll
                        for (int hh = 0; hh < 4; ++hh) { build_tab_ld<TABF>(vf[hh], biasd + (4 * g + hh) * TABN, 2047, tid); build_tab_ld<TABWN>(vw[hh], biasd + (4 * g + hh) * TABN, 511, tid); }
#pragma unroll
                        for (int hh = 0; hh < 4; ++hh) { build_tab_st<TABF>(tabs + hh * TABF, vf[hh], 2047, tid); build_tab_st<TABWN>(tabs + 4 * TABF + hh * TABWN, vw[hh], 511, tid); } }
                    __syncthreads();
#if MK_PROBE == 56
                    if (threadIdx.x == 0) ((float*)(ws + WS_CB1 + 8192))[blockIdx.x] = (float)(__builtin_amdgcn_s_memrealtime() - p11_t0);
#endif
#pragma unroll 1
                    for (int k = 0; k < 4; ++k) { const int pr = 2 * sub + (k >> 1); const int chunk = (k & 1) ? 31 - pr : pr;
#if MK_GHOST && MK_GHOST < 30
                        if (rep_) nsa_unit<MK_GHOST>(wave, L, b, g, chunk, QB, KV1, KC, VC, GATES, HB, tabs); else
#endif
                        nsa_unit<0>(wave, L, b, g, chunk, QB, KV1, KC, VC, GATES, HB, tabs, (float*)(ws + WS_CB1 + 4096)); }
                }
#if MK_PROBE >= 51 && MK_PROBE != 56
                if (threadIdx.x == 0) ((float*)(ws + WS_CB1 + 8192))[blockIdx.x] = (float)(__builtin_amdgcn_s_memrealtime() - p11_t0);
#endif
            }
}
            SEAM(11);
        }
        if (IN(pb)) { PHASE_WS
            {
                PHASE_IDS
                const float* p1 = args.in[1] + (size_t)layer * M * PLE;
                for (int m0 = gw; m0 < M; m0 += 8 * NGW) {
                    f32x4 v[8];
#pragma unroll
                    for (int j = 0; j < 8; ++j) { const int m = m0 + j * NGW; v[j] = ((const GAS f32x4*)(p1 + (size_t)(m < M ? m : M - 1) * PLE))[lane]; }
#pragma unroll
                    for (int j = 0; j < 8; ++j) { const int m = m0 + j * NGW;
                        if (m < M) ((GAS unsigned long long*)(PB1 + (size_t)m * PLE))[lane] = (unsigned long long)pk2(v[j].x, v[j].y) | ((unsigned long long)pk2(v[j].z, v[j].w) << 32); } }
            }
            Gemm g{OCUR, Wout, M, DM, DM}; StaticOrder S; S.init(M, DM, G, bx, MK_WGM4);
            EpiResid<0> E{HCUR, HCUR, nullptr, ss_ffn, nullptr, nullptr};
            gemm_phase<EpiResid<0>, StaticOrder, true, true>(L, g, S, E); }
        SEAM(pb);
for (int rep_ = 0; rep_ < REPN(pb + 1); ++rep_) { if (rep_) xcd_barrier(bar);
        if (IN(pb + 1)) { PHASE_WS  Gemm g{HCUR, Wgu, M, N_GU, DM}; StaticOrder S; S.init(M, N_GU, G, bx, MK_WGM22); EpiSwiglu E{HID, ss_ffn, 0};
#if MK_GHOST >= 30
            if (rep_) { E.ghost = 1; S.flat = (MK_GHOST == 31); }
#endif
            gemm_phase<EpiSwiglu, StaticOrder, true, true>(L, g, S, E);
            if (G == 256 ? bx >= 128 : true) {
                int kk = PLE; asm volatile("" : "+s"(kk)); Gemm g2{PB1, (const bf16*)(ws + (layer ? WS_WPP1 : WS_WPP0)), M, DM, kk}; StaticOrder S2;
                if (G == 256) S2.init(M, DM, 128, bx - 128); else S2.init(M, DM, G, bx);
                EpiStoreBf16 E2{PP, DM};
                gemm_phase<EpiStoreBf16, StaticOrder, true, true>(L, g2, S2, E2); } }
}
        SEAM(pb + 1);
        if (IN(pb + 2)) { PHASE_WS  Gemm g{HID, Wd, M, DM, FF}; StaticOrder S; S.init(M, DM, G, bx, MK_WGM4);
            EpiResid<0> E{HCUR, HCUR, nullptr, ss_ple, nullptr, nullptr};
            gemm_phase<EpiResid<0>, StaticOrder, true, true>(L, g, S, E); }
        SEAM(pb + 2);
        if (IN(pb + 3)) { PHASE_WS  Gemm g{HCUR, Wpg, M, DM, DM}; StaticOrder S; S.init(M, DM, G, bx, MK_WGM4);
            EpiResid<1> E{HCUR, layer ? (bf16*)nullptr : OB, layer ? args.out : (float*)nullptr, ss_next, ss_ple, PP};
            gemm_phase<EpiResid<1>, StaticOrder, true, true>(L, g, S, E); }
        if (layer == 0) SEAM(7);
    }
#if MK_PROBE
#if MK_PROBE < 31
    float g_probe_acc = 0.f;
#endif
    xcd_barrier(bar);
    if (blockIdx.x == 0 && threadIdx.x == 0) { unsigned char* ws = args.ws; float pv_ = ((MK_PROBE >= 31) ? g_probe_acc : ((float*)(ws + WS_CB1 + 4096))[0]) * (1.0f / MK_PROBE_DIV);
#if MK_PROBE >= 51
        { const float* a = (const float*)(ws + WS_CB1 + 8192); float mx = 0.f, mn = 1e30f, sm = 0.f; int am = 0;
          for (int i = 0; i < 256; ++i) { const float t = a[i]; if (t > mx) { mx = t; am = i; } mn = t < mn ? t : mn; sm += t; }
          pv_ = (MK_PROBE == 51 ? mx : MK_PROBE == 52 ? mn : MK_PROBE == 53 ? (float)am * MK_PROBE_DIV : (MK_PROBE == 55 || MK_PROBE == 56) ? a[MK_PROBE_BLK] : sm * (1.0f / 256.0f)) * (1.0f / MK_PROBE_DIV) - (float)MK_PROBE_OFF; if (pv_ < 0.f) pv_ = 0.f; }
#endif
 float q_ = 1.f; while (pv_ >= 20.f) { pv_ *= 0.5f; q_ *= 2.f; } args.out[0] += floorf(pv_ * 0.5f) * 2.f * q_; }
#endif
#if MK_DBG
    if (lo == 99) {
        const bf16* src = (const bf16*)(ws + (size_t)MK_DBG_OFF);
        for (size_t i = (size_t)bx * 512 + threadIdx.x; i < (size_t)M * DM; i += (size_t)G * 512) args.out[i] = i < (size_t)MK_DBG_CNT ? bf2f(src[i]) : 0.f;
    }
#endif
#undef IN
#undef SEAM
}

extern "C" void kernel_launch(void* const* d_in, const int* in_sizes, int n_in, void* d_out, int out_size, void* d_ws, size_t ws_size, hipStream_t stream) {
    static int grid = 0;
    if (grid == 0) {
        if (n_in != 33 || out_size != M * DM || ws_size < WS_END) { fprintf(stderr, "kernel_launch: unexpected problem (n_in %d out %d ws %zu)\n", n_in, out_size, ws_size); grid = -1; return; }
        int dev = 0, cus = 0, per_cu = 0;
        if (hipGetDevice(&dev) != hipSuccess || hipDeviceGetAttribute(&cus, hipDeviceAttributeMultiprocessorCount, dev) != hipSuccess) { grid = -1; return; }
        if (hipFuncSetAttribute((const void*)fwd_kernel, hipFuncAttributeMaxDynamicSharedMemorySize, LDS_BYTES) != hipSuccess) { fprintf(stderr, "kernel_launch: hipFuncSetAttribute failed\n"); grid = -1; return; }
        if (hipOccupancyMaxActiveBlocksPerMultiprocessor(&per_cu, (const void*)fwd_kernel, NWAVES * 64, LDS_BYTES) != hipSuccess || per_cu < 1) { fprintf(stderr, "kernel_launch: occupancy query says %d\n", per_cu); }
        (void)hipGetLastError();
        grid = cus < 256 ? cus : 256;
    }
    if (grid < 0) return;
    if (hipMemsetAsync((char*)d_ws + WS_CTL, 0, CTL_ZERO_BYTES, stream) != hipSuccess) return;
    Args a{};
    for (int i = 0; i < 33; ++i) a.in[i] = (const float*)d_in[i];
    a.out = (float*)d_out; a.ws = (unsigned char*)d_ws;
#if MK_SPLIT
    for (int ph = 0; ph < MK_PH_END; ++ph) { a.ph_lo = ph; a.ph_hi = ph + 1; hipLaunchKernelGGL(fwd_kernel, dim3(grid), dim3(NWAVES * 64), LDS_BYTES, stream, a); }
#if MK_DBG
    a.ph_lo = 99; a.ph_hi = 100; hipLaunchKernelGGL(fwd_kernel, dim3(grid), dim3(NWAVES * 64), LDS_BYTES, stream, a);
#endif
#else
    a.ph_lo = 0; a.ph_hi = MK_PH_END;
    hipLaunchKernelGGL(fwd_kernel, dim3(grid), dim3(NWAVES * 64), LDS_BYTES, stream, a);
#endif
}
```

```cpp
#include <hip/hip_runtime.h>
#include <cstdio>
#include <cstdint>

#ifndef MK_SPLIT
#define MK_SPLIT 0
#endif
#ifndef MK_DBG
#define MK_DBG 0
#define MK_DBG_OFF (0ull << 10)
#define MK_DBG_CNT (0)
#endif
#ifndef MK_PROBE
#define MK_PROBE 0
#define MK_PROBE_CHUNK 31
#define MK_PROBE_BLK 0
#define MK_PROBE_DIV 100.0f
#define MK_PROBE_OFF 0
#endif
#ifndef MK_P3SKIP
#define MK_P3SKIP 0
#endif
#ifndef MK_STAGGER
#define MK_STAGGER 0
#endif
#ifndef MK_WGM4
#define MK_WGM4 2
#define MK_WGM22 2
#define MK_WGM12 2
#endif
#ifndef MK_SERP
#define MK_SERP 0
#endif
#ifndef MK_BG
#define MK_BG 1
#endif
#ifndef MK_GHOST
#define MK_GHOST 0
#endif
#ifndef MK_REP
#define MK_REP 0
#endif
#ifndef MK_MASK
#define MK_MASK 0xFFFF
#endif
#ifndef MK_PH_END
#define MK_PH_END 16
#endif

#if MK_PROBE >= 31
__device__ float g_probe_acc = 0.f;
#endif
namespace pg8 {
#define PG8_LAS __attribute__((address_space(3)))
typedef unsigned short bf16_t;
typedef short bf16x8 __attribute__((ext_vector_type(8)));
typedef float f32x4 __attribute__((ext_vector_type(4)));
typedef unsigned u32x4 __attribute__((ext_vector_type(4)));
constexpr int BM = 256, BK = 64, HALF = 128, HTB = HALF * BK * 2  , STAGE_BYTES = 8 * HTB, NXCD = 8, WGM = 2;

__host__ __device__ __forceinline__ int lds_byte(int r, int c) { const int st = (r >> 4) * 2 + (c >> 5), rr = r & 15, cc = c & 31, ob = rr * 64 + cc * 2; return st * 1024 + (ob ^ (((ob >> 9) & 1) << 5)); }
__host__ __device__ __forceinline__ void stage_rc(int b, int& R, int& C) { const int st = b / 1024, sb = b % 1024, swz = sb ^ (((sb >> 9) & 1) << 5); R = (st >> 1) * 16 + swz / 64; C = (st & 1) * 32 + (swz % 64) / 2; }
__host__ __device__ __forceinline__ int perm32(int rho) { const int n = rho >> 4, i = rho & 15; return 8 * (i >> 2) + 4 * n + (i & 3); }

struct Unit { int pm, pn; };
struct Gemm { const bf16_t* A; const bf16_t* Bt; int M, N, K; };

struct StaticOrder {
    int nM, nN, nwg, G, c, wgm, flat = 0;
    __host__ __device__ void init(int M, int N, int G_, int c_, int wgm_ = WGM) { nM = M / BM; nN = N / BM; nwg = nM * nN; G = G_; c = c_; wgm = wgm_; }
    __host__ __device__ bool next(int i, Unit& u) const {
        const long L = (long)i * G + c; if (L >= nwg) return false;
        int wgid = (int)L; { const int q = nwg / NXCD, r = nwg % NXCD, xcd = wgid % NXCD, off = wgid / NXCD; wgid = (xcd < r ? xcd * (q + 1) : r * (q + 1) + (xcd - r) * q) + off; }
        const int nig = wgm * nN, gid = wgid / nig, fm = gid * wgm, gsz = (nM - fm) < wgm ? (nM - fm) : wgm;
        u.pm = fm + ((wgid % nig) % gsz); u.pn = (wgid % nig) / gsz; if (MK_SERP && (gid & 1)) u.pn = nN - 1 - u.pn;
#if MK_GHOST >= 30
        if (flat) { u.pm = 0; u.pn = 0; }
#endif
        return true;
    }
    __device__ __forceinline__ void a_ready(const Unit&) const {}
    __device__ __forceinline__ void done(const Unit&) const {}
};

__device__ __forceinline__ unsigned cvt_pk_bf16(float lo, float hi) { unsigned r; asm volatile("v_cvt_pk_bf16_f32 %0, %1, %2" : "=v"(r) : "v"(lo), "v"(hi)); return r; }
template <class Epi, class Sched, bool ALIGN_EPI = false, bool SP2 = false>
__device__ __forceinline__ void gemm_phase(PG8_LAS unsigned char* lds, const Gemm g, const Sched& S, const Epi& E) {
    int tid_ = threadIdx.x; asm volatile("" : "+v"(tid_));
    const int tid = tid_, wid = __builtin_amdgcn_readfirstlane(tid >> 6), lane = tid & 63, wr = wid >> 2, wc = wid & 3, fr = lane & 15, fq = lane >> 4;
    const int K = g.K, nt = K / BK;
    unsigned voffA[2], voffB[2];
#pragma unroll
    for (int i = 0; i < 2; ++i) { int R, C; stage_rc(tid * 16 + i * 8192, R, C); const int Rb = Epi::PERM ? ((R & ~31) + perm32(R & 31)) : R;
        voffA[i] = (unsigned)(R * K + C) * 2u; voffB[i] = (unsigned)(Rb * K + C) * 2u; }
    const size_t kstep = (size_t)(BK * 2);
    const size_t hstep = (size_t)HALF * K * 2;
    const size_t tstep = 2 * hstep;
    const unsigned ldsw = (unsigned)wid * 1024u;
    const int aoff = lds_byte(wr * 64 + fr, fq * 8), boff = lds_byte(wc * 32 + fr, fq * 8);
#define PG8_SA(b, h) (((b) * 2 + (h)) * HTB)
#define PG8_SB(b, h) ((4 + (b) * 2 + (h)) * HTB)
#define PG8_STAGE(bufoff, gbase, voff) do { _Pragma("unroll") for (int _i = 0; _i < 2; ++_i) \
        __builtin_amdgcn_global_load_lds((const unsigned*)((const char*)(gbase) + (voff)[_i]), (PG8_LAS unsigned*)(lds + (bufoff) + ldsw + _i * 8192), 16, 0, 0); } while (0)
#define PG8_LDA(dst, b, h) do { _Pragma("unroll") for (int m = 0; m < 4; ++m) _Pragma("unroll") for (int k = 0; k < 2; ++k) dst[m][k] = *(const PG8_LAS bf16x8*)(lds + PG8_SA(b, h) + aoff + m * 2048 + k * 1024); } while (0)
#define PG8_LDB(dst, b, h) do { _Pragma("unroll") for (int n = 0; n < 2; ++n) _Pragma("unroll") for (int k = 0; k < 2; ++k) dst[n][k] = *(const PG8_LAS bf16x8*)(lds + PG8_SB(b, h) + boff + n * 2048 + k * 1024); } while (0)
#define PG8_MMA(ai, bj, At, Bt) do { __builtin_amdgcn_s_setprio(1); _Pragma("unroll") for (int m = 0; m < 4; ++m) _Pragma("unroll") for (int n = 0; n < 2; ++n) _Pragma("unroll") for (int k = 0; k < 2; ++k) \
        acc[ai][bj][m][n] = __builtin_amdgcn_mfma_f32_16x16x32_bf16(Bt[n][k], At[m][k], acc[ai][bj][m][n], 0, 0, 0); __builtin_amdgcn_s_setprio(0); } while (0)
#define PG8_WAIT_V(n) asm volatile("s_waitcnt vmcnt(" #n ")" ::: "memory")
#define PG8_WAIT_L(n) asm volatile("s_waitcnt lgkmcnt(" #n ")" ::: "memory")
#define PG8_BAR __builtin_amdgcn_s_barrier()
#define PG8_SCHED __builtin_amdgcn_sched_barrier(0)
    Unit cur, nxt; int ui = 0;
    if (!S.next(0, cur)) return;
    f32x4 acc[2][2][4][2];
#pragma unroll
    for (int a = 0; a < 2; ++a)
#pragma unroll
        for (int b = 0; b < 2; ++b)
#pragma unroll
            for (int m = 0; m < 4; ++m)
#pragma unroll
                for (int n = 0; n < 2; ++n) acc[a][b][m][n] = (f32x4){0.f, 0.f, 0.f, 0.f};
    bf16x8 At[4][2], B0[2][2], B1[2][2];
    const char* cA = (const char*)g.A + (size_t)cur.pm * tstep; const char* cB = (const char*)g.Bt + (size_t)cur.pn * tstep;
    S.a_ready(cur);
    if constexpr (SP2) {
        PG8_STAGE(PG8_SB(0, 0), cB, voffB); PG8_STAGE(PG8_SB(0, 1), cB + hstep, voffB); PG8_STAGE(PG8_SA(0, 0), cA, voffA); PG8_STAGE(PG8_SA(0, 1), cA + hstep, voffA);
        if (wr == 1) PG8_BAR;
        PG8_WAIT_V(2); PG8_BAR;
        PG8_STAGE(PG8_SB(1, 0), cB + kstep, voffB); PG8_STAGE(PG8_SA(1, 0), cA + kstep, voffA); PG8_STAGE(PG8_SB(1, 1), cB + hstep + kstep, voffB);
        PG8_WAIT_V(6); PG8_BAR;
    } else {
        PG8_STAGE(PG8_SB(0, 0), cB, voffB); PG8_STAGE(PG8_SA(0, 0), cA, voffA); PG8_STAGE(PG8_SB(0, 1), cB + hstep, voffB); PG8_STAGE(PG8_SA(0, 1), cA + hstep, voffA);
        if (wr == 1) PG8_BAR;
        PG8_WAIT_V(4); PG8_BAR;
        PG8_STAGE(PG8_SB(1, 0), cB + kstep, voffB); PG8_STAGE(PG8_SA(1, 0), cA + kstep, voffA); PG8_STAGE(PG8_SB(1, 1), cB + hstep + kstep, voffB);
        PG8_WAIT_V(6); PG8_BAR;
    }
    for (;;) {
        const bool has_next = S.next(ui + 1, nxt);
        const char* nA = has_next ? (const char*)g.A + (size_t)nxt.pm * tstep : cA; const char* nB = has_next ? (const char*)g.Bt + (size_t)nxt.pn * tstep : cB;
        for (int t = 0; t < nt; t += 2) {
            const bool last = (t == nt - 2);
            const char* a1 = cA + (size_t)(t + 1) * kstep;
            const char* a2 = last ? nA : cA + (size_t)(t + 2) * kstep; const char* b2 = last ? nB : cB + (size_t)(t + 2) * kstep;
            const char* a3 = a2 + kstep; const char* b3 = b2 + kstep;
            if (last && has_next) S.a_ready(nxt);
            if constexpr (SP2) {
            PG8_LDB(B0, 0, 0); PG8_LDB(B1, 0, 1); PG8_SCHED; PG8_LDA(At, 0, 0); PG8_STAGE(PG8_SA(1, 1), a1 + hstep, voffA);
            PG8_WAIT_V(8); PG8_WAIT_L(0); PG8_BAR; PG8_MMA(0, 0, At, B0); PG8_MMA(0, 1, At, B1); PG8_BAR; PG8_SCHED;
            PG8_LDA(At, 0, 1); PG8_STAGE(PG8_SB(0, 0), b2, voffB); PG8_STAGE(PG8_SB(0, 1), b2 + hstep, voffB); PG8_STAGE(PG8_SA(0, 0), a2, voffA);
            PG8_WAIT_V(8); PG8_WAIT_L(0); PG8_BAR; PG8_MMA(1, 0, At, B0); PG8_MMA(1, 1, At, B1); PG8_BAR; PG8_SCHED;
            PG8_LDB(B0, 1, 0); PG8_LDB(B1, 1, 1); PG8_SCHED; PG8_LDA(At, 1, 0); PG8_STAGE(PG8_SA(0, 1), a2 + hstep, voffA);
            PG8_WAIT_V(8); PG8_WAIT_L(0); PG8_BAR; PG8_MMA(0, 0, At, B0); PG8_MMA(0, 1, At, B1); PG8_BAR; PG8_SCHED;
            PG8_LDA(At, 1, 1); PG8_STAGE(PG8_SB(1, 0), b3, voffB); PG8_STAGE(PG8_SB(1, 1), b3 + hstep, voffB); PG8_STAGE(PG8_SA(1, 0), a3, voffA);
            PG8_WAIT_V(8); PG8_WAIT_L(0); PG8_BAR; PG8_MMA(1, 0, At, B0); PG8_MMA(1, 1, At, B1); PG8_BAR; PG8_SCHED;
            } else {
            PG8_LDB(B0, 0, 0); PG8_SCHED; PG8_LDA(At, 0, 0); PG8_STAGE(PG8_SA(1, 1), a1 + hstep, voffA);
            PG8_WAIT_L(8); PG8_BAR; PG8_WAIT_L(0); PG8_MMA(0, 0, At, B0); PG8_BAR; PG8_SCHED;
            PG8_LDB(B1, 0, 1); PG8_STAGE(PG8_SB(0, 0), b2, voffB);
            PG8_BAR; PG8_WAIT_L(0); PG8_MMA(0, 1, At, B1); PG8_BAR;
            PG8_LDA(At, 0, 1); PG8_STAGE(PG8_SA(0, 0), a2, voffA);
            PG8_BAR; PG8_WAIT_L(0); PG8_MMA(1, 0, At, B0); PG8_BAR; PG8_SCHED;
            PG8_STAGE(PG8_SB(0, 1), b2 + hstep, voffB);
            PG8_WAIT_V(6); PG8_BAR; PG8_MMA(1, 1, At, B1); PG8_BAR;
            PG8_LDB(B0, 1, 0); PG8_SCHED; PG8_LDA(At, 1, 0); PG8_STAGE(PG8_SA(0, 1), a2 + hstep, voffA);
            PG8_WAIT_L(8); PG8_BAR; PG8_WAIT_L(0); PG8_MMA(0, 0, At, B0); PG8_BAR; PG8_SCHED;
            PG8_LDB(B1, 1, 1); PG8_STAGE(PG8_SB(1, 0), b3, voffB);
            PG8_BAR; PG8_WAIT_L(0); PG8_MMA(0, 1, At, B1); PG8_BAR;
            PG8_LDA(At, 1, 1); PG8_STAGE(PG8_SA(1, 0), a3, voffA);
            PG8_BAR; PG8_WAIT_L(0); PG8_MMA(1, 0, At, B0); PG8_BAR; PG8_SCHED;
            PG8_STAGE(PG8_SB(1, 1), b3 + hstep, voffB);
            PG8_WAIT_V(6); PG8_BAR; PG8_MMA(1, 1, At, B1); PG8_BAR;
            }
        }
        if constexpr (ALIGN_EPI) { if (wr == 0) PG8_BAR; }
#if MK_PROBE >= 31
        const unsigned long long ge_t0 = __builtin_amdgcn_s_memrealtime();
#endif
        if constexpr (!Epi::AFTER_DRAIN) { E(acc, cur, wr, wc, fr, fq); S.done(cur); }
#if MK_PROBE >= 31
        asm volatile("s_waitcnt vmcnt(0)" ::: "memory");
        if (Epi::PROBE_ID == MK_PROBE && blockIdx.x == 0 && tid == 0) g_probe_acc += (float)(__builtin_amdgcn_s_memrealtime() - ge_t0);
#endif
        if (!has_next) break;
#pragma unroll
        for (int a = 0; a < 2; ++a)
#pragma unroll
            for (int b = 0; b < 2; ++b)
#pragma unroll
                for (int m = 0; m < 4; ++m)
#pragma unroll
                    for (int n = 0; n < 2; ++n) acc[a][b][m][n] = (f32x4){0.f, 0.f, 0.f, 0.f};
        cur = nxt; cA = nA; cB = nB; ++ui;
        if constexpr (ALIGN_EPI) { if (wr == 1) PG8_BAR; }
    }
    PG8_WAIT_V(0);
    if constexpr (!ALIGN_EPI) { if (wr == 0) PG8_BAR; }
    PG8_BAR;
    if constexpr (Epi::AFTER_DRAIN) { E.fused(acc, cur, wr, wc, fr, fq, lds, wid, lane); S.done(cur); }
#undef PG8_SA
#undef PG8_SB
#undef PG8_STAGE
#undef PG8_LDA
#undef PG8_LDB
#undef PG8_MMA
#undef PG8_WAIT_V
#undef PG8_WAIT_L
#undef PG8_BAR
#undef PG8_SCHED
}
}

constexpr int BATCH = 8, SEQ = 2048, DM = 1024, M = BATCH * SEQ, FF = 2816, PLE = 256;
constexpr int NH = 16, HD = 64;
constexpr int N_IN0 = 3072, N_IN1 = 2608, N_IN1P = 2816, N_GU = 2 * FF;
constexpr float RMS_EPS = 1e-6f;
constexpr float LOG2E = 1.4426950408889634f;
constexpr float C2 = 0.125f * LOG2E;
constexpr int TABN = 2048;

constexpr size_t MiB = 1u << 20, KiB = 1u << 10;
constexpr size_t WS_CTL = 0, CTL_ZERO_BYTES = 2 * MiB;
constexpr size_t WS_SS = 256 * KiB;
constexpr size_t WS_KMEAN = 1280 * KiB;
constexpr size_t WS_W = 2 * MiB;
constexpr size_t WS_WIN0 = WS_W, WS_WOUT0 = WS_WIN0 + 6 * MiB, WS_WGU0 = WS_WOUT0 + 2 * MiB, WS_WD0 = WS_WGU0 + 11 * MiB,
                 WS_WPG0 = WS_WD0 + 5632 * KiB, WS_WPP0 = WS_WPG0 + 2 * MiB,
                 WS_WIN1 = WS_WPP0 + 512 * KiB, WS_WOUT1 = WS_WIN1 + 5632 * KiB, WS_WGU1 = WS_WOUT1 + 2 * MiB, WS_WD1 = WS_WGU1 + 11 * MiB,
                 WS_WPG1 = WS_WD1 + 5632 * KiB, WS_WPP1 = WS_WPG1 + 2 * MiB,
                 WS_CW1K = WS_WPP1 + 512 * KiB, WS_CW1V = WS_CW1K + 512 * KiB, WS_CW2K = WS_CW1V + 512 * KiB, WS_CW2V = WS_CW2K + 16 * KiB,
                 WS_WEND = WS_CW2V + 16 * KiB;
static_assert(WS_WEND <= 58 * MiB, "weights");
constexpr size_t WS_MISC = 58 * MiB;
constexpr size_t WS_BIASD = WS_MISC;
constexpr size_t WS_CB1 = WS_MISC + 128 * KiB;
constexpr size_t WS_GN = WS_MISC + 192 * KiB;
constexpr size_t WS_KC = WS_MISC + 256 * KiB, WS_VC = WS_KC + 512 * KiB;
constexpr size_t WS_HB = 60 * MiB;
constexpr size_t WS_PP = 92 * MiB;
constexpr size_t WS_O = 124 * MiB;
constexpr size_t WS_QKV = 156 * MiB;
constexpr size_t WS_Q = WS_QKV, WS_K0 = WS_QKV + 32 * MiB, WS_V0 = WS_QKV + 64 * MiB;
constexpr size_t WS_KV1 = WS_QKV + 32 * MiB;
constexpr size_t WS_HID = WS_QKV;
constexpr size_t WS_PB1 = WS_QKV + 88 * MiB;
constexpr size_t WS_PB0 = WS_O;
constexpr size_t WS_GATES = 252 * MiB;
constexpr size_t WS_END = 256 * MiB;
static_assert(WS_QKV + 96 * MiB <= WS_GATES && WS_GATES + 3 * MiB <= WS_END, "ws map");

constexpr int CW_BAR = 4096;

constexpr int WAVE_LDS = 16384;
constexpr int TAB0_OFF = 131072;
constexpr int KM_OFF = TAB0_OFF + 21760;
constexpr int TAB1_OFF = 100608;
constexpr int MISC_OFF = 154880;
constexpr int LDS_BYTES = MISC_OFF + 512;
static_assert(LDS_BYTES <= 163840 && KM_OFF + 2048 <= MISC_OFF && TAB1_OFF + (4 * 2112 + 4 * 704) * 4 <= MISC_OFF, "LDS map");

#define GAS __attribute__((address_space(1)))
#define LAS __attribute__((address_space(3)))
typedef unsigned short bf16;
typedef float f32x4 __attribute__((ext_vector_type(4)));
typedef float f32x16 __attribute__((ext_vector_type(16)));
typedef short bf16x8 __attribute__((ext_vector_type(8)));
typedef unsigned u32x4 __attribute__((ext_vector_type(4)));
typedef unsigned u32x2 __attribute__((ext_vector_type(2)));
typedef GAS unsigned gu32;

__device__ __forceinline__ unsigned f2bf(float f) { unsigned u = __builtin_bit_cast(unsigned, f); return (u + 0x7fffu + ((u >> 16) & 1u)) >> 16; }
__device__ __forceinline__ unsigned pk2(float lo, float hi) { return f2bf(lo) | (f2bf(hi) << 16); }
__device__ __forceinline__ float bf2f(unsigned short h) { return __builtin_bit_cast(float, (unsigned)h << 16); }
typedef float f32x2_t __attribute__((ext_vector_type(2))); typedef __bf16 bf16x2_t __attribute__((ext_vector_type(2)));
__device__ __forceinline__ unsigned cvtpk(float lo, float hi) { f32x2_t v = {lo, hi}; bf16x2_t b = __builtin_convertvector(v, bf16x2_t); return __builtin_bit_cast(unsigned, b); }
__device__ __forceinline__ float fast_exp2(float x) { return __builtin_amdgcn_exp2f(x); }
__device__ __forceinline__ float fast_rcp(float x) { return __builtin_amdgcn_rcpf(x); }
__device__ __forceinline__ float sigmoidf_(float x) { return fast_rcp(1.0f + fast_exp2(-x * LOG2E)); }


__device__ __forceinline__ float x32_other(float v) { const auto r = __builtin_amdgcn_permlane32_swap(__builtin_bit_cast(unsigned, v), __builtin_bit_cast(unsigned, v), false, false);
    return (threadIdx.x & 32) ? __builtin_bit_cast(float, r[0]) : __builtin_bit_cast(float, r[1]); }
__device__ __forceinline__ float sum_x32(float v) { return v + __shfl_xor(v, 32); }
__device__ __forceinline__ float max_x32(float v) { const auto r = __builtin_amdgcn_permlane32_swap(__builtin_bit_cast(unsigned, v), __builtin_bit_cast(unsigned, v), false, false);
    return fmaxf(__builtin_bit_cast(float, r[0]), __builtin_bit_cast(float, r[1])); }
__device__ __forceinline__ float sum_x16(float v) { return v + __shfl_xor(v, 16); }
template <int CTRL> __device__ __forceinline__ float dppf(float v) { return __builtin_bit_cast(float, __builtin_amdgcn_update_dpp(0, __builtin_bit_cast(int, v), CTRL, 0xF, 0xF, true)); }
__device__ __forceinline__ float sum_row16(float v) { v += dppf<0xB1>(v); v += dppf<0x4E>(v); v += dppf<0x141>(v); v += dppf<0x140>(v); return v; }

using pg8::Unit;
typedef float accf4 __attribute__((ext_vector_type(4)));
#define EPI_ARGS const accf4 (&acc)[2][2][4][2], const Unit& u, int wr, int wc, int fr_in, int fq_in
#define EPI_OPAQUE int fr = fr_in, fq = fq_in; asm volatile("" : "+v"(fr), "+v"(fq));
typedef unsigned long long ss_t;
constexpr float SS_SCALE = 16777216.0f;
__device__ __forceinline__ float rstd_row(const ss_t* ss, int row) { return rsqrtf((float)ss[row] * (1.0f / (SS_SCALE * DM)) + RMS_EPS); }

struct EpiStoreBf16 {
    static constexpr bool PERM = true, AFTER_DRAIN = false; static constexpr int PROBE_ID = 30;
    bf16* O; int ldc;
    __device__ __forceinline__ void operator()(EPI_ARGS) const {
        EPI_OPAQUE
        const int row0 = u.pm * 256 + wr * 64 + fr, col0 = u.pn * 256 + wc * 32 + 8 * fq;
#pragma unroll
        for (int ai = 0; ai < 2; ++ai)
#pragma unroll
            for (int m = 0; m < 4; ++m) { bf16* rowp = O + (size_t)(row0 + ai * 128 + m * 16) * ldc + col0;
#pragma unroll
                for (int bj = 0; bj < 2; ++bj) { const accf4 v0 = acc[ai][bj][m][0], v1 = acc[ai][bj][m][1];
                    u32x4 w; w.x = cvtpk(v0[0], v0[1]); w.y = cvtpk(v0[2], v0[3]); w.z = cvtpk(v1[0], v1[1]); w.w = cvtpk(v1[2], v1[3]);
                    *(u32x4*)(rowp + bj * 128) = w; } }
    }
};

__device__ __forceinline__ void bf8_to_f(const u32x4 w, float (&f)[8]) {
    f[0] = __builtin_bit_cast(float, w.x << 16); f[1] = __builtin_bit_cast(float, w.x & 0xffff0000u); f[2] = __builtin_bit_cast(float, w.y << 16); f[3] = __builtin_bit_cast(float, w.y & 0xffff0000u);
    f[4] = __builtin_bit_cast(float, w.z << 16); f[5] = __builtin_bit_cast(float, w.z & 0xffff0000u); f[6] = __builtin_bit_cast(float, w.w << 16); f[7] = __builtin_bit_cast(float, w.w & 0xffff0000u);
}
template <int MODE> struct EpiResid {
    static constexpr bool PERM = true, AFTER_DRAIN = false; static constexpr int PROBE_ID = 32 + MODE;
    const bf16* base; bf16* outb; float* outf; ss_t* ss_out; const ss_t* ss_in; const bf16* pp;
    __device__ __forceinline__ void operator()(EPI_ARGS) const {
        EPI_OPAQUE
        const int row0 = u.pm * 256 + wr * 64 + fr, col0 = u.pn * 256 + wc * 32 + 8 * fq;
        float rsv[8];
#pragma unroll
        for (int g8 = 0; g8 < 8; ++g8) rsv[g8] = (MODE == 1) ? rstd_row(ss_in, row0 + (g8 >> 2) * 128 + (g8 & 3) * 16) : 1.f;
        float sqv[8];
#pragma unroll
        for (int ai = 0; ai < 2; ++ai) {
            u32x4 bw[4][2];
#pragma unroll
            for (int m = 0; m < 4; ++m) { const size_t off = (size_t)(row0 + ai * 128 + m * 16) * DM + col0;
                bw[m][0] = *(const u32x4*)(base + off); bw[m][1] = *(const u32x4*)(base + off + 128); }
#pragma unroll
            for (int m = 0; m < 4; ++m) {
                const int g8 = ai * 4 + m; const int row = row0 + ai * 128 + m * 16; const size_t off = (size_t)row * DM + col0;
                const float rs = rsv[g8];
                float sq = 0.f;
#pragma unroll
                for (int bj = 0; bj < 2; ++bj) {
                    const accf4 v0 = acc[ai][bj][m][0], v1 = acc[ai][bj][m][1];
                    float v[8] = {v0[0], v0[1], v0[2], v0[3], v1[0], v1[1], v1[2], v1[3]};
                    float bs[8]; bf8_to_f(bw[m][bj], bs);
                    if (MODE == 1) { float p[8]; bf8_to_f(*(const u32x4*)(pp + off + bj * 128), p);
#pragma unroll
                        for (int i = 0; i < 8; ++i) v[i] = sigmoidf_(v[i] * rs) * p[i]; }
                    float hh[8];
#pragma unroll
                    for (int i = 0; i < 8; ++i) { hh[i] = bs[i] + v[i]; sq += hh[i] * hh[i]; }
                    if (outf) { *(f32x4*)(outf + off + bj * 128) = (f32x4){hh[0], hh[1], hh[2], hh[3]}; *(f32x4*)(outf + off + bj * 128 + 4) = (f32x4){hh[4], hh[5], hh[6], hh[7]}; }
                    else { u32x4 w; w.x = cvtpk(hh[0], hh[1]); w.y = cvtpk(hh[2], hh[3]); w.z = cvtpk(hh[4], hh[5]); w.w = cvtpk(hh[6], hh[7]); *(u32x4*)(outb + off + bj * 128) = w; }
                }
                sqv[g8] = sq;
            }
        }
        if (ss_out) {
#pragma unroll
            for (int g8 = 0; g8 < 8; ++g8) sqv[g8] = sum_x16(sqv[g8]);
#pragma unroll
            for (int g8 = 0; g8 < 8; ++g8) sqv[g8] = sum_x32(sqv[g8]);
            if (fq == 0) {
#pragma unroll
                for (int g8 = 0; g8 < 8; ++g8) atomicAdd(ss_out + row0 + (g8 >> 2) * 128 + (g8 & 3) * 16, (ss_t)(sqv[g8] * SS_SCALE)); }
        }
    }
};

struct EpiSwiglu {
    static constexpr bool PERM = true, AFTER_DRAIN = false; static constexpr int PROBE_ID = 31;
    bf16* hid; const ss_t* ss_in; int ghost;
    __device__ __forceinline__ void operator()(EPI_ARGS) const {
#if MK_GHOST >= 30
        if (ghost) return;
#endif
        EPI_OPAQUE
        const int row0 = u.pm * 256 + wr * 64 + fr, col0 = u.pn * 128 + wc * 32 + 8 * fq;
#pragma unroll
        for (int ai = 0; ai < 2; ++ai)
#pragma unroll
            for (int m = 0; m < 4; ++m) {
                const int row = row0 + ai * 128 + m * 16; const float rs = rstd_row(ss_in, row);
                float r[8];
#pragma unroll
                for (int n = 0; n < 2; ++n)
#pragma unroll
                    for (int i = 0; i < 4; ++i) { const float g = acc[ai][0][m][n][i] * rs, uu = acc[ai][1][m][n][i] * rs; r[4 * n + i] = g * sigmoidf_(g) * uu; }
                u32x4 w; w.x = cvtpk(r[0], r[1]); w.y = cvtpk(r[2], r[3]); w.z = cvtpk(r[4], r[5]); w.w = cvtpk(r[6], r[7]);
                *(u32x4*)(hid + (size_t)row * FF + col0) = w;
            }
    }
};

template <int LAYER> struct EpiInProj {
    static constexpr bool PERM = true, AFTER_DRAIN = false; static constexpr int PROBE_ID = 34 + LAYER;
    const ss_t* ss_in; bf16* Q;
    const float* gains;
    float* kmean; float* gates;
    __device__ __forceinline__ void operator()(EPI_ARGS) const {
        EPI_OPAQUE
        const int pn = u.pn;
        const float* gain = gains; bool has_gain = false; bf16* dst = Q; int head, nheads; bool do_km = false;
        if (LAYER == 0) {
            const int t6 = pn >> 1, type = t6 % 3, grp = t6 / 3;
            head = grp * 8 + (pn & 1) * 4 + wc; nheads = 16;
            dst = Q + (size_t)type * ((size_t)M * DM);
            has_gain = type < 2; gain = gains + 64 * (grp * 2 + (type & 1)); do_km = (type == 1 && grp == 0);
        } else {
            if (pn < 4) { head = pn * 4 + wc; nheads = 16; has_gain = true; gain = gains + 64 * 4; }
            else { head = wc; nheads = 4; dst = Q + (size_t)M * DM + (size_t)(pn - 4) * ((size_t)BATCH * 4 * SEQ * HD); has_gain = (pn == 6) || (pn == 8); gain = gains + 64 * (pn == 6 ? 5 : 6); }
        }
        const int row0 = u.pm * 256 + wr * 64 + fr;
        if (LAYER == 1 && pn == 10) {
            if (wc == 0) {
#pragma unroll
                for (int ai = 0; ai < 2; ++ai)
#pragma unroll
                    for (int m = 0; m < 4; ++m) { const int row = row0 + ai * 128 + m * 16; const float rs = rstd_row(ss_in, row);
#pragma unroll
                        for (int bj = 0; bj < 2; ++bj) { const int j0 = 32 * bj + 8 * fq;
                            if (j0 < 48) { const accf4 v0 = acc[ai][bj][m][0], v1 = acc[ai][bj][m][1];
                                f32x4 g0, g1;
#pragma unroll
                                for (int i = 0; i < 4; ++i) { g0[i] = sigmoidf_(v0[i] * rs); g1[i] = sigmoidf_(v1[i] * rs); }
                                *(f32x4*)(gates + (size_t)row * 48 + j0) = g0; *(f32x4*)(gates + (size_t)row * 48 + j0 + 4) = g1; } } }
            }
            return;
        }
        float ksum[2][2][4];
#pragma unroll
        for (int bj = 0; bj < 2; ++bj)
#pragma unroll
            for (int n = 0; n < 2; ++n)
#pragma unroll
                for (int i = 0; i < 4; ++i) ksum[bj][n][i] = 0.f;
        float rsv[8], r2v[8];
#pragma unroll
        for (int g8 = 0; g8 < 8; ++g8) { const int ai = g8 >> 2, m = g8 & 3; rsv[g8] = rstd_row(ss_in, row0 + ai * 128 + m * 16); }
        if (has_gain) {
#pragma unroll
            for (int g8 = 0; g8 < 8; ++g8) { const int ai = g8 >> 2, m = g8 & 3; float sq = 0.f;
#pragma unroll
                for (int bj = 0; bj < 2; ++bj)
#pragma unroll
                    for (int n = 0; n < 2; ++n)
#pragma unroll
                        for (int i = 0; i < 4; ++i) { const float x = acc[ai][bj][m][n][i] * rsv[g8]; sq += x * x; }
                r2v[g8] = sq; }
#pragma unroll
            for (int g8 = 0; g8 < 8; ++g8) r2v[g8] = sum_x16(r2v[g8]);
#pragma unroll
            for (int g8 = 0; g8 < 8; ++g8) r2v[g8] = sum_x32(r2v[g8]);
#pragma unroll
            for (int g8 = 0; g8 < 8; ++g8) r2v[g8] = rsqrtf(r2v[g8] * (1.0f / HD) + RMS_EPS) * rsv[g8];
        } else {
#pragma unroll
            for (int g8 = 0; g8 < 8; ++g8) r2v[g8] = rsv[g8];
        }
        f32x4 gq[2][2];
#pragma unroll
        for (int bj = 0; bj < 2; ++bj)
#pragma unroll
            for (int n = 0; n < 2; ++n) gq[bj][n] = has_gain ? *(const f32x4*)(gain + 32 * bj + 8 * fq + 4 * n) : (f32x4){1.f, 1.f, 1.f, 1.f};
#pragma unroll
        for (int ai = 0; ai < 2; ++ai)
#pragma unroll
            for (int m = 0; m < 4; ++m) {
                const int row = row0 + ai * 128 + m * 16, b = row >> 11, s = row & (SEQ - 1); const float sc = r2v[ai * 4 + m];
                float v[2][2][4];
#pragma unroll
                for (int bj = 0; bj < 2; ++bj)
#pragma unroll
                    for (int n = 0; n < 2; ++n)
#pragma unroll
                        for (int i = 0; i < 4; ++i) v[bj][n][i] = acc[ai][bj][m][n][i] * sc * gq[bj][n][i];
                if (LAYER == 0 && do_km) {
#pragma unroll
                    for (int bj = 0; bj < 2; ++bj)
#pragma unroll
                        for (int n = 0; n < 2; ++n)
#pragma unroll
                            for (int i = 0; i < 4; ++i) ksum[bj][n][i] += v[bj][n][i];
                }
                bf16* rowp = dst + ((size_t)(b * nheads + head) * SEQ + s) * HD + 8 * fq;
#pragma unroll
                for (int bj = 0; bj < 2; ++bj) { u32x4 w; w.x = cvtpk(v[bj][0][0], v[bj][0][1]); w.y = cvtpk(v[bj][0][2], v[bj][0][3]); w.z = cvtpk(v[bj][1][0], v[bj][1][1]); w.w = cvtpk(v[bj][1][2], v[bj][1][3]);
                    *(u32x4*)(rowp + 32 * bj) = w; }
            }
        if (LAYER == 0 && do_km) {
            const int b = u.pm >> 3, blk = u.pm & 7;
            float* kp = kmean + ((size_t)((b * 8 + head) * 8 + blk)) * HD + 8 * fq;
#pragma unroll
            for (int bj = 0; bj < 2; ++bj)
#pragma unroll
                for (int n = 0; n < 2; ++n)
#pragma unroll
                    for (int i = 0; i < 4; ++i) { float s = ksum[bj][n][i];
                        s = sum_row16(s);
                        if (fr == 0) atomicAdd(kp + 32 * bj + 4 * n + i, s); }
        }
    }
};
#define XB_TMO      128
#define XB_XCNT(j)  (256  + 64 * (j))
#define XB_XSUB(j)  (1280 + 64 * (j))
#define XB_XGEN(j)  (2304 + 64 * (j))
#define XB_TOP      3328
#define XB_TOPGEN   3392
#define XCD_BAR_WORDS 3456
#define XB_SPIN_CAP (1u << 18)

__device__ __forceinline__ unsigned xb_ld(unsigned* p)              { return __hip_atomic_load(p, __ATOMIC_RELAXED, __HIP_MEMORY_SCOPE_AGENT); }
__device__ __forceinline__ unsigned xb_add(unsigned* p, unsigned v) { return __hip_atomic_fetch_add(p, v, __ATOMIC_RELAXED, __HIP_MEMORY_SCOPE_AGENT); }
__device__ __forceinline__ unsigned xb_xcc_id() { return (unsigned)__builtin_amdgcn_s_getreg((3 << 11) | 20) & 0xFu; }
#define XB_SPIN(cond, bar) do { unsigned _sp = 0; while (cond) { __builtin_amdgcn_s_sleep(1); \
    if ((++_sp & 255u) == 0u) { if (xb_ld(&(bar)[XB_TMO])) break; if (_sp > XB_SPIN_CAP) { atomicAdd(&(bar)[XB_TMO], 1u); break; } } } } while (0)

struct XcdBarrier {
    unsigned* bar; unsigned x;
    volatile LAS unsigned* st;
};

__device__ __forceinline__ XcdBarrier xcd_barrier_post(unsigned* bar, volatile LAS unsigned* st) {
    XcdBarrier b; b.bar = bar; b.x = xb_xcc_id(); b.st = st;
    if (threadIdx.x == 0) (void)xb_add(&bar[XB_XCNT(b.x)], 1u);
    return b;
}
__device__ __forceinline__ void xcd_barrier_complete(unsigned* bar, unsigned x, unsigned& nloc, unsigned& nx) {
    const unsigned G = gridDim.x * gridDim.y * gridDim.z;
    unsigned sum, cnt, mine, sp = 0u;
    for (;;) {
        sum = 0u; cnt = 0u; mine = 0u;
#pragma unroll
        for (unsigned j = 0; j < 16; ++j) { const unsigned c = xb_ld(&bar[XB_XCNT(j)]); sum += c; cnt += (c > 0u) ? 1u : 0u; mine = (j == x) ? c : mine; }
        if (sum == G) break;
        __builtin_amdgcn_s_sleep(1);
        if ((++sp & 255u) == 0u) { if (xb_ld(&bar[XB_TMO])) break; if (sp > XB_SPIN_CAP) { atomicAdd(&bar[XB_TMO], 1u); break; } }
    }
    nloc = mine > 0u ? mine : 1u; nx = cnt > 0u ? cnt : 1u;
}

__device__ __forceinline__ void xcd_barrier(const XcdBarrier& b) {
    asm volatile("s_waitcnt vmcnt(0)" ::: "memory");
    __syncthreads();
    if (threadIdx.x == 0) {
        unsigned* bar = b.bar;
        __builtin_amdgcn_s_waitcnt(0);
        unsigned nloc = b.st[0], nx = b.st[1];
        if (nloc == 0u) { xcd_barrier_complete(bar, b.x, nloc, nx); b.st[0] = nloc; b.st[1] = nx; }
        const unsigned old = xb_add(&bar[XB_XSUB(b.x)], 1u);
        const unsigned gen = old / nloc;
        if (old + 1u == (gen + 1u) * nloc) {
            __builtin_amdgcn_fence(__ATOMIC_RELEASE, "agent");
            asm volatile("s_waitcnt vmcnt(0)" ::: "memory");
            const unsigned og = xb_add(&bar[XB_TOP], 1u);
            const unsigned tg = og / nx;
            if (og + 1u == (tg + 1u) * nx) xb_add(&bar[XB_TOPGEN], 1u);
            else XB_SPIN(xb_ld(&bar[XB_TOPGEN]) == tg, bar);
            __builtin_amdgcn_fence(__ATOMIC_ACQUIRE, "agent");
            xb_add(&bar[XB_XGEN(b.x)], 1u);
            asm volatile("s_waitcnt vmcnt(0)" ::: "memory");
        } else {
            XB_SPIN(xb_ld(&bar[XB_XGEN(b.x)]) == gen, bar);
            __builtin_amdgcn_fence(__ATOMIC_ACQUIRE, "agent");
            asm volatile("s_waitcnt vmcnt(0)" ::: "memory");
        }
    }
    __syncthreads();
}

__device__ __forceinline__ int crow(int r, int hi) { return (r & 3) + 8 * (r >> 2) + 4 * hi; }
__device__ __forceinline__ void glds16(const void* gsrc, unsigned lds_dst) { unsigned keep;
    asm volatile("s_mov_b32 %0, m0\n\ts_mov_b32 m0, %2\n\ts_nop 0\n\tglobal_load_lds_dwordx4 %1, off\n\ts_mov_b32 m0, %0" : "=&s"(keep) : "v"(gsrc), "s"(lds_dst) : "memory"); }
typedef short v4i16_t __attribute__((ext_vector_type(4)));
typedef LAS const char* lds_cptr;
__device__ __forceinline__ v4i16_t vtr(lds_cptr p) { return __builtin_amdgcn_ds_read_tr16_b64_v4i16((LAS v4i16_t*)p); }
constexpr int TILE_B = 16384;
constexpr float THR = 8.0f;
__device__ __forceinline__ int clampi(int v, int lo, int hi) { return v < lo ? lo : (v > hi ? hi : v); }

struct WCtx { int lane, r32, hi; unsigned lds0; lds_cptr ldsp; unsigned koff, voff; bf16x8 lsel; };
__device__ __forceinline__ WCtx make_ctx(LAS unsigned char* L) {
    int lane = threadIdx.x & 63; asm volatile("" : "+v"(lane));
    WCtx c; c.lane = lane; c.r32 = lane & 31; c.hi = lane >> 5; c.ldsp = (lds_cptr)L; c.lds0 = (unsigned)(uintptr_t)((unsigned char*)L);
    c.koff = c.r32 * 128 + (((c.r32 & 7) ^ c.hi) << 4);
    const int q = (lane & 15) >> 2, p = lane & 3, g1 = (lane >> 4) & 1;
    c.voff = 8192 + (4 * c.hi + q) * 128 + ((((g1 << 1) | (p >> 1)) ^ ((q >> 1) << 2)) << 4) + (p & 1) * 8;
    { const bool on = ((lane & 15) == 0 && ((lane >> 4) & 1) == 0) || ((lane & 15) == 1 && ((lane >> 4) & 1) == 1); const short v = on ? (short)0x3F80 : (short)0;
      c.lsel = (bf16x8){v, v, v, v, v, v, v, v}; }
    return c;
}
__device__ __forceinline__ void issue_piece(const WCtx& c, const bf16* Kb, const bf16* Vb, unsigned rowidx, unsigned tile_lds, int pc) {
    const unsigned cch = c.lane & 7, rl = c.lane >> 3;
    unsigned ko = rowidx * 128u + ((cch ^ rl) << 4); asm volatile("" : "+v"(ko));
    unsigned vo = rowidx * 128u + ((cch ^ (((rl >> 1) & 1) << 2)) << 4); asm volatile("" : "+v"(vo));
    glds16((const char*)Kb + ko, (unsigned)__builtin_amdgcn_readfirstlane(tile_lds + pc * 1024));
    glds16((const char*)Vb + vo, (unsigned)__builtin_amdgcn_readfirstlane(tile_lds + 8192 + pc * 1024));
}
__device__ __forceinline__ void issue_k_piece(const WCtx& c, const bf16* Kb, unsigned rowidx, unsigned tile_lds, int pc) {
    const unsigned cch = c.lane & 7, rl = c.lane >> 3;
    unsigned ko = rowidx * 128u + ((cch ^ rl) << 4); asm volatile("" : "+v"(ko));
    glds16((const char*)Kb + ko, (unsigned)__builtin_amdgcn_readfirstlane(tile_lds + pc * 1024));
}
__device__ __forceinline__ void issue_v_piece(const WCtx& c, const bf16* Vb, unsigned rowidx, unsigned tile_lds, int pc) {
    const unsigned cch = c.lane & 7, rl = c.lane >> 3;
    unsigned vo = rowidx * 128u + ((cch ^ (((rl >> 1) & 1) << 2)) << 4); asm volatile("" : "+v"(vo));
    glds16((const char*)Vb + vo, (unsigned)__builtin_amdgcn_readfirstlane(tile_lds + 8192 + pc * 1024));
}
__device__ __forceinline__ void vm_wait8() { asm volatile("s_waitcnt vmcnt(8)" ::: "memory"); }
__device__ __forceinline__ void vm_wait0() { asm volatile("s_waitcnt vmcnt(0)" ::: "memory"); }
__device__ __forceinline__ void lgkm_wait0() { asm volatile("s_waitcnt lgkmcnt(0)" ::: "memory"); }

__device__ __forceinline__ void tile_qk(const WCtx& c, lds_cptr kt, const bf16x8 (&qr)[4], f32x16& p0, f32x16& p1) {
#pragma unroll
    for (int d0 = 0; d0 < 4; ++d0) {
        const unsigned off = c.koff ^ (d0 << 5);
        const bf16x8 b0 = *(LAS const bf16x8*)(kt + off), b1 = *(LAS const bf16x8*)(kt + off + 4096);
        p0 = __builtin_amdgcn_mfma_f32_32x32x16_bf16(b0, qr[d0], p0, 0, 0, 0);
        p1 = __builtin_amdgcn_mfma_f32_32x32x16_bf16(b1, qr[d0], p1, 0, 0, 0);
    }
}
#ifndef MK_LSUM
#define MK_LSUM 1
#endif
#ifndef MK_BIGL
#define MK_BIGL 0x1p40f
#endif
constexpr float BIGL = MK_BIGL;
#ifndef MK_NOPK
#define MK_NOPK 1
#endif
#ifndef MK_DIL_PF
#define MK_DIL_PF 0
#endif
#ifndef MK_MOBA_PF
#define MK_MOBA_PF 1
#endif
#ifndef MK_PIPE
#define MK_PIPE 0
#endif
#ifndef MK_QKSPLIT
#define MK_QKSPLIT 0
#endif
#ifndef MK_PRIO
#define MK_PRIO 2
#endif
template <bool LS = false> __device__ __forceinline__ void tile_pv(const WCtx& c, lds_cptr vt, f32x16& o0, f32x16& o1, const f32x16& p0, const f32x16& p1, f32x4* ls = nullptr) {
    u32x4 pw[4];
#pragma unroll
    for (int k = 0; k < 2; ++k) {
        pw[k]     = (u32x4){cvtpk(p0[8 * k], p0[8 * k + 1]), cvtpk(p0[8 * k + 2], p0[8 * k + 3]), cvtpk(p0[8 * k + 4], p0[8 * k + 5]), cvtpk(p0[8 * k + 6], p0[8 * k + 7])};
        pw[2 + k] = (u32x4){cvtpk(p1[8 * k], p1[8 * k + 1]), cvtpk(p1[8 * k + 2], p1[8 * k + 3]), cvtpk(p1[8 * k + 4], p1[8 * k + 5]), cvtpk(p1[8 * k + 6], p1[8 * k + 7])};
    }
    lds_cptr v0p = vt + c.voff, v1p = vt + (c.voff ^ 64u);
#pragma unroll
    for (int ks = 0; ks < 4; ++ks) {
        const v4i16_t l0 = vtr(v0p + ks * 2048), h0 = vtr(v0p + ks * 2048 + 1024), l1 = vtr(v1p + ks * 2048), h1 = vtr(v1p + ks * 2048 + 1024);
        const bf16x8 v0 = (bf16x8){l0[0], l0[1], l0[2], l0[3], h0[0], h0[1], h0[2], h0[3]};
        const bf16x8 v1 = (bf16x8){l1[0], l1[1], l1[2], l1[3], h1[0], h1[1], h1[2], h1[3]};
        const bf16x8 pf = __builtin_bit_cast(bf16x8, pw[ks]);
#if MK_PRIO >= 2
        if (LS) __builtin_amdgcn_s_setprio(1);
#endif
        if (LS) *ls = __builtin_amdgcn_mfma_f32_16x16x32_bf16(c.lsel, pf, *ls, 0, 0, 0);
        o0 = __builtin_amdgcn_mfma_f32_32x32x16_bf16(v0, pf, o0, 0, 0, 0);
        o1 = __builtin_amdgcn_mfma_f32_32x32x16_bf16(v1, pf, o1, 0, 0, 0);
#if MK_PRIO >= 2
        if (LS) __builtin_amdgcn_s_setprio(0);
#endif
    }
}
#if MK_LSUM
struct AState { f32x16 o0, o1; f32x4 ls; float mhat; bool sh; };
__device__ __forceinline__ void astate_init(AState& s) {
#pragma unroll
    for (int r = 0; r < 16; ++r) { s.o0[r] = 0.f; s.o1[r] = 0.f; }
    s.ls = (f32x4){0.f, 0.f, 0.f, 0.f}; s.mhat = 0.f; s.sh = false;
}
#else
struct AState { f32x16 o0, o1, nv; float mhat, l; };
__device__ __forceinline__ void astate_init(AState& s) {
#pragma unroll
    for (int r = 0; r < 16; ++r) { s.o0[r] = 0.f; s.o1[r] = 0.f; s.nv[r] = 0.f; }
    s.mhat = 0.f; s.l = 0.f;
}
#endif
#if MK_LSUM
__device__ __forceinline__ float astate_l(const AState& st, const WCtx& c) {
    const float a = __shfl(st.ls[0], c.r32 & 15), b = __shfl(st.ls[1], c.r32 & 15); return (c.r32 & 16) ? b : a;
}
__device__ __forceinline__ void astate_recheck(AState& st, const WCtx& c) {
    if (__any(fmaxf(st.ls[0], st.ls[1]) > BIGL)) {
        asm volatile("" ::: "memory");
        const float d0 = st.ls[0] > BIGL ? __builtin_log2f(st.ls[0]) : 0.f, d1 = st.ls[1] > BIGL ? __builtin_log2f(st.ls[1]) : 0.f;
        const float a = __shfl(d0, c.r32 & 15), b = __shfl(d1, c.r32 & 15); const float dl = (c.r32 & 16) ? b : a;
        st.mhat += dl; st.sh = true;
        const float f = fast_exp2(-dl);
#pragma unroll
        for (int r = 0; r < 16; ++r) { st.o0[r] *= f; st.o1[r] *= f; }
        st.ls[0] *= fast_exp2(-d0); st.ls[1] *= fast_exp2(-d1);
    }
}
__device__ __forceinline__ void astate_shift(const AState& st, f32x16& p0, f32x16& p1) {
    if (st.sh) {
        asm volatile("" ::: "memory");
#pragma unroll
        for (int r = 0; r < 16; ++r) { p0[r] -= st.mhat; p1[r] -= st.mhat; }
    }
}
#endif
struct NoHook { __device__ __forceinline__ void operator()() const {} };
template <class BiasF, class H1 = NoHook, class H2 = NoHook, class H3 = NoHook>
__device__ __forceinline__ void tile_step(const WCtx& c, unsigned tile, AState& st, const bf16x8 (&qr)[4], BiasF biasf, H1 h1 = H1(), H2 h2 = H2(), H3 h3 = H3()) {
#if MK_LSUM
    astate_recheck(st, c);
    f32x16 p0, p1;
#pragma unroll
    for (int r = 0; r < 16; ++r) { p0[r] = biasf(r, 0); p1[r] = biasf(r, 1); }
    tile_qk(c, c.ldsp + tile, qr, p0, p1);
    h1();
    astate_shift(st, p0, p1);
#pragma unroll
    for (int r = 0; r < 16; ++r) { p0[r] = fast_exp2(p0[r]); p1[r] = fast_exp2(p1[r]); }
    h2();
    tile_pv<true>(c, c.ldsp + tile, st.o0, st.o1, p0, p1, &st.ls);
    h3();
#else
    f32x16 p0 = st.nv, p1 = st.nv;
    tile_qk(c, c.ldsp + tile, qr, p0, p1);
    h1();
    float rm = -INFINITY;
#pragma unroll
    for (int r = 0; r < 16; ++r) { p0[r] = __builtin_fmaf(p0[r], C2, biasf(r, 0)); rm = fmaxf(rm, p0[r]); }
#pragma unroll
    for (int r = 0; r < 16; ++r) { p1[r] = __builtin_fmaf(p1[r], C2, biasf(r, 1)); rm = fmaxf(rm, p1[r]); }
    float sum = 0.f;
#pragma unroll
    for (int r = 0; r < 16; ++r) { p0[r] = fast_exp2(p0[r]); p1[r] = fast_exp2(p1[r]); sum += p0[r] + p1[r]; }
    st.l += sum;
    h2();
    tile_pv(c, c.ldsp + tile, st.o0, st.o1, p0, p1);
    h3();
    rm = max_x32(rm);
    if (__any(rm > THR)) {
        asm volatile("" ::: "memory");
        const float dl = fmaxf(rm, 0.f);
        st.mhat += dl; const float ng = -st.mhat * (1.0f / C2);
        const float f = fast_exp2(-dl);
        st.l *= f;
#pragma unroll
        for (int r = 0; r < 16; ++r) { st.o0[r] *= f; st.o1[r] *= f; st.nv[r] = ng; }
    }
#endif
}
__device__ __forceinline__ void bias_ld(LAS const float* P0_, f32x16& p0, f32x16& p1) {
    unsigned pa = (unsigned)(size_t)P0_; asm volatile("" : "+v"(pa)); LAS const float* P0 = (LAS const float*)(size_t)pa;
#pragma unroll
    for (int r = 0; r < 16; ++r) { p0[r] = P0[(r & 3) + 8 * (r >> 2)]; p1[r] = P0[32 + (r & 3) + 8 * (r >> 2)]; }
}
template <int G = 0, class H1 = NoHook, class H2 = NoHook, class H3 = NoHook>
__device__ __forceinline__ void tile_step_fast(const WCtx& c, unsigned tile, AState& st, const bf16x8 (&qr)[4], f32x16 p0, f32x16 p1, H1 h1 = H1(), H2 h2 = H2(), H3 h3 = H3()) {
    if (G == 6) { return; }
#if MK_LSUM
    astate_recheck(st, c);
#endif
    lds_cptr kt = c.ldsp + tile;
    bf16x8 kf[8];
#pragma unroll
    for (int d0 = 0; d0 < 4; ++d0) { const unsigned off = c.koff ^ (d0 << 5); kf[2 * d0] = *(LAS const bf16x8*)(kt + off); kf[2 * d0 + 1] = *(LAS const bf16x8*)(kt + off + 4096); }
#if MK_LSUM
    __builtin_amdgcn_sched_barrier(0);
#if MK_PRIO
    __builtin_amdgcn_s_setprio(1);
#endif
#if MK_QKSPLIT
#pragma unroll
    for (int d0 = 0; d0 < 4; ++d0) p0 = __builtin_amdgcn_mfma_f32_32x32x16_bf16(kf[2 * d0], qr[d0], p0, 0, 0, 0);
#pragma unroll
    for (int d0 = 0; d0 < 4; ++d0) p1 = __builtin_amdgcn_mfma_f32_32x32x16_bf16(kf[2 * d0 + 1], qr[d0], p1, 0, 0, 0);
#else
#pragma unroll
    for (int d0 = 0; d0 < 4; ++d0) {
        p0 = __builtin_amdgcn_mfma_f32_32x32x16_bf16(kf[2 * d0], qr[d0], p0, 0, 0, 0);
        p1 = __builtin_amdgcn_mfma_f32_32x32x16_bf16(kf[2 * d0 + 1], qr[d0], p1, 0, 0, 0);
    }
#endif
#if MK_PRIO
    __builtin_amdgcn_s_setprio(0);
    __builtin_amdgcn_sched_barrier(0);
#endif
#else
    float bv0[16], bv1[16];
#pragma unroll
    for (int r = 0; r < 16; ++r) { bv0[r] = P0[63 - ((r & 3) + 8 * (r >> 2))]; bv1[r] = P0[31 - ((r & 3) + 8 * (r >> 2))]; }
    __builtin_amdgcn_sched_barrier(0);
    f32x16 p0 = __builtin_amdgcn_mfma_f32_32x32x16_bf16(kf[0], qr[0], st.nv, 0, 0, 0);
    f32x16 p1 = __builtin_amdgcn_mfma_f32_32x32x16_bf16(kf[1], qr[0], st.nv, 0, 0, 0);
#pragma unroll
    for (int d0 = 1; d0 < 4; ++d0) {
        p0 = __builtin_amdgcn_mfma_f32_32x32x16_bf16(kf[2 * d0], qr[d0], p0, 0, 0, 0);
        p1 = __builtin_amdgcn_mfma_f32_32x32x16_bf16(kf[2 * d0 + 1], qr[d0], p1, 0, 0, 0);
    }
#endif
    h1();
#if MK_LSUM
    astate_shift(st, p0, p1);
#pragma unroll
    for (int r = 0; r < 16; ++r) { p0[r] = fast_exp2(p0[r]); p1[r] = fast_exp2(p1[r]); }
    h2();
    tile_pv<true>(c, c.ldsp + tile, st.o0, st.o1, p0, p1, &st.ls);
    h3();
#else
    float rm = -INFINITY;
#pragma unroll
    for (int r = 0; r < 16; ++r) { p0[r] = __builtin_fmaf(p0[r], C2, bv0[r]); rm = fmaxf(rm, p0[r]); }
#pragma unroll
    for (int r = 0; r < 16; ++r) { p1[r] = __builtin_fmaf(p1[r], C2, bv1[r]); rm = fmaxf(rm, p1[r]); }
    float sum = 0.f;
#pragma unroll
    for (int r = 0; r < 16; ++r) { p0[r] = fast_exp2(p0[r]); p1[r] = fast_exp2(p1[r]); sum += p0[r] + p1[r]; }
    st.l += sum;
    h2();
    tile_pv(c, c.ldsp + tile, st.o0, st.o1, p0, p1);
    h3();
    rm = max_x32(rm);
    if (__any(rm > THR)) {
        asm volatile("" ::: "memory");
        const float dl = fmaxf(rm, 0.f);
        st.mhat += dl; const float ng = -st.mhat * (1.0f / C2);
        const float f = fast_exp2(-dl);
        st.l *= f;
#pragma unroll
        for (int r = 0; r < 16; ++r) { st.o0[r] *= f; st.o1[r] *= f; st.nv[r] = ng; }
    }
#endif
}
__device__ __forceinline__ void qk_issue(const WCtx& c, unsigned ktile, const bf16x8 (&qr)[4], f32x16& p0, f32x16& p1) {
    lds_cptr kt = c.ldsp + ktile;
    bf16x8 kf[8];
#pragma unroll
    for (int d0 = 0; d0 < 4; ++d0) { const unsigned off = c.koff ^ (d0 << 5); kf[2 * d0] = *(LAS const bf16x8*)(kt + off); kf[2 * d0 + 1] = *(LAS const bf16x8*)(kt + off + 4096); }
    __builtin_amdgcn_sched_barrier(0);
    __builtin_amdgcn_s_setprio(1);
#pragma unroll
    for (int d0 = 0; d0 < 4; ++d0) {
        p0 = __builtin_amdgcn_mfma_f32_32x32x16_bf16(kf[2 * d0], qr[d0], p0, 0, 0, 0);
        p1 = __builtin_amdgcn_mfma_f32_32x32x16_bf16(kf[2 * d0 + 1], qr[d0], p1, 0, 0, 0);
    }
    __builtin_amdgcn_s_setprio(0);
}
__device__ __forceinline__ void sm_pv(const WCtx& c, unsigned vtile, AState& st, f32x16 p0, f32x16 p1) {
    astate_recheck(st, c);
    astate_shift(st, p0, p1);
#pragma unroll
    for (int r = 0; r < 16; ++r) { p0[r] = fast_exp2(p0[r]); p1[r] = fast_exp2(p1[r]); }
    tile_pv<true>(c, c.ldsp + vtile, st.o0, st.o1, p0, p1, &st.ls);
}
__device__ __forceinline__ void issue_piece_kv(const WCtx& c, const bf16* Kb, const bf16* Vb, unsigned rowidx, unsigned kt_off, unsigned vt_off, int pc) {
    issue_k_piece(c, Kb, rowidx, c.lds0 + kt_off, pc); issue_v_piece(c, Vb, rowidx, c.lds0 + vt_off, pc);
}
__device__ __forceinline__ void astate_fold(const AState& st, const WCtx& c, float w, f32x16& a0, f32x16& a1) {
#if MK_LSUM
    const float lt = astate_l(st, c);
#else
    const float lt = sum_x32(st.l);
#endif
    const float sc = lt > 0.f ? w / lt : 0.f;
#pragma unroll
    for (int r = 0; r < 16; ++r) { a0[r] += st.o0[r] * sc; a1[r] += st.o1[r] * sc; }
}
__device__ __forceinline__ void store_o(const WCtx& c, bf16* orow, const f32x16& a0, const f32x16& a1) {
#pragma unroll
    for (int g = 0; g < 4; ++g) {
        u32x2 w0, w1; w0.x = cvtpk(a0[4 * g], a0[4 * g + 1]); w0.y = cvtpk(a0[4 * g + 2], a0[4 * g + 3]); w1.x = cvtpk(a1[4 * g], a1[4 * g + 1]); w1.y = cvtpk(a1[4 * g + 2], a1[4 * g + 3]);
        *(u32x2*)(orow + 8 * g + 4 * c.hi) = w0; *(u32x2*)(orow + 32 + 8 * g + 4 * c.hi) = w1;
    }
}
__device__ __forceinline__ void load_q(bf16x8 (&qr)[4], const bf16* qrow, int hi) {
#pragma unroll
    for (int d0 = 0; d0 < 4; ++d0) qr[d0] = *(const bf16x8*)(qrow + d0 * 16 + hi * 8);
}
__device__ __forceinline__ void lds_or(LAS unsigned* p, unsigned v) { __hip_atomic_fetch_or(p, v, __ATOMIC_RELAXED, __HIP_MEMORY_SCOPE_WORKGROUP); }
template <int N> __device__ __forceinline__ void build_tab_ld(float (&v)[(N + 511) / 512], const float* biasd_h, int maxd, int tid) {
    asm volatile("" : "+v"(tid));
#pragma unroll
    for (int j = 0; j < (N + 511) / 512; ++j) { const int d = tid + 512 * j - 64; v[j] = biasd_h[clampi(d, 0, maxd)]; }
}
template <int N> __device__ __forceinline__ void build_tab_st(LAS float* tab, const float (&v)[(N + 511) / 512], int maxd, int tid) {
    asm volatile("" : "+v"(tid));
#pragma unroll
    for (int j = 0; j < (N + 511) / 512; ++j) { const int i = tid + 512 * j, d = i - 64; if (i < N) tab[N - 1 - i] = (d < 0 || d > maxd) ? -INFINITY : v[j]; }
}
template <int N> __device__ __forceinline__ void build_tab(LAS float* tab, const float* biasd_h, int maxd, int tid) {
    float v[(N + 511) / 512]; build_tab_ld<N>(v, biasd_h, maxd, tid); build_tab_st<N>(tab, v, maxd, tid);
}

constexpr int UW_OFF = 32768, TABF = 2112, TABWN = 704, MOBA_BUF1 = 49152;
#ifndef MK_TWO
#define MK_TWO 0
#endif
struct NoBg { int pend = 0; __device__ __forceinline__ void even() {} __device__ __forceinline__ void odd() {} };
template <int GH = 0, class BG = NoBg> __device__ __forceinline__ void moba_unit(LAS unsigned char* L_, int wid, int b, int h, int j, const bf16* Q, const bf16* K, const bf16* V, bf16* O, LAS const float* tab, LAS const float* km, BG& bg, float* probe_out = nullptr) {
    const WCtx c = make_ctx(L_);
#if MK_PROBE >= 11
    const unsigned long long mp_t0 = __builtin_amdgcn_s_memrealtime(); unsigned long long mp_acc = 0; unsigned mp_n = 0;
#endif
    const size_t hb = (size_t)(b * NH + h) * SEQ;
    const bf16* Kb = K + hb * HD; const bf16* Vb = V + hb * HD;
    const int t0 = 256 * j + 32 * wid, tq = t0 + c.r32;
    const bf16* qrow = Q + (hb + tq) * HD;
    if (GH != 1) issue_piece(c, Kb, Vb, (unsigned)(256 * j + 8 * wid + (c.lane >> 3)), c.lds0, wid);
#if MK_TWO
    issue_piece(c, Kb, Vb, (unsigned)(256 * j + 64 + 8 * wid + (c.lane >> 3)), c.lds0 + TILE_B, wid);
#endif
    bf16x8 qr[4]; load_q(qr, qrow, c.hi);
    unsigned sel = 0u;
    if (j > 0) {
        float g4[4] = {0.f, 0.f, 0.f, 0.f};
#pragma unroll
        for (int ch = 0; ch < 8; ++ch) {
            const u32x4 qq = *(const u32x4*)(qrow + 8 * ch);
            const float qf[8] = {__builtin_bit_cast(float, qq.x << 16), __builtin_bit_cast(float, qq.x & 0xffff0000u), __builtin_bit_cast(float, qq.y << 16), __builtin_bit_cast(float, qq.y & 0xffff0000u),
                                 __builtin_bit_cast(float, qq.z << 16), __builtin_bit_cast(float, qq.z & 0xffff0000u), __builtin_bit_cast(float, qq.w << 16), __builtin_bit_cast(float, qq.w & 0xffff0000u)};
#pragma unroll
            for (int k = 0; k < 4; ++k) { LAS const float* kr = km + (2 * k + c.hi) * 64 + 8 * ch;
                const f32x4 a = *(LAS const f32x4*)kr, bq = *(LAS const f32x4*)(kr + 4);
                g4[k] += (qf[0] * a[0] + qf[1] * a[1]) + (qf[2] * a[2] + qf[3] * a[3]) + (qf[4] * bq[0] + qf[5] * bq[1]) + (qf[6] * bq[2] + qf[7] * bq[3]); }
        }
        float ga[8];
#pragma unroll
        for (int k = 0; k < 4; ++k) { const float ot = __shfl_xor(g4[k], 32); ga[2 * k] = c.hi ? ot : g4[k]; ga[2 * k + 1] = c.hi ? g4[k] : ot; }
#pragma unroll
        for (int n = 0; n < 8; ++n) if (n >= j) ga[n] = -INFINITY;
#pragma unroll
        for (int n = 0; n < 8; ++n) { int rank = 0;
#pragma unroll
            for (int n2 = 0; n2 < 8; ++n2) if (n2 != n) rank += (n2 < n) ? (ga[n2] >= ga[n] ? 1 : 0) : (ga[n2] > ga[n] ? 1 : 0);
            if (rank < 3 && n < j) sel |= 1u << n; }
    }
    LAS unsigned* UW = (LAS unsigned*)(L_ + UW_OFF);
    if (j > 0) { lds_or(UW, sel); lds_or(UW + 1 + wid, sel); }
    vm_wait0(); __syncthreads();
    const unsigned U = __builtin_amdgcn_readfirstlane(UW[0]), wsel = __builtin_amdgcn_readfirstlane(UW[1 + wid]);
    AState st; astate_init(st);
    const int ntile = 4 + 4 * __builtin_popcount(U);
    int blk = j, kt = 0; unsigned rest = U; int slot = 0;
#if MK_TWO
    int pblk = j; unsigned prest = U;
#endif
#if MK_PROBE >= 11
    const unsigned long long mp_t1 = __builtin_amdgcn_s_memrealtime();
#endif
#if MK_PIPE
    {
        constexpr unsigned TV2 = 32768;
        auto tv_off = [](int s) -> unsigned { return s == 2 ? TV2 : (unsigned)s * TILE_B; };
        auto is_active = [&](int bk, int k) { return (bk == j) ? (k <= (wid >> 1)) : (((wsel >> bk) & 1u) != 0u); };
        auto bias_ptr = [&](int bk, int k) { const bool mn = (bk == j) ? true : (((sel >> bk) & 1u) != 0u); return tab + (TABF - 64 - (mn ? (tq - (256 * bk + 64 * k) + 1 - 4 * c.hi) : 0)); };
        int b1 = j, k1 = 1, b2 = j, k2 = 2; unsigned r2 = U;
        issue_piece_kv(c, Kb, Vb, (unsigned)(256 * b1 + 64 * k1 + 8 * wid + (c.lane >> 3)), TILE_B, tv_off(1), wid);
        f32x16 p0, p1, n0, n1;
        bias_ld(bias_ptr(j, 0), p0, p1);
        qk_issue(c, 0u, qr, p0, p1);
        if (is_active(b1, k1)) bias_ld(bias_ptr(b1, k1), n0, n1);
        int vs = 0;
        for (int it = 0; it < ntile; ++it) {
            if (it + 1 < ntile) { vm_wait0(); __syncthreads(); }
            if (it + 2 < ntile) issue_piece_kv(c, Kb, Vb, (unsigned)(256 * b2 + 64 * k2 + 8 * wid + (c.lane >> 3)), (unsigned)(it & 1) * TILE_B, tv_off(vs == 0 ? 2 : vs - 1), wid);
            const bool act = is_active(blk, kt), actn = (it + 1 < ntile) && is_active(b1, k1);
            if (actn) qk_issue(c, (unsigned)((it + 1) & 1) * TILE_B, qr, n0, n1);
            if (act) sm_pv(c, tv_off(vs), st, p0, p1);
            p0 = n0; p1 = n1;
            if (it + 2 < ntile && is_active(b2, k2)) bias_ld(bias_ptr(b2, k2), n0, n1);
            blk = b1; kt = k1; b1 = b2; k1 = k2;
            if (++k2 == 4) { k2 = 0; b2 = __builtin_ctz(r2 | 0x80000000u); r2 &= r2 - 1; }
            vs = vs == 2 ? 0 : vs + 1;
        }
    }
#else
    f32x16 bb0, bb1;
#if MK_MOBA_PF
    bias_ld(tab + (TABF - 64 - (tq - 256 * j + 1 - 4 * c.hi)), bb0, bb1);
#endif
    for (int it = 0; it < ntile; ++it) {
#if MK_PROBE >= 15
        const unsigned long long mp_b = __builtin_amdgcn_s_memrealtime();
#endif
        int nblk = blk, nkt = kt + 1; unsigned nrest = rest;
        if (nkt == 4) { nkt = 0; nblk = __builtin_ctz(nrest | 0x80000000u); nrest &= nrest - 1; }
#if MK_TWO
        if ((it & 1) == 0) {
            if (it) { vm_wait0(); __syncthreads(); }
            if (it + 2 < ntile) {
                if (((it + 2) & 3) == 0) { pblk = __builtin_ctz(prest | 0x80000000u); prest &= prest - 1; }
                const unsigned nb_off = (((it >> 1) + 1) & 1) ? (unsigned)MOBA_BUF1 : 0u; const int pk = (it + 2) & 3;
                issue_piece(c, Kb, Vb, (unsigned)(256 * pblk + 64 * pk + 8 * wid + (c.lane >> 3)), c.lds0 + nb_off, wid);
                issue_piece(c, Kb, Vb, (unsigned)(256 * pblk + 64 * (pk + 1) + 8 * wid + (c.lane >> 3)), c.lds0 + nb_off + TILE_B, wid);
            }
        }
        const unsigned tile_off = (((it >> 1) & 1) ? (unsigned)MOBA_BUF1 : 0u) + (unsigned)(it & 1) * TILE_B;
#else
        if (it) {
            if (bg.pend == 10) asm volatile("s_waitcnt vmcnt(10) lgkmcnt(0)\n\ts_barrier" ::: "memory");
            else if (bg.pend == 8) asm volatile("s_waitcnt vmcnt(8) lgkmcnt(0)\n\ts_barrier" ::: "memory");
            else if (bg.pend == 4) asm volatile("s_waitcnt vmcnt(4) lgkmcnt(0)\n\ts_barrier" ::: "memory");
            else if (bg.pend == 2) asm volatile("s_waitcnt vmcnt(2) lgkmcnt(0)\n\ts_barrier" ::: "memory");
            else asm volatile("s_waitcnt vmcnt(0) lgkmcnt(0)\n\ts_barrier" ::: "memory"); }
        if (GH != 1 && it + 1 < ntile) issue_piece(c, Kb, Vb, (unsigned)(256 * nblk + 64 * nkt + 8 * wid + (c.lane >> 3)), c.lds0 + (slot ^ 1) * TILE_B, wid);
        const unsigned tile_off = (unsigned)slot * TILE_B;
#endif
        const int k0 = 256 * blk + 64 * kt;
        const bool own = (blk == j);
        const bool mine = own ? true : ((sel >> blk) & 1u);
        const bool active = own ? (kt <= (wid >> 1)) : ((wsel >> blk) & 1u);
#if MK_PROBE == 15
        mp_acc += __builtin_amdgcn_s_memrealtime() - mp_b; ++mp_n;
#endif
        if (active) {
            if (MK_STAGGER && wid >= 4) __builtin_amdgcn_s_sleep(MK_STAGGER);
#if MK_PROBE >= 11 && MK_PROBE < 15
            const unsigned long long mp_a = __builtin_amdgcn_s_memrealtime();
#endif
#if !MK_MOBA_PF
            bias_ld(tab + (TABF - 64 - (mine ? (tq - k0 + 1 - 4 * c.hi) : 0)), bb0, bb1);
#endif
            tile_step_fast(c, tile_off, st, qr, bb0, bb1);
#if MK_PROBE >= 11 && MK_PROBE < 15
            asm volatile("s_nop 0" :: "v"(st.o0[0]), "v"(st.o1[15])); mp_acc += __builtin_amdgcn_s_memrealtime() - mp_a; ++mp_n;
#endif
        }
#if MK_PROBE == 16
        asm volatile("s_nop 0" :: "v"(st.o0[0]), "v"(st.o1[15])); mp_acc += __builtin_amdgcn_s_memrealtime() - mp_b; ++mp_n;
#endif
        if (MK_MOBA_PF && it + 1 < ntile) {
            const bool nown = (nblk == j);
            const bool nmine = nown ? true : ((sel >> nblk) & 1u);
            const bool nactive = nown ? (nkt <= (wid >> 1)) : ((wsel >> nblk) & 1u);
            if (nactive) bias_ld(tab + (TABF - 64 - (nmine ? (tq - (256 * nblk + 64 * nkt) + 1 - 4 * c.hi) : 0)), bb0, bb1);
        }
        if (it & 1) bg.odd(); else bg.even();
        blk = nblk; kt = nkt; rest = nrest; slot ^= 1;
    }
#endif
    f32x16 a0, a1;
#pragma unroll
    for (int r = 0; r < 16; ++r) { a0[r] = 0.f; a1[r] = 0.f; }
    astate_fold(st, c, 1.0f, a0, a1);
    if (GH == 0 || a0[0] == 123456.789f) store_o(c, O + ((size_t)b * SEQ + tq) * DM + h * HD, a0, a1);
#if MK_PROBE >= 11
    if (MK_PROBE < 20 && blockIdx.x == 0 && threadIdx.x == 0 && j == 7 && probe_out) { const unsigned long long mp_t2 = __builtin_amdgcn_s_memrealtime();
        probe_out[0] = (MK_PROBE == 11 || MK_PROBE >= 15) ? (float)mp_acc / (float)(mp_n ? mp_n : 1) : (MK_PROBE == 12) ? (float)(mp_t1 - mp_t0) : (MK_PROBE == 13) ? (float)(mp_t2 - mp_t0) : (float)mp_n; }
#endif
    if (threadIdx.x < 9) UW[threadIdx.x] = 0u;
    lgkm_wait0(); __syncthreads();
}

constexpr int DT_LEN = 258, DT1_OFF = 0, DT4_OFF = 16 * DT_LEN, DT16_OFF = 20 * DT_LEN, DT_TOTAL = 21 * DT_LEN;
__device__ __forceinline__ void build_dil_tabs(LAS float* tab, const float* biasd_h, int tid) {
    constexpr int IT = (DT_TOTAL + 511) / 512;
    float v[IT];
    asm volatile("" : "+v"(tid));
#pragma unroll
    for (int j = 0; j < IT; ++j) { const int i = tid + 512 * j, cp = i / DT_LEN, e = i - cp * DT_LEN, step = e - 64;
        const int r = cp < 16 ? 1 : cp < 20 ? 4 : 16, maxstep = r == 16 ? 127 : 128;
        v[j] = biasd_h[r * clampi(step, 0, maxstep)]; }
#pragma unroll
    for (int j = 0; j < IT; ++j) { const int i = tid + 512 * j, cp = i / DT_LEN, e = i - cp * DT_LEN, step = e - 64;
        const int r = cp < 16 ? 1 : cp < 20 ? 4 : 16, maxstep = r == 16 ? 127 : 128;
        if (i < DT_TOTAL) tab[cp * DT_LEN + (DT_LEN - 1 - e)] = (step < 0 || step > maxstep) ? -INFINITY : v[j]; }
}
template <int PASS> __device__ __forceinline__ void dil_wave(LAS unsigned char* L_, int wid, int b, int h, int chunk, int idx, const bf16* Q, const bf16* K, const bf16* V, bf16* O, LAS const float* tab,
                                                             bf16* SO, float* SM, float* SL) {
    const WCtx c = make_ctx(L_);
    const size_t hb = (size_t)(b * NH + h) * SEQ;
    const bf16* Kb = K + hb * HD; const bf16* Vb = V + hb * HD;
    const int t0 = 512 * chunk + (PASS == 0 ? 32 * idx : idx), tq = t0 + (PASS == 0 ? c.r32 : 16 * c.r32);
    const size_t srow = (size_t)(b * 8 + (h - 8)) * SEQ + tq;
    bf16x8 qr[4]; load_q(qr, Q + (hb + tq) * HD, c.hi);
    AState st; astate_init(st);
    if (PASS == 1) {
        const bf16* sp = SO + srow * HD + 4 * c.hi;
#pragma unroll
        for (int g = 0; g < 4; ++g) { const u32x2 w0 = __builtin_nontemporal_load((const u32x2*)(sp + 8 * g)), w1 = __builtin_nontemporal_load((const u32x2*)(sp + 32 + 8 * g));
            st.o0[4 * g] = __builtin_bit_cast(float, w0.x << 16); st.o0[4 * g + 1] = __builtin_bit_cast(float, w0.x & 0xffff0000u); st.o0[4 * g + 2] = __builtin_bit_cast(float, w0.y << 16); st.o0[4 * g + 3] = __builtin_bit_cast(float, w0.y & 0xffff0000u);
            st.o1[4 * g] = __builtin_bit_cast(float, w1.x << 16); st.o1[4 * g + 1] = __builtin_bit_cast(float, w1.x & 0xffff0000u); st.o1[4 * g + 2] = __builtin_bit_cast(float, w1.y << 16); st.o1[4 * g + 3] = __builtin_bit_cast(float, w1.y & 0xffff0000u); }
        st.mhat = __builtin_nontemporal_load(SM + srow);
        const float lt = __builtin_nontemporal_load(SL + srow);
#if MK_LSUM
        st.sh = __any(st.mhat != 0.f);
        { const float lo = __shfl(lt, (c.lane & 15) + 16); st.ls[0] = c.lane < 16 ? lt : 0.f; st.ls[1] = c.lane < 16 ? lo : 0.f; }
#else
        { const float ng = -st.mhat * (1.0f / C2);
#pragma unroll
            for (int r = 0; r < 16; ++r) st.nv[r] = ng; }
        st.l = c.hi ? 0.f : lt;
#endif
    }
    const unsigned tile = wid * TILE_B, tile_lds = c.lds0 + tile;
    auto k0_of = [&](int br, int kt) { const int sh = 2 * br; return t0 - (128 << sh) + ((64 * kt) << sh); };
    auto advance = [&](int& br, int& kt) { for (;;) { ++kt; if (kt == (br == 0 ? 3 : br == 1 ? 4 : 3)) { kt = 0; ++br; if (PASS == 0) br = 3; } if (br >= 3) return; if (k0_of(br, kt) + (63 << (2 * br)) >= 0) return; } };
    auto issue_k = [&](int br, int kt) { const int sh = 2 * br, k0 = k0_of(br, kt);
#pragma unroll
        for (int pc = 0; pc < 8; ++pc) issue_k_piece(c, Kb, (unsigned)clampi(k0 + ((8 * pc + (c.lane >> 3)) << sh), 0, SEQ - 1), tile_lds, pc); };
    auto issue_v = [&](int br, int kt) { const int sh = 2 * br, k0 = k0_of(br, kt);
#pragma unroll
        for (int pc = 0; pc < 8; ++pc) issue_v_piece(c, Vb, (unsigned)clampi(k0 + ((8 * pc + (c.lane >> 3)) << sh), 0, SEQ - 1), tile_lds, pc); };
    int br = (PASS == 0) ? 0 : 1, kt = -1; advance(br, kt);
    lgkm_wait0();
    if (br < 3) { issue_k(br, kt); issue_v(br, kt); }
#pragma unroll 1
    while (br < 3) {
        int nbr = br, nkt = kt; advance(nbr, nkt);
        const bool has_next = nbr < 3;
        const int sh = 2 * br, k0 = k0_of(br, kt);
        LAS const float* tb = tab + (br == 0 ? DT1_OFF : br == 1 ? DT4_OFF : DT16_OFF);
        LAS const float* tcopy = tb + (br == 0 ? 0 : br == 1 ? ((c.r32 >> 3) & 3) : 0) * DT_LEN;
        const int sb = (tq - k0) >> sh;
        const bool fastp = k0 >= 0, inr = (sb >= -1) && (sb <= 128 + 63);
        f32x16 bb0, bb1;
#if MK_DIL_PF
        if (fastp) bias_ld(inr ? tcopy + (DT_LEN - 64 - (sb + 1 - 4 * c.hi)) : tb + (DT_LEN - 64), bb0, bb1);
#endif
        vm_wait8();
#if !MK_DIL_PF
        if (fastp) bias_ld(inr ? tcopy + (DT_LEN - 64 - (sb + 1 - 4 * c.hi)) : tb + (DT_LEN - 64), bb0, bb1);
#endif
        auto h1 = [&]() { lgkm_wait0(); if (has_next) issue_k(nbr, nkt); };
        auto h2 = [&]() { if (has_next) vm_wait8(); else vm_wait0(); };
        auto h3 = [&]() { lgkm_wait0(); if (has_next) issue_v(nbr, nkt); };
        if (fastp) {
            tile_step_fast<0>(c, tile, st, qr, bb0, bb1, h1, h2, h3);
        } else {
            const int lim = tq >> sh;
            tile_step(c, tile, st, qr, [&](int rr, int half) { const int s = sb - ((rr & 3) + 8 * (rr >> 2) + 4 * c.hi + 32 * half);
                return tb[DT_LEN - 1 - ((s > lim) ? 0 : clampi(s + 64, 0, DT_LEN - 1))]; }, h1, h2, h3);
        }
        br = nbr; kt = nkt;
    }
    if (PASS == 0) {
        store_o(c, SO + srow * HD, st.o0, st.o1);
#if MK_LSUM
        const float lt = astate_l(st, c);
#else
        const float lt = sum_x32(st.l);
#endif
        if (c.hi == 0) { SM[srow] = st.mhat; SL[srow] = lt; }
    } else {
        f32x16 a0, a1;
#pragma unroll
        for (int r = 0; r < 16; ++r) { a0[r] = 0.f; a1[r] = 0.f; }
        astate_fold(st, c, 1.0f, a0, a1);
        store_o(c, O + ((size_t)b * SEQ + tq) * DM + h * HD, a0, a1);
    }
    lgkm_wait0();
}

constexpr int IMP_OFF = 33024, SELW_OFF = 145664;
template <int GHOST> __device__ __forceinline__ void nsa_unit(int wid, LAS unsigned char* lds, int b, int g, int chunk, const bf16* Q, const bf16* KV1, const bf16* KC, const bf16* VC,
                                         const float* gates, bf16* O, LAS const float* tabs, float* probe_out = nullptr) {
    const WCtx c = make_ctx(lds);
#if MK_PROBE >= 3
    const unsigned long long pu_t0 = __builtin_amdgcn_s_memrealtime();
#endif
    const int hh = wid & 3, qt = wid >> 2, h = 4 * g + hh;
    LAS const float* tab = tabs + hh * TABF; LAS const float* tabw = tabs + 4 * TABF + hh * TABWN;
    const int t0 = 64 * chunk + 32 * qt, tq = t0 + c.r32, cur = chunk;
    const bool late = cur >= 16;
    const size_t qb = (size_t)(b * NH + h) * SEQ, gb = (size_t)(b * 4 + g) * SEQ, TS = (size_t)BATCH * 4 * SEQ * HD;
    const bf16* KCb = KC + (size_t)(b * 4 + g) * 128 * HD; const bf16* VCb = VC + (size_t)(b * 4 + g) * 128 * HD;
    issue_piece(c, KCb, VCb, (unsigned)(8 * wid + (c.lane >> 3)), c.lds0, wid);
    if (late) issue_piece(c, KCb, VCb, (unsigned)(64 + 8 * wid + (c.lane >> 3)), c.lds0 + TILE_B, wid);
    bf16x8 qr[4]; load_q(qr, Q + (qb + tq) * HD, c.hi);
    const float* grow = gates + ((size_t)b * SEQ + tq) * 48 + 3 * h;
    const float g0 = grow[0], g1 = grow[1], g2 = grow[2];
    f32x16 a0, a1;
#pragma unroll
    for (int r = 0; r < 16; ++r) { a0[r] = 0.f; a1[r] = 0.f; }
    vm_wait0(); __syncthreads();
#if MK_PROBE >= 3
    const unsigned long long pu_ta = __builtin_amdgcn_s_memrealtime();
#endif
    LAS float* IA = (LAS float*)(lds + IMP_OFF + wid * 8448); LAS float* IB = IA + 32 * 33;
    {
        f32x16 p[4];
        const int db = tq - 31 + 64 - 64 * c.hi;
#pragma unroll
        for (int T = 0; T < 4; ++T)
#pragma unroll
            for (int r = 0; r < 16; ++r) { const int idx = db - 16 * (32 * T + (r & 3) + 8 * (r >> 2)); p[T][r] = (T < 2 || late) ? tab[TABF - 1 - clampi(idx, 0, TABF - 1)] : 0.f; }
        tile_qk(c, c.ldsp, qr, p[0], p[1]);
        if (late) tile_qk(c, c.ldsp + TILE_B, qr, p[2], p[3]);
        float rm = -INFINITY;
#pragma unroll
        for (int T = 0; T < 4; ++T) { if (T < 2 || late) {
#pragma unroll
            for (int r = 0; r < 16; ++r) rm = fmaxf(rm, p[T][r]); } }
        rm = max_x32(rm);
        const float mu = fmaxf(rm, -1e30f);
        float lsum = 0.f;
#pragma unroll
        for (int T = 0; T < 4; ++T) { if (T < 2 || late) {
#pragma unroll
            for (int r = 0; r < 16; ++r) { p[T][r] = fast_exp2(p[T][r] - mu); lsum += p[T][r]; } } }
        lsum = sum_x32(lsum);
        const float linv = lsum > 0.f ? 1.0f / lsum : 0.f;
#pragma unroll
        for (int T = 0; T < 4; ++T)
#pragma unroll
            for (int r = 0; r < 16; ++r) p[T][r] *= linv;
        tile_pv(c, c.ldsp, a0, a1, p[0], p[1]);
        if (late) tile_pv(c, c.ldsp + TILE_B, a0, a1, p[2], p[3]);
#pragma unroll
        for (int r = 0; r < 16; ++r) { a0[r] *= g0; a1[r] *= g0; }
        if (late) {
#pragma unroll
            for (int T = 0; T < 4; ++T)
#pragma unroll
                for (int gq = 0; gq < 4; ++gq) { const int n = 8 * T + 2 * gq + c.hi; const float b3 = 16.f * p[T][4 * gq + 3];
                    IA[c.r32 * 33 + n] = 32.f * (p[T][4 * gq] + p[T][4 * gq + 1] + p[T][4 * gq + 2]) + b3; IB[c.r32 * 33 + n] = b3; }
        }
    }
    lgkm_wait0(); __syncthreads();
    const bf16* Ks = KV1 + 2 * TS + gb * HD; const bf16* Vs = KV1 + 3 * TS + gb * HD;
    const bf16* Kw = KV1 + 4 * TS + gb * HD; const bf16* Vw = KV1 + 5 * TS + gb * HD;
    if (GHOST != 1) issue_piece(c, Ks, Vs, (unsigned)(8 * wid + (c.lane >> 3)), c.lds0, wid);
    unsigned selm = (cur >= 31) ? 0xffffffffu : ((2u << cur) - 1u);
    LAS unsigned* UW = (LAS unsigned*)(lds + UW_OFF);
    if (late) {
        float imp[16];
#pragma unroll
        for (int k = 0; k < 16; ++k) imp[k] = 0.f;
#pragma unroll
        for (int w4 = 0; w4 < 4; ++w4) { LAS const float* A = (LAS const float*)(lds + IMP_OFF + (w4 + 4 * qt) * 8448) + c.r32 * 33; LAS const float* Bq = A + 32 * 33;
#pragma unroll
            for (int k = 0; k < 16; ++k) { const int n = 16 * c.hi + k; imp[k] += A[n] + (n > 0 ? Bq[n - 1] : 0.f); } }
        int mine[16], oth[16];
#pragma unroll
        for (int k = 0; k < 16; ++k) { const int n = 16 * c.hi + k; const bool valid = n <= cur, forced = (n == 0) || (n == cur) || (n == cur - 1);
            mine[k] = !valid ? -2 : forced ? 0x7f000000 : __builtin_bit_cast(int, imp[k]);
            oth[k] = __shfl_xor(mine[k], 32); }
        unsigned sm = 0u;
#pragma unroll
        for (int k = 0; k < 16; ++k) { if ((k >> 2) == hh) { int rank = 0; const int me = mine[k], me1 = mine[k] - 1, meo = mine[k] - c.hi;
#pragma unroll
            for (int k2 = 0; k2 < 16; ++k2) { if (k2 < k) rank += mine[k2] > me1 ? 1 : 0; else if (k2 > k) rank += mine[k2] > me ? 1 : 0; rank += oth[k2] > meo ? 1 : 0; }
            if (rank < 16) sm |= 1u << k; } }
        sm <<= 16 * c.hi;
        LAS unsigned* SELW = (LAS unsigned*)(lds + SELW_OFF) + 32 * qt + c.r32;
        lds_or(SELW, sm);
        lgkm_wait0(); __syncthreads();
        selm &= *SELW;
        lds_or(UW, selm); lds_or(UW + 1 + wid, selm);
        lgkm_wait0(); __syncthreads();
    }
    const unsigned U = late ? __builtin_amdgcn_readfirstlane(UW[0]) : ((cur >= 31) ? 0xffffffffu : ((2u << cur) - 1u)), wsel = late ? __builtin_amdgcn_readfirstlane(UW[1 + wid]) : U;
    LAS float* stash = (LAS float*)(lds + IMP_OFF + wid * 8448);
#pragma unroll
    for (int r = 0; r < 16; ++r) { stash[r * 64 + c.lane] = a0[r]; stash[(16 + r) * 64 + c.lane] = a1[r]; }
    const int nsel = __builtin_popcount(U);
    int wlo = 64 * chunk - 511; wlo = wlo < 0 ? 0 : wlo; const int w0 = wlo >> 6, nwin = chunk - w0 + 1;
    const int ntile = nsel + nwin;
    AState st; astate_init(st);
    unsigned rest = U & (U - 1); int slot = 0; int tn = 0;
    auto tile_bias = [&](int itx, int tnx, f32x16& b0, f32x16& b1) { const int k0x = 64 * tnx;
        if (itx < nsel) { if ((wsel >> tnx) & 1u) { const bool mn = (selm >> tnx) & 1u; bias_ld(tab + (TABF - 64 - (mn ? (tq - k0x + 1 - 4 * c.hi) : 0)), b0, b1); } }
        else if (k0x + 63 >= t0 - 511) bias_ld(tabw + (TABWN - 64 - (tq - k0x + 1 - 4 * c.hi)), b0, b1); };
    f32x16 bb0, bb1; tile_bias(0, 0, bb0, bb1);
#if MK_PROBE
    unsigned long long pr_acc = 0; unsigned pr_n = 0;
#endif
#if MK_PROBE >= 3
    const unsigned long long pu_t1 = __builtin_amdgcn_s_memrealtime();
#endif
    for (int it = 0; it < ntile; ++it) {
        const bool is_win = it >= nsel;
        const int nit = it + 1; const bool n_win = nit >= nsel;
        int ntn; unsigned nrest = rest;
        if (n_win) ntn = w0 + (nit - nsel); else { ntn = __builtin_ctz(nrest | 0x80000000u); nrest &= nrest - 1; }
#if MK_PROBE == 8 || MK_PROBE == 9
        const unsigned long long pw_t0 = __builtin_amdgcn_s_memrealtime();
        vm_wait0();
        const unsigned long long pw_t1 = __builtin_amdgcn_s_memrealtime();
        __syncthreads();
        const unsigned long long pw_t2 = __builtin_amdgcn_s_memrealtime();
        pr_acc += (MK_PROBE == 8) ? (pw_t1 - pw_t0) : (pw_t2 - pw_t1); ++pr_n;
#else
        vm_wait0(); if (GHOST != 2) __syncthreads();
#endif
        if (GHOST != 1 && nit < ntile) issue_piece(c, n_win ? Kw : Ks, n_win ? Vw : Vs, (unsigned)(64 * ntn + 8 * wid + (c.lane >> 3)), c.lds0 + (slot ^ 1) * TILE_B, wid);
        if (it == nsel) {
#pragma unroll
            for (int r = 0; r < 16; ++r) { a0[r] = stash[r * 64 + c.lane]; a1[r] = stash[(16 + r) * 64 + c.lane]; }
            astate_fold(st, c, g1, a0, a1); astate_init(st);
#pragma unroll
            for (int r = 0; r < 16; ++r) { stash[r * 64 + c.lane] = a0[r]; stash[(16 + r) * 64 + c.lane] = a1[r]; } }
        const int k0 = 64 * tn;
        if (!is_win) {
            if ((wsel >> tn) & 1u) {
#if MK_PROBE == 1 || MK_PROBE == 2
                const unsigned long long pr_t0 = (MK_PROBE == 1) ? __builtin_amdgcn_s_memtime() : __builtin_amdgcn_s_memrealtime();
#endif
                tile_step_fast<GHOST>(c, slot * TILE_B, st, qr, bb0, bb1);
#if MK_PROBE == 1 || MK_PROBE == 2
                asm volatile("s_nop 0" :: "v"(st.o0[0]), "v"(st.o1[15]));
                pr_acc += ((MK_PROBE == 1) ? __builtin_amdgcn_s_memtime() : __builtin_amdgcn_s_memrealtime()) - pr_t0; ++pr_n;
#endif
            }
        } else {
            if (k0 + 63 >= t0 - 511) {
                if (MK_STAGGER && wid >= 4) __builtin_amdgcn_s_sleep(MK_STAGGER);
                tile_step_fast<GHOST>(c, slot * TILE_B, st, qr, bb0, bb1); }
        }
        if (nit < ntile) tile_bias(nit, ntn, bb0, bb1);
        tn = ntn; rest = nrest; slot ^= 1;
    }
#pragma unroll
    for (int r = 0; r < 16; ++r) { a0[r] = stash[r * 64 + c.lane]; a1[r] = stash[(16 + r) * 64 + c.lane]; }
    astate_fold(st, c, g2, a0, a1);
    if (GHOST == 0 || a0[0] == 123456.789f) store_o(c, O + ((size_t)b * SEQ + tq) * DM + h * HD, a0, a1);
    if (threadIdx.x < 9) UW[threadIdx.x] = 0u;
    if (late && threadIdx.x < 64) ((LAS unsigned*)(lds + SELW_OFF))[threadIdx.x] = 0u;
#if MK_PROBE
#if MK_PROBE >= 3 && MK_PROBE <= 6
    { const unsigned long long pu_t2 = __builtin_amdgcn_s_memrealtime(); pr_acc = (MK_PROBE == 3) ? (pu_t1 - pu_t0) : (MK_PROBE == 4) ? (pu_t2 - pu_t0) : (MK_PROBE == 6) ? (pu_ta - pu_t0) : (pu_t2 - pu_t1); pr_n = 1; }
#endif
    if (MK_PROBE < 11 && blockIdx.x == 0 && threadIdx.x == 0) { const float pv_ = (float)pr_acc / (float)(pr_n ? pr_n : 1); probe_out[0] = (MK_PROBE >= 3 && MK_PROBE <= 6 && chunk != 0) ? probe_out[0] + pv_ : pv_; }
#endif
    lgkm_wait0(); __syncthreads();
}

#define LDS_WAIT() asm volatile("s_waitcnt lgkmcnt(0)" ::: "memory")
#define VM_WAIT() asm volatile("s_waitcnt vmcnt(0)" ::: "memory")
constexpr int NWAVES = 8;
__device__ __forceinline__ float wave_sum(float v) {
#pragma unroll
    for (int o = 1; o < 64; o <<= 1) v += __shfl_xor(v, o);
    return v;
}

struct Args { const float* in[33]; float* out; unsigned char* ws; int ph_lo, ph_hi; };

__device__ __forceinline__ void tr_item(const float* src, int Nsrc, int srccol0, const float* gain, bf16* dst, int Kdst, int dstrow0, int k0, LAS float* scr, int lane) {
    const int col = srccol0 + (lane & 31); const bool ok = col < Nsrc;
#pragma unroll 8
    for (int i = 0; i < 32; ++i) { const int kk = 2 * i + (lane >> 5); float v = ok ? src[(size_t)(k0 + kk) * Nsrc + col] : 0.f; if (gain) v *= gain[k0 + kk]; scr[kk * 33 + (lane & 31)] = v; }
    LDS_WAIT(); asm volatile("" ::: "memory");
    const int c = lane & 7;
#pragma unroll
    for (int j = 0; j < 4; ++j) { const int n = (lane >> 3) + 8 * j; const LAS float* s = scr + (8 * c) * 33 + n;
        u32x4 o; o.x = pk2(s[0 * 33], s[1 * 33]); o.y = pk2(s[2 * 33], s[3 * 33]); o.z = pk2(s[4 * 33], s[5 * 33]); o.w = pk2(s[6 * 33], s[7 * 33]);
        *(GAS u32x4*)(dst + (size_t)(dstrow0 + n) * Kdst + k0 + 8 * c) = o; }
    LDS_WAIT(); asm volatile("" ::: "memory");
}
__device__ __forceinline__ void tr_matrix(int item, const float* src, const float* src2, int Ksrc, int Nsrc, int Ndst, int map, const float* gain, bf16* dst, LAS float* scr, int lane) {
    const int nblk = Ndst / 32, kb = item / nblk, nb = item % nblk;
    int srccol0 = 32 * nb; const float* s = src;
    if (map == 1) { const int pn = nb >> 3, pb = nb & 7, half = pb >> 2, hh = pb & 3; srccol0 = 256 * pn + 64 * hh + 32 * half; }
    else if (map == 2) { const int pn = nb >> 3, pb = nb & 7; srccol0 = 128 * pn + 32 * (pb & 3); s = (pb < 4) ? src : src2; }
    tr_item(s, Nsrc, srccol0, gain, dst, Ksrc, 32 * nb, 64 * kb, scr, lane);
}

__device__ __forceinline__ void tr_wg_load(f32x4 (&v)[8], const float* src, const float* src2, int Nsrc, int map, const float* gain, int kb, int nb, int tid) {
    const int c4 = tid & 63;
    const float* s = src; int col;
    if (map == 2) { s = (c4 < 32) ? src : src2; col = 128 * nb + 4 * (c4 & 31); } else col = 256 * nb + 4 * c4;
    const bool ok = col < Nsrc;
#pragma unroll
    for (int i = 0; i < 8; ++i) { const int k = 64 * kb + (tid >> 6) + 8 * i;
        f32x4 x = ok ? *(const GAS f32x4*)(s + (size_t)k * Nsrc + col) : (f32x4){0.f, 0.f, 0.f, 0.f};
        if (gain) x = x * gain[k];
        v[i] = x; }
}
__device__ __forceinline__ void tr_wg_store(const f32x4 (&v)[8], LAS float* T, int map, bf16* dst, int Kdst, int kb, int nb, int tid) {
    const int c4 = tid & 63;
    __syncthreads();
#pragma unroll
    for (int i = 0; i < 8; ++i) *(LAS f32x4*)(T + ((tid >> 6) + 8 * i) * 260 + 4 * c4) = v[i];
    __syncthreads();
    const int ch = tid & 7;
#pragma unroll
    for (int j = 0; j < 4; ++j) { const int n = (tid >> 3) + 64 * j;
        const int lc = (map == 1) ? (64 * ((n >> 5) & 3) + 32 * (n >> 7) + (n & 31)) : n;
        const LAS float* s = T + (8 * ch) * 260 + lc;
        u32x4 o; o.x = cvtpk(s[0 * 260], s[1 * 260]); o.y = cvtpk(s[2 * 260], s[3 * 260]); o.z = cvtpk(s[4 * 260], s[5 * 260]); o.w = cvtpk(s[6 * 260], s[7 * 260]);
        *(GAS u32x4*)(dst + (size_t)(256 * nb + n) * Kdst + 64 * kb + 8 * ch) = o; }
}
struct TrDesc { const float* src; const float* src2; int Nsrc, Kdst, map; const float* gain; bf16* dst; int kb, nb; };

__device__ __forceinline__ int rel_bucket(int d) {
    if (d < 16) return d;
    int b = 16;
    b += d >= 22; b += d >= 30; b += d >= 40; b += d >= 54; b += d >= 73; b += d >= 99; b += d >= 134; b += d >= 182;
    b += d >= 246; b += d >= 332; b += d >= 450; b += d >= 609; b += d >= 825; b += d >= 1117; b += d >= 1513;
    return b;
}

constexpr int TW_IN0 = 16 * (N_IN0 / 256), TW_IN1 = 16 * (N_IN1P / 256), TW_OUT = 16 * 4, TW_GU = 16 * (N_GU / 256), TW_D = (FF / 64) * 4, TW_PG = 16 * 4, TW_PP = 4 * 4;
constexpr int TR_NWI = TW_IN0 + TW_IN1 + 2 * TW_OUT + 2 * TW_GU + 2 * TW_D + 2 * TW_PG + 2 * TW_PP;
__device__ __forceinline__ TrDesc tr_desc(const Args& args, unsigned char* ws, int it) {
    const float* nmix = args.in[3]; const float* nffn = args.in[4]; const float* nple = args.in[5];
    TrDesc d; int r = it; int nbn;
    if (r < TW_IN0) { d = TrDesc{args.in[11], nullptr, N_IN0, DM, 1, nmix, (bf16*)(ws + WS_WIN0), 0, 0}; nbn = N_IN0 / 256; }
    else if ((r -= TW_IN0) < TW_IN1) { d = TrDesc{args.in[17], nullptr, N_IN1, DM, 1, nmix + DM, (bf16*)(ws + WS_WIN1), 0, 0}; nbn = N_IN1P / 256; }
    else if ((r -= TW_IN1) < TW_OUT) { d = TrDesc{args.in[12], nullptr, DM, DM, 0, nullptr, (bf16*)(ws + WS_WOUT0), 0, 0}; nbn = 4; }
    else if ((r -= TW_OUT) < TW_OUT) { d = TrDesc{args.in[18], nullptr, DM, DM, 0, nullptr, (bf16*)(ws + WS_WOUT1), 0, 0}; nbn = 4; }
    else if ((r -= TW_OUT) < TW_GU) { d = TrDesc{args.in[6], args.in[7], FF, DM, 2, nffn, (bf16*)(ws + WS_WGU0), 0, 0}; nbn = N_GU / 256; }
    else if ((r -= TW_GU) < TW_GU) { d = TrDesc{args.in[6] + (size_t)DM * FF, args.in[7] + (size_t)DM * FF, FF, DM, 2, nffn + DM, (bf16*)(ws + WS_WGU1), 0, 0}; nbn = N_GU / 256; }
    else if ((r -= TW_GU) < TW_D) { d = TrDesc{args.in[8], nullptr, DM, FF, 0, nullptr, (bf16*)(ws + WS_WD0), 0, 0}; nbn = 4; }
    else if ((r -= TW_D) < TW_D) { d = TrDesc{args.in[8] + (size_t)FF * DM, nullptr, DM, FF, 0, nullptr, (bf16*)(ws + WS_WD1), 0, 0}; nbn = 4; }
    else if ((r -= TW_D) < TW_PG) { d = TrDesc{args.in[10], nullptr, DM, DM, 0, nple, (bf16*)(ws + WS_WPG0), 0, 0}; nbn = 4; }
    else if ((r -= TW_PG) < TW_PG) { d = TrDesc{args.in[10] + (size_t)DM * DM, nullptr, DM, DM, 0, nple + DM, (bf16*)(ws + WS_WPG1), 0, 0}; nbn = 4; }
    else if ((r -= TW_PG) < TW_PP) { d = TrDesc{args.in[9], nullptr, DM, PLE, 0, nullptr, (bf16*)(ws + WS_WPP0), 0, 0}; nbn = 4; }
    else { r -= TW_PP; d = TrDesc{args.in[9] + (size_t)PLE * DM, nullptr, DM, PLE, 0, nullptr, (bf16*)(ws + WS_WPP1), 0, 0}; nbn = 4; }
    d.kb = r / nbn; d.nb = r % nbn; return d;
}
constexpr int TRBG_T_OFF = 49152;
struct TrBg {
    const Args& args; unsigned char* ws; LAS unsigned char* L;
    f32x4 v[8], g0, g1; int next, end, stride, loaded, inlds, pend;
    __device__ __forceinline__ void load_item(int it, int tid) {
        const TrDesc d = tr_desc(args, ws, it);
        const int c4 = tid & 63; const float* s = d.src; int col;
        if (d.map == 2) { s = (c4 < 32) ? d.src : d.src2; col = 128 * d.nb + 4 * (c4 & 31); } else col = 256 * d.nb + 4 * c4;
        const bool ok = col < d.Nsrc; const int colc = ok ? col : 0;
#pragma unroll
        for (int i = 0; i < 8; ++i) { const int k = 64 * d.kb + (tid >> 6) + 8 * i;
            const f32x4 x = *(const GAS f32x4*)(s + (size_t)k * d.Nsrc + colc);
            v[i] = ok ? x : (f32x4){0.f, 0.f, 0.f, 0.f}; }
    }
    __device__ __forceinline__ void even() {
        int tid = threadIdx.x; asm volatile("" : "+v"(tid));
        LAS float* T = (LAS float*)(L + TRBG_T_OFF);
        pend = 0;
        if (loaded >= 0) {
            const int c4 = tid & 63;
#pragma unroll
            for (int i = 0; i < 8; ++i) *(LAS f32x4*)(T + ((tid >> 6) + 8 * i) * 260 + 4 * c4) = v[i];
            const TrDesc d = tr_desc(args, ws, loaded);
            if (d.gain) { const float* gp = d.gain + 64 * d.kb + 8 * (tid & 7); g0 = *(const GAS f32x4*)gp; g1 = *(const GAS f32x4*)(gp + 4); pend += 2; }
            else { g0 = (f32x4){1.f, 1.f, 1.f, 1.f}; g1 = g0; }
        }
        inlds = loaded;
        if (next < end) { load_item(next, tid); loaded = next; next += stride; pend += 8; } else loaded = -1;
    }
    __device__ __forceinline__ void odd() {
        int tid = threadIdx.x; asm volatile("" : "+v"(tid));
        LAS float* T = (LAS float*)(L + TRBG_T_OFF);
        pend = 0;
        if (inlds >= 0) {
            const TrDesc d = tr_desc(args, ws, inlds);
            const int ch = tid & 7;
#pragma unroll
            for (int j = 0; j < 4; ++j) { const int n = (tid >> 3) + 64 * j;
                const int lc = (d.map == 1) ? (64 * ((n >> 5) & 3) + 32 * (n >> 7) + (n & 31)) : n;
                const LAS float* s = T + (8 * ch) * 260 + lc;
                u32x4 o; o.x = cvtpk(s[0 * 260] * g0.x, s[1 * 260] * g0.y); o.y = cvtpk(s[2 * 260] * g0.z, s[3 * 260] * g0.w); o.z = cvtpk(s[4 * 260] * g1.x, s[5 * 260] * g1.y); o.w = cvtpk(s[6 * 260] * g1.z, s[7 * 260] * g1.w);
                *(GAS u32x4*)(d.dst + (size_t)(256 * d.nb + n) * d.Kdst + 64 * d.kb + 8 * ch) = o; }
            pend = 4; inlds = -1;
        }
    }
    __device__ __forceinline__ bool busy() const { return loaded >= 0 || inlds >= 0 || next < end; }
};

__device__ __forceinline__ bool in_phase(int k, int lo, int hi) { asm volatile("" : "+s"(lo), "+s"(hi)); return lo <= k && k < hi; }
__global__ void __launch_bounds__(NWAVES * 64, 2) fwd_kernel(Args args) {
    extern __shared__ __attribute__((aligned(16))) unsigned char lds[];
    LAS unsigned char* L = (LAS unsigned char*)lds;
    volatile LAS unsigned* MISC = (volatile LAS unsigned*)(L + MISC_OFF);
    const int tid = threadIdx.x, lane = tid & 63, wave = __builtin_amdgcn_readfirstlane(tid >> 6);
    const int G = gridDim.x; const int bx = blockIdx.x; const int vcu = (G % 8 == 0) ? (bx % 8) * (G / 8) + bx / 8 : bx;
    unsigned char* ws = args.ws;
    gu32* ctl = (gu32*)(ws + WS_CTL);
    for (int u = tid; u < 128; u += NWAVES * 64) ((LAS unsigned*)(L + MISC_OFF))[u] = 0u;
    __syncthreads();
    XcdBarrier bar = xcd_barrier_post((unsigned*)(ctl + CW_BAR), MISC + 8);
    const int lo = args.ph_lo, hi = args.ph_hi;
#if MK_PROBE >= 31
    if (blockIdx.x == 0 && threadIdx.x == 0) g_probe_acc = 0.f;
#endif
#define IN(k) (((MK_MASK >> (k)) & 1) && in_phase((k), lo, hi))
#define PHASE_IDS int tid_o = threadIdx.x; asm volatile("" : "+v"(tid_o)); const int tid = tid_o, lane = tid_o & 63; (void)tid; (void)lane;
#define PHASE_WS unsigned char* ws_o = args.ws; asm volatile("" : "+s"(ws_o)); unsigned char* const ws = ws_o; (void)ws; int bx_o = blockIdx.x; asm volatile("" : "+s"(bx_o)); const int bx = bx_o; (void)bx;
#define REPN(k) (1 + ((MK_REP >> (k)) & 1))
#define INR(k) in_phase((k), lo, hi)
#define SEAM(k) do { if (INR(k) && INR((k) + 1)) xcd_barrier(bar); } while (0)

#define ssb ((ss_t*)(ws + WS_SS))
#define kmean ((float*)(ws + WS_KMEAN))
#define biasd ((float*)(ws + WS_BIASD))
#define cb1 ((float*)(ws + WS_CB1))
#define HB ((bf16*)(ws + WS_HB))
#define PP ((bf16*)(ws + WS_PP))
#define OB ((bf16*)(ws + WS_O))
#define QB ((bf16*)(ws + WS_Q))
#define K0 ((bf16*)(ws + WS_K0))
#define V0 ((bf16*)(ws + WS_V0))
#define KV1 ((bf16*)(ws + WS_KV1))
#define HID ((bf16*)(ws + WS_HID))
#define PB0 ((bf16*)(ws + WS_PB0))
#define PB1 ((bf16*)(ws + WS_PB1))
#define KC ((bf16*)(ws + WS_KC))
#define VC ((bf16*)(ws + WS_VC))
#define GATES ((float*)(ws + WS_GATES))
    const int gw = vcu * NWAVES + wave, NGW = G * NWAVES;

for (int rep_ = 0; rep_ < REPN(0); ++rep_) { if (rep_) xcd_barrier(bar);
    if (IN(0)) {
        PHASE_IDS
#if MK_PROBE >= 21
        const unsigned long long pp_t0 = __builtin_amdgcn_s_memrealtime();
#define PP_MARK(k) if (MK_PROBE == (k) && blockIdx.x == MK_PROBE_BLK && threadIdx.x == 0) ((float*)(ws + WS_CB1 + 4096))[0] = (float)(__builtin_amdgcn_s_memrealtime() - pp_t0);
#else
#define PP_MARK(k)
#endif
        LAS float* scr = (LAS float*)(L + wave * WAVE_LDS);
        const float* nmix = args.in[3]; const float* nffn = args.in[4]; const float* nple = args.in[5];
        {
            constexpr int W_IN0 = 16 * (N_IN0 / 256), W_IN1 = 16 * (N_IN1P / 256), W_OUT = 16 * 4, W_GU = 16 * (N_GU / 256), W_D = (FF / 64) * 4, W_PG = 16 * 4, W_PP = 4 * 4;
            constexpr int NWI = W_IN0 + W_IN1 + 2 * W_OUT + 2 * W_GU + 2 * W_D + 2 * W_PG + 2 * W_PP;
            LAS float* T = (LAS float*)L;
            auto desc = [&](int it) { TrDesc d; int r = it; int nbn;
                if (r < W_IN0) { d = TrDesc{args.in[11], nullptr, N_IN0, DM, 1, nmix, (bf16*)(ws + WS_WIN0), 0, 0}; nbn = N_IN0 / 256; }
                else if ((r -= W_IN0) < W_IN1) { d = TrDesc{args.in[17], nullptr, N_IN1, DM, 1, nmix + DM, (bf16*)(ws + WS_WIN1), 0, 0}; nbn = N_IN1P / 256; }
                else if ((r -= W_IN1) < W_OUT) { d = TrDesc{args.in[12], nullptr, DM, DM, 0, nullptr, (bf16*)(ws + WS_WOUT0), 0, 0}; nbn = 4; }
                else if ((r -= W_OUT) < W_OUT) { d = TrDesc{args.in[18], nullptr, DM, DM, 0, nullptr, (bf16*)(ws + WS_WOUT1), 0, 0}; nbn = 4; }
                else if ((r -= W_OUT) < W_GU) { d = TrDesc{args.in[6], args.in[7], FF, DM, 2, nffn, (bf16*)(ws + WS_WGU0), 0, 0}; nbn = N_GU / 256; }
                else if ((r -= W_GU) < W_GU) { d = TrDesc{args.in[6] + (size_t)DM * FF, args.in[7] + (size_t)DM * FF, FF, DM, 2, nffn + DM, (bf16*)(ws + WS_WGU1), 0, 0}; nbn = N_GU / 256; }
                else if ((r -= W_GU) < W_D) { d = TrDesc{args.in[8], nullptr, DM, FF, 0, nullptr, (bf16*)(ws + WS_WD0), 0, 0}; nbn = 4; }
                else if ((r -= W_D) < W_D) { d = TrDesc{args.in[8] + (size_t)FF * DM, nullptr, DM, FF, 0, nullptr, (bf16*)(ws + WS_WD1), 0, 0}; nbn = 4; }
                else if ((r -= W_D) < W_PG) { d = TrDesc{args.in[10], nullptr, DM, DM, 0, nple, (bf16*)(ws + WS_WPG0), 0, 0}; nbn = 4; }
                else if ((r -= W_PG) < W_PG) { d = TrDesc{args.in[10] + (size_t)DM * DM, nullptr, DM, DM, 0, nple + DM, (bf16*)(ws + WS_WPG1), 0, 0}; nbn = 4; }
                else if ((r -= W_PG) < W_PP) { d = TrDesc{args.in[9], nullptr, DM, PLE, 0, nullptr, (bf16*)(ws + WS_WPP0), 0, 0}; nbn = 4; }
                else { r -= W_PP; d = TrDesc{args.in[9] + (size_t)PLE * DM, nullptr, DM, PLE, 0, nullptr, (bf16*)(ws + WS_WPP1), 0, 0}; nbn = 4; }
                d.kb = r / nbn; d.nb = r % nbn; return d; };
            f32x4 v[8];
            const int NWI_P0 = (MK_BG && G == 256) ? W_IN0 : NWI;
            int it = vcu;
            if (it < NWI_P0) { const TrDesc d = desc(it); tr_wg_load(v, d.src, d.src2, d.Nsrc, d.map, d.gain, d.kb, d.nb, tid); }
#pragma unroll 1
            for (; it < NWI_P0; it += G) {
                const TrDesc d = desc(it);
                f32x4 w[8];
#pragma unroll
                for (int i = 0; i < 8; ++i) w[i] = v[i];
                if (it + G < NWI_P0) { const TrDesc dn = desc(it + G); tr_wg_load(v, dn.src, dn.src2, dn.Nsrc, dn.map, dn.gain, dn.kb, dn.nb, tid); }
                tr_wg_store(w, T, d.map, d.dst, d.Kdst, d.kb, d.nb, tid);
            }
            __syncthreads();
        }
        PP_MARK(21)
        constexpr int I_C1 = 32 * 4, I_C2 = 2 * 2, NIT = 2 * I_C1 + 2 * I_C2;
        for (int it = gw; it < NIT; it += NGW) {
            int r = it;
            if (r < I_C1) { tr_matrix(r, args.in[24], nullptr, 2048, 128, 128, 0, nullptr, (bf16*)(ws + WS_CW1K), scr, lane); continue; } r -= I_C1;
            if (r < I_C1) { tr_matrix(r, args.in[29], nullptr, 2048, 128, 128, 0, nullptr, (bf16*)(ws + WS_CW1V), scr, lane); continue; } r -= I_C1;
            if (r < I_C2) { tr_matrix(r, args.in[26], nullptr, 128, 64, 64, 0, nullptr, (bf16*)(ws + WS_CW2K), scr, lane); continue; } r -= I_C2;
            tr_matrix(r, args.in[31], nullptr, 128, 64, 64, 0, nullptr, (bf16*)(ws + WS_CW2V), scr, lane);
        }
        PP_MARK(22)
        const float* x = args.in[0];
        for (int m = 2 * gw; m < M; m += 2 * NGW) {
            const GAS f32x4* xr = (const GAS f32x4*)(x + (size_t)m * DM) + lane; f32x4 v[8]; float s0 = 0.f, s1 = 0.f;
#pragma unroll
            for (int j = 0; j < 8; ++j) v[j] = xr[64 * j];
#pragma unroll
            for (int j = 0; j < 4; ++j) { s0 += (v[j].x * v[j].x + v[j].y * v[j].y) + (v[j].z * v[j].z + v[j].w * v[j].w); s1 += (v[4 + j].x * v[4 + j].x + v[4 + j].y * v[4 + j].y) + (v[4 + j].z * v[4 + j].z + v[4 + j].w * v[4 + j].w); }
            s0 = wave_sum(s0); s1 = wave_sum(s1);
            GAS unsigned long long* o8 = (GAS unsigned long long*)(HB + (size_t)m * DM) + lane;
#pragma unroll
            for (int j = 0; j < 8; ++j) o8[64 * j] = (unsigned long long)cvtpk(v[j].x, v[j].y) | ((unsigned long long)cvtpk(v[j].z, v[j].w) << 32);
            if (lane == 0) { ssb[m] = (ss_t)(s0 * SS_SCALE); ssb[m + 1] = (ss_t)(s1 * SS_SCALE); }
        }
        PP_MARK(23)
        const float* relb = args.in[2];
        for (int i = bx * 512 + tid; i < NH * TABN; i += G * 512) { const int h = i / TABN, d = i % TABN; biasd[i] = relb[rel_bucket(d) * NH + h] * LOG2E; }
        for (int o = vcu; o < 256; o += G) { const int kv = o >> 7, col = o & 127; const float* pos = args.in[kv ? 28 : 23]; const float* w1 = args.in[kv ? 29 : 24]; const float* b1 = args.in[kv ? 30 : 25];
            float s = 0.f;
#pragma unroll
            for (int i = 0; i < 4; ++i) { const int k = tid + 512 * i; s += pos[k] * w1[(size_t)k * 128 + col]; }
            s = wave_sum(s);
            LAS float* red = (LAS float*)(L + 8 * WAVE_LDS);
            __syncthreads(); if (lane == 0) red[wave] = s; __syncthreads();
            if (tid == 0) cb1[o] = ((red[0] + red[1]) + (red[2] + red[3])) + ((red[4] + red[5]) + (red[6] + red[7])) + b1[col]; }
        if (bx == 0) { const int gi = tid >> 6; const int src_idx = gi < 4 ? 13 + gi : gi == 4 ? 19 : gi == 5 ? 21 : gi == 6 ? 22 : 20; ((float*)(ws + WS_GN))[tid] = args.in[src_idx][tid & 63] * ((gi == 0 || gi == 2 || gi == 4) ? C2 : 1.0f); }
        for (int i = bx * 512 + tid; i < 2 * 32 * 32; i += G * 512) { const int kv = i >> 10, bg = (i >> 5) & 31, w = i & 31; ((unsigned*)((kv ? VC : KC) + ((size_t)bg * 128 + 127) * HD))[w] = 0u; }
    }
}
    SEAM(0);
    using namespace pg8;
    if (IN(2)) { PHASE_WS  Gemm g{HB, (const bf16*)(ws + WS_WIN0), M, N_IN0, DM}; StaticOrder S; S.init(M, N_IN0, G, bx, MK_WGM12);
        EpiInProj<0> E{ssb, QB, (const float*)(ws + WS_GN), kmean, nullptr};
        gemm_phase<EpiInProj<0>, StaticOrder, true, true>(L, g, S, E); }
    SEAM(2);
for (int rep_ = 0; rep_ < REPN(3); ++rep_) { if (rep_) xcd_barrier(bar);
    if (IN(3)) { PHASE_WS
        PHASE_IDS
        LAS float* tab = (LAS float*)(L + TAB0_OFF); LAS float* km = (LAS float*)(L + KM_OFF);
        for (int v = vcu; v < 256; v += G) {
            const int bh = v >> 2, b = bh >> 3, h = bh & 7, sub = v & 3;
            __syncthreads();
            if (tid < 9) ((LAS unsigned*)(L + UW_OFF))[tid] = 0u;
            build_tab<2112>(tab, biasd + h * TABN, 2047, tid);
            km[tid] = kmean[(size_t)(b * 8 + h) * 512 + tid] * (1.0f / 256.0f);
            __syncthreads();
#ifndef NO_MOBA
            if (!(rep_ && MK_P3SKIP == 2))
            {
#if MK_BG
                TrBg bg{args, ws, L}; bg.next = TW_IN0 + ((G == 256) ? vcu : TR_NWI); bg.end = TR_NWI; bg.stride = G; bg.loaded = -1; bg.inlds = -1; bg.pend = 0;
                if (rep_) bg.next = TR_NWI;
#else
                NoBg bg;
#endif
#pragma unroll 1
                for (int uu = 0; uu < 2; ++uu) moba_unit<0>(L, wave, b, h, uu ? 7 - sub : sub, QB, K0, V0, OB, tab, km, bg, (float*)(ws + WS_CB1 + 4096));
#if MK_BG
#pragma unroll 1
                while (bg.busy()) { bg.even(); asm volatile("s_waitcnt vmcnt(0) lgkmcnt(0)" ::: "memory"); __syncthreads(); bg.odd(); asm volatile("s_waitcnt vmcnt(0) lgkmcnt(0)" ::: "memory"); __syncthreads(); }
#endif
            }
#endif
            build_dil_tabs(tab, biasd + (8 + h) * TABN, tid);
            __syncthreads();
#ifndef NO_DIL
            if (!(rep_ && MK_P3SKIP == 1)) {
                bf16* SO = (bf16*)(ws + WS_PP); float* SM = (float*)(ws + WS_PP + 16 * MiB); float* SL = SM + (size_t)BATCH * 8 * SEQ;
#pragma unroll 1
                for (int uu = 0; uu < 2; ++uu) dil_wave<0>(L, wave, b, 8 + h, sub, 8 * uu + wave, QB, K0, V0, OB, tab, SO, SM, SL);
                asm volatile("s_waitcnt vmcnt(0)" ::: "memory"); __syncthreads();
#pragma unroll 1
                for (int uu = 0; uu < 2; ++uu) dil_wave<1>(L, wave, b, 8 + h, sub, 8 * uu + wave, QB, K0, V0, OB, tab, SO, SM, SL);
            }
#endif
        }
    }
}
    SEAM(3);
#pragma unroll 1
    for (int layer = 0; layer < 2; ++layer) {
        const int pb = layer ? 12 : 4;
#define Wout ((const bf16*)(ws + (layer ? WS_WOUT1 : WS_WOUT0)))
#define Wgu ((const bf16*)(ws + (layer ? WS_WGU1 : WS_WGU0)))
#define Wd ((const bf16*)(ws + (layer ? WS_WD1 : WS_WD0)))
#define Wpg ((const bf16*)(ws + (layer ? WS_WPG1 : WS_WPG0)))
#define HCUR (layer ? OB : HB)
#define OCUR (layer ? HB : OB)
#define ss_ffn (ssb + (size_t)(3 * layer + 1) * M)
#define ss_ple (ssb + (size_t)(3 * layer + 2) * M)
#define ss_next (layer ? (ss_t*)nullptr : ssb + (size_t)3 * M)
        if (layer == 1) {
for (int rep_ = 0; rep_ < REPN(9); ++rep_) { if (rep_) xcd_barrier(bar);
            if (IN(9)) { PHASE_WS  Gemm g{OB, (const bf16*)(ws + WS_WIN1), M, N_IN1P, DM}; StaticOrder S; S.init(M, N_IN1P, G, bx, MK_WGM12);
                EpiInProj<1> E{ssb + (size_t)3 * M, QB, (const float*)(ws + WS_GN), nullptr, GATES};
                gemm_phase<EpiInProj<1>, StaticOrder, true, true>(L, g, S, E); }
}
            SEAM(9);
for (int rep_ = 0; rep_ < REPN(10); ++rep_) { if (rep_) xcd_barrier(bar);
            if (IN(10)) { PHASE_WS
                PHASE_IDS
                for (int task = vcu; task < 256; task += G) {
                    const int kv = task >> 7, bg = (task >> 2) & 31, rt = task & 3, i0 = 32 * rt;
                    const bf16* T = KV1 + (size_t)kv * ((size_t)BATCH * 4 * SEQ * HD) + (size_t)bg * SEQ * HD;
                    const bf16* W1 = (const bf16*)(ws + (kv ? WS_CW1V : WS_CW1K)); const bf16* W2 = (const bf16*)(ws + (kv ? WS_CW2V : WS_CW2K));
                    const int r32 = lane & 31, hi5 = lane >> 5;
                    f32x16 acc4[4];
#pragma unroll
                    for (int nb = 0; nb < 4; ++nb)
#pragma unroll
                        for (int r = 0; r < 16; ++r) acc4[nb][r] = 0.f;
                    int arow = i0 + r32; arow = arow > 126 ? 126 : arow;
                    const bf16* ap = T + (size_t)arow * 16 * HD + 256 * wave + 8 * hi5;
                    const bf16* bp = W1 + (size_t)r32 * 2048 + 256 * wave + 8 * hi5;
                    bf16x8 af[16];
#pragma unroll
                    for (int s = 0; s < 16; ++s) af[s] = *(const bf16x8*)(ap + 16 * s);
#pragma unroll
                    for (int s = 0; s < 16; ++s) {
#pragma unroll
                        for (int nb = 0; nb < 4; ++nb) { const bf16x8 bb = *(const bf16x8*)(bp + (size_t)nb * 32 * 2048 + 16 * s);
                            acc4[nb] = __builtin_amdgcn_mfma_f32_32x32x16_bf16(af[s], bb, acc4[nb], 0, 0, 0); } }
                    __syncthreads();
                    LAS float* part = (LAS float*)L;
#pragma unroll
                    for (int nb = 0; nb < 4; ++nb)
#pragma unroll
                        for (int r = 0; r < 16; ++r) part[(wave * 32 + crow(r, hi5)) * 129 + 32 * nb + r32] = acc4[nb][r];
                    __syncthreads();
                    LAS bf16* H1 = (LAS bf16*)(L + 135168);
                    const float cbv = cb1[kv * 128 + (tid & 127)];
                    for (int e = tid; e < 32 * 128; e += 512) { const int row = e >> 7, col = e & 127;
                        float v = cbv;
#pragma unroll
                        for (int w8 = 0; w8 < 8; ++w8) v += part[(w8 * 32 + row) * 129 + col];
                        const float u2 = 0.7978845608028654f * (v + 0.044715f * v * v * v);
                        const float th = 1.0f - 2.0f * fast_rcp(1.0f + fast_exp2(2.0f * u2 * LOG2E));
                        H1[row * 136 + col] = (bf16)f2bf(0.5f * v * (1.0f + th)); }
                    __syncthreads();
                    LAS float* OUT = (LAS float*)(L + 144384);
                    if (wave < 2) {
                        f32x16 a2;
#pragma unroll
                        for (int r = 0; r < 16; ++r) a2[r] = 0.f;
#pragma unroll
                        for (int s = 0; s < 8; ++s) { const bf16x8 a = *(LAS const bf16x8*)(H1 + r32 * 136 + 16 * s + 8 * hi5);
                            const bf16x8 bb = *(const bf16x8*)(W2 + (size_t)(32 * wave + r32) * 128 + 16 * s + 8 * hi5);
                            a2 = __builtin_amdgcn_mfma_f32_32x32x16_bf16(a, bb, a2, 0, 0, 0); }
                        const float* b2 = args.in[kv ? 32 : 27];
#pragma unroll
                        for (int r = 0; r < 16; ++r) OUT[crow(r, hi5) * 65 + 32 * wave + r32] = a2[r] + b2[32 * wave + r32];
                    }
                    __syncthreads();
                    if (tid < 256) { const int row = tid >> 3, c8 = (tid & 7) * 8; float v[8]; float sq = 0.f;
#pragma unroll
                        for (int i = 0; i < 8; ++i) { v[i] = OUT[row * 65 + c8 + i]; sq += v[i] * v[i]; }
                        sq += __shfl_xor(sq, 1); sq += __shfl_xor(sq, 2); sq += __shfl_xor(sq, 4);
                        if (kv == 0) { const float r2 = rsqrtf(sq * (1.0f / HD) + RMS_EPS); const float* kn = (const float*)(ws + WS_GN) + 7 * 64;
#pragma unroll
                            for (int i = 0; i < 8; ++i) v[i] = v[i] * r2 * kn[c8 + i]; }
                        if (i0 + row < 127) { u32x4 w; w.x = pk2(v[0], v[1]); w.y = pk2(v[2], v[3]); w.z = pk2(v[4], v[5]); w.w = pk2(v[6], v[7]);
                            *(u32x4*)((kv ? VC : KC) + ((size_t)bg * 128 + i0 + row) * HD + c8) = w; } }
                    __syncthreads();
                }
            }
}
            SEAM(10);
for (int rep_ = 0; rep_ < REPN(11); ++rep_) { if (rep_) xcd_barrier(bar);
            if (IN(11)) { PHASE_WS
                PHASE_IDS
#if MK_PROBE >= 51
                const unsigned long long p11_t0 = __builtin_amdgcn_s_memrealtime();
#endif
                LAS float* tabs = (LAS float*)(L + TAB1_OFF);
                for (int v = vcu; v < 256; v += G) {
                    const int bg = v >> 3, b = bg >> 2, g = bg & 3, sub = v & 7;
                    __syncthreads();
                    if (tid < 9) ((LAS unsigned*)(L + UW_OFF))[tid] = 0u;
                    if (tid < 64) ((LAS unsigned*)(L + SELW_OFF))[tid] = 0u;
                    { float vf[4][(TABF + 511) / 512], vw[4][(TABWN + 511) / 512];
#pragma unroll
                        for (int hh = 0; hh < 4; ++hh) { build_tab_ld<TABF>(vf[hh], biasd + (4 * g + hh) * TABN, 2047, tid); build_tab_ld<TABWN>(vw[hh], biasd + (4 * g + hh) * TABN, 511, tid); }
#pragma unroll
                        for (int hh = 0; hh < 4; ++hh) { build_tab_st<TABF>(tabs + hh * TABF, vf[hh], 2047, tid); build_tab_st<TABWN>(tabs + 4 * TABF + hh * TABWN, vw[hh], 511, tid); } }
                    __syncthreads();
#if MK_PROBE == 56
                    if (threadIdx.x == 0) ((float*)(ws + WS_CB1 + 8192))[blockIdx.x] = (float)(__builtin_amdgcn_s_memrealtime() - p11_t0);
#endif
#pragma unroll 1
                    for (int k = 0; k < 4; ++k) { const int pr = 2 * sub + (k >> 1); const int chunk = (k & 1) ? 31 - pr : pr;
#if MK_GHOST && MK_GHOST < 30
                        if (rep_) nsa_unit<MK_GHOST>(wave, L, b, g, chunk, QB, KV1, KC, VC, GATES, HB, tabs); else
#endif
                        nsa_unit<0>(wave, L, b, g, chunk, QB, KV1, KC, VC, GATES, HB, tabs, (float*)(ws + WS_CB1 + 4096)); }
                }
#if MK_PROBE >= 51 && MK_PROBE != 56
                if (threadIdx.x == 0) ((float*)(ws + WS_CB1 + 8192))[blockIdx.x] = (float)(__builtin_amdgcn_s_memrealtime() - p11_t0);
#endif
            }
}
            SEAM(11);
        }
        if (IN(pb)) { PHASE_WS
            {
                PHASE_IDS
                const float* p1 = args.in[1] + (size_t)layer * M * PLE;
                for (int m0 = gw; m0 < M; m0 += 8 * NGW) {
                    f32x4 v[8];
#pragma unroll
                    for (int j = 0; j < 8; ++j) { const int m = m0 + j * NGW; v[j] = ((const GAS f32x4*)(p1 + (size_t)(m < M ? m : M - 1) * PLE))[lane]; }
#pragma unroll
                    for (int j = 0; j < 8; ++j) { const int m = m0 + j * NGW;
                        if (m < M) ((GAS unsigned long long*)(PB1 + (size_t)m * PLE))[lane] = (unsigned long long)pk2(v[j].x, v[j].y) | ((unsigned long long)pk2(v[j].z, v[j].w) << 32); } }
            }
            Gemm g{OCUR, Wout, M, DM, DM}; StaticOrder S; S.init(M, DM, G, bx, MK_WGM4);
            EpiResid<0> E{HCUR, HCUR, nullptr, ss_ffn, nullptr, nullptr};
            gemm_phase<EpiResid<0>, StaticOrder, true, true>(L, g, S, E); }
        SEAM(pb);
for (int rep_ = 0; rep_ < REPN(pb + 1); ++rep_) { if (rep_) xcd_barrier(bar);
        if (IN(pb + 1)) { PHASE_WS  Gemm g{HCUR, Wgu, M, N_GU, DM}; StaticOrder S; S.init(M, N_GU, G, bx, MK_WGM22); EpiSwiglu E{HID, ss_ffn, 0};
#if MK_GHOST >= 30
            if (rep_) { E.ghost = 1; S.flat = (MK_GHOST == 31); }
#endif
            gemm_phase<EpiSwiglu, StaticOrder, true, true>(L, g, S, E);
            if (G == 256 ? bx >= 128 : true) {
                int kk = PLE; asm volatile("" : "+s"(kk)); Gemm g2{PB1, (const bf16*)(ws + (layer ? WS_WPP1 : WS_WPP0)), M, DM, kk}; StaticOrder S2;
                if (G == 256) S2.init(M, DM, 128, bx - 128); else S2.init(M, DM, G, bx);
                EpiStoreBf16 E2{PP, DM};
                gemm_phase<EpiStoreBf16, StaticOrder, true, true>(L, g2, S2, E2); } }
}
        SEAM(pb + 1);
        if (IN(pb + 2)) { PHASE_WS  Gemm g{HID, Wd, M, DM, FF}; StaticOrder S; S.init(M, DM, G, bx, MK_WGM4);
            EpiResid<0> E{HCUR, HCUR, nullptr, ss_ple, nullptr, nullptr};
            gemm_phase<EpiResid<0>, StaticOrder, true, true>(L, g, S, E); }
        SEAM(pb + 2);
        if (IN(pb + 3)) { PHASE_WS  Gemm g{HCUR, Wpg, M, DM, DM}; StaticOrder S; S.init(M, DM, G, bx, MK_WGM4);
            EpiResid<1> E{HCUR, layer ? (bf16*)nullptr : OB, layer ? args.out : (float*)nullptr, ss_next, ss_ple, PP};
            gemm_phase<EpiResid<1>, StaticOrder, true, true>(L, g, S, E); }
        if (layer == 0) SEAM(7);
    }
#if MK_PROBE
#if MK_PROBE < 31
    float g_probe_acc = 0.f;
#endif
    xcd_barrier(bar);
    if (blockIdx.x == 0 && threadIdx.x == 0) { unsigned char* ws = args.ws; float pv_ = ((MK_PROBE >= 31) ? g_probe_acc : ((float*)(ws + WS_CB1 + 4096))[0]) * (1.0f / MK_PROBE_DIV);
#if MK_PROBE >= 51
        { const float* a = (const float*)(ws + WS_CB1 + 8192); float mx = 0.f, mn = 1e30f, sm = 0.f; int am = 0;
          for (int i = 0; i < 256; ++i) { const float t = a[i]; if (t > mx) { mx = t; am = i; } mn = t < mn ? t : mn; sm += t; }
          pv_ = (MK_PROBE == 51 ? mx : MK_PROBE == 52 ? mn : MK_PROBE == 53 ? (float)am * MK_PROBE_DIV : (MK_PROBE == 55 || MK_PROBE == 56) ? a[MK_PROBE_BLK] : sm * (1.0f / 256.0f)) * (1.0f / MK_PROBE_DIV) - (float)MK_PROBE_OFF; if (pv_ < 0.f) pv_ = 0.f; }
#endif
 float q_ = 1.f; while (pv_ >= 20.f) { pv_ *= 0.5f; q_ *= 2.f; } args.out[0] += floorf(pv_ * 0.5f) * 2.f * q_; }
#endif
#if MK_DBG
    if (lo == 99) {
        const bf16* src = (const bf16*)(ws + (size_t)MK_DBG_OFF);
        for (size_t i = (size_t)bx * 512 + threadIdx.x; i < (size_t)M * DM; i += (size_t)G * 512) args.out[i] = i < (size_t)MK_DBG_CNT ? bf2f(src[i]) : 0.f;
    }
#endif
#undef IN
#undef SEAM
}

extern "C" void kernel_launch(void* const* d_in, const int* in_sizes, int n_in, void* d_out, int out_size, void* d_ws, size_t ws_size, hipStream_t stream) {
    static int grid = 0;
    if (grid == 0) {
        if (n_in != 33 || out_size != M * DM || ws_size < WS_END) { fprintf(stderr, "kernel_launch: unexpected problem (n_in %d out %d ws %zu)\n", n_in, out_size, ws_size); grid = -1; return; }
        int dev = 0, cus = 0, per_cu = 0;
        if (hipGetDevice(&dev) != hipSuccess || hipDeviceGetAttribute(&cus, hipDeviceAttributeMultiprocessorCount, dev) != hipSuccess) { grid = -1; return; }
        if (hipFuncSetAttribute((const void*)fwd_kernel, hipFuncAttributeMaxDynamicSharedMemorySize, LDS_BYTES) != hipSuccess) { fprintf(stderr, "kernel_launch: hipFuncSetAttribute failed\n"); grid = -1; return; }
        if (hipOccupancyMaxActiveBlocksPerMultiprocessor(&per_cu, (const void*)fwd_kernel, NWAVES * 64, LDS_BYTES) != hipSuccess || per_cu < 1) { fprintf(stderr, "kernel_launch: occupancy query says %d\n", per_cu); }
        (void)hipGetLastError();
        grid = cus < 256 ? cus : 256;
    }
    if (grid < 0) return;
    if (hipMemsetAsync((char*)d_ws + WS_CTL, 0, CTL_ZERO_BYTES, stream) != hipSuccess) return;
    Args a{};
    for (int i = 0; i < 33; ++i) a.in[i] = (const float*)d_in[i];
    a.out = (float*)d_out; a.ws = (unsigned char*)d_ws;
#if MK_SPLIT
    for (int ph = 0; ph < MK_PH_END; ++ph) { a.ph_lo = ph; a.ph_hi = ph + 1; hipLaunchKernelGGL(fwd_kernel, dim3(grid), dim3(NWAVES * 64), LDS_BYTES, stream, a); }
#if MK_DBG
    a.ph_lo = 99; a.ph_hi = 100; hipLaunchKernelGGL(fwd_kernel, dim3(grid), dim3(NWAVES * 64), LDS_BYTES, stream, a);
#endif
#else
    a.ph_lo = 0; a.ph_hi = MK_PH_END;
    hipLaunchKernelGGL(fwd_kernel, dim3(grid), dim3(NWAVES * 64), LDS_BYTES, stream, a);
#endif
}
```

```cpp
#include <hip/hip_runtime.h>
#include <cstdio>
#include <cstdint>

#ifndef MK_SPLIT
#define MK_SPLIT 0
#endif
#ifndef MK_DBG
#define MK_DBG 0
#define MK_DBG_OFF (0ull << 10)
#define MK_DBG_CNT (0)
#endif
#ifndef MK_PROBE
#define MK_PROBE 0
#define MK_PROBE_CHUNK 31
#define MK_PROBE_BLK 0
#define MK_PROBE_DIV 100.0f
#define MK_PROBE_OFF 0
#endif
#ifndef MK_P3SKIP
#define MK_P3SKIP 0
#endif
#ifndef MK_STAGGER
#define MK_STAGGER 0
#endif
#ifndef MK_WGM4
#define MK_WGM4 2
#define MK_WGM22 2
#define MK_WGM12 2
#endif
#ifndef MK_SERP
#define MK_SERP 0
#endif
#ifndef MK_MIX
#define MK_MIX 0
#endif
#ifndef MK_P0DMA
#define MK_P0DMA 1
#endif
#ifndef MK_BG
#define MK_BG 1
#endif
#ifndef MK_GHOST
#define MK_GHOST 0
#endif
#ifndef MK_REP
#define MK_REP 0
#endif
#ifndef MK_MASK
#define MK_MASK 0xFFFF
#endif
#ifndef MK_PH_END
#define MK_PH_END 16
#endif

#if MK_PROBE >= 31
__device__ float g_probe_acc = 0.f;
#endif
namespace pg8 {
#define PG8_LAS __attribute__((address_space(3)))
typedef unsigned short bf16_t;
typedef short bf16x8 __attribute__((ext_vector_type(8)));
typedef float f32x4 __attribute__((ext_vector_type(4)));
typedef unsigned u32x4 __attribute__((ext_vector_type(4)));
constexpr int BM = 256, BK = 64, HALF = 128, HTB = HALF * BK * 2  , STAGE_BYTES = 8 * HTB, NXCD = 8, WGM = 2;

__host__ __device__ __forceinline__ int lds_byte(int r, int c) { const int st = (r >> 4) * 2 + (c >> 5), rr = r & 15, cc = c & 31, ob = rr * 64 + cc * 2; return st * 1024 + (ob ^ (((ob >> 9) & 1) << 5)); }
__host__ __device__ __forceinline__ void stage_rc(int b, int& R, int& C) { const int st = b / 1024, sb = b % 1024, swz = sb ^ (((sb >> 9) & 1) << 5); R = (st >> 1) * 16 + swz / 64; C = (st & 1) * 32 + (swz % 64) / 2; }
__host__ __device__ __forceinline__ int perm32(int rho) { const int n = rho >> 4, i = rho & 15; return 8 * (i >> 2) + 4 * n + (i & 3); }

struct Unit { int pm, pn; };
struct Gemm { const bf16_t* A; const bf16_t* Bt; int M, N, K; };

struct StaticOrder {
    int nM, nN, nwg, G, c, wgm, flat = 0;
    __host__ __device__ void init(int M, int N, int G_, int c_, int wgm_ = WGM) { nM = M / BM; nN = N / BM; nwg = nM * nN; G = G_; c = c_; wgm = wgm_; }
    __host__ __device__ bool next(int i, Unit& u) const {
        const long L = (long)i * G + c; if (L >= nwg) return false;
        int wgid = (int)L; { const int q = nwg / NXCD, r = nwg % NXCD, xcd = wgid % NXCD, off = wgid / NXCD; wgid = (xcd < r ? xcd * (q + 1) : r * (q + 1) + (xcd - r) * q) + off; }
        const int nig = wgm * nN, gid = wgid / nig, fm = gid * wgm, gsz = (nM - fm) < wgm ? (nM - fm) : wgm;
        u.pm = fm + ((wgid % nig) % gsz); u.pn = (wgid % nig) / gsz; if (MK_SERP && (gid & 1)) u.pn = nN - 1 - u.pn;
#if MK_GHOST >= 30
        if (flat) { u.pm = 0; u.pn = 0; }
#endif
        return true;
    }
    __device__ __forceinline__ void a_ready(const Unit&) const {}
    __device__ __forceinline__ void done(const Unit&) const {}
};

__device__ __forceinline__ unsigned cvt_pk_bf16(float lo, float hi) { unsigned r; asm volatile("v_cvt_pk_bf16_f32 %0, %1, %2" : "=v"(r) : "v"(lo), "v"(hi)); return r; }
template <class Epi, class Sched, bool ALIGN_EPI = false, bool SP2 = false>
__device__ __forceinline__ void gemm_phase(PG8_LAS unsigned char* lds, const Gemm g, const Sched& S, const Epi& E) {
    int tid_ = threadIdx.x; asm volatile("" : "+v"(tid_));
    const int tid = tid_, wid = __builtin_amdgcn_readfirstlane(tid >> 6), lane = tid & 63, wr = wid >> 2, wc = wid & 3, fr = lane & 15, fq = lane >> 4;
    const int K = g.K, nt = K / BK;
    unsigned voffA[2], voffB[2];
#pragma unroll
    for (int i = 0; i < 2; ++i) { int R, C; stage_rc(tid * 16 + i * 8192, R, C); const int Rb = Epi::PERM ? ((R & ~31) + perm32(R & 31)) : R;
        voffA[i] = (unsigned)(R * K + C) * 2u; voffB[i] = (unsigned)(Rb * K + C) * 2u; }
    const size_t kstep = (size_t)(BK * 2);
    const size_t hstep = (size_t)HALF * K * 2;
    const size_t tstep = 2 * hstep;
    const unsigned ldsw = (unsigned)wid * 1024u;
    const int aoff = lds_byte(wr * 64 + fr, fq * 8), boff = lds_byte(wc * 32 + fr, fq * 8);
#define PG8_SA(b, h) (((b) * 2 + (h)) * HTB)
#define PG8_SB(b, h) ((4 + (b) * 2 + (h)) * HTB)
#define PG8_STAGE(bufoff, gbase, voff) do { _Pragma("unroll") for (int _i = 0; _i < 2; ++_i) \
        __builtin_amdgcn_global_load_lds((const unsigned*)((const char*)(gbase) + (voff)[_i]), (PG8_LAS unsigned*)(lds + (bufoff) + ldsw + _i * 8192), 16, 0, 0); } while (0)
#define PG8_LDA(dst, b, h) do { _Pragma("unroll") for (int m = 0; m < 4; ++m) _Pragma("unroll") for (int k = 0; k < 2; ++k) dst[m][k] = *(const PG8_LAS bf16x8*)(lds + PG8_SA(b, h) + aoff + m * 2048 + k * 1024); } while (0)
#define PG8_LDB(dst, b, h) do { _Pragma("unroll") for (int n = 0; n < 2; ++n) _Pragma("unroll") for (int k = 0; k < 2; ++k) dst[n][k] = *(const PG8_LAS bf16x8*)(lds + PG8_SB(b, h) + boff + n * 2048 + k * 1024); } while (0)
#define PG8_MMA(ai, bj, At, Bt) do { __builtin_amdgcn_s_setprio(1); _Pragma("unroll") for (int m = 0; m < 4; ++m) _Pragma("unroll") for (int n = 0; n < 2; ++n) _Pragma("unroll") for (int k = 0; k < 2; ++k) \
        acc[ai][bj][m][n] = __builtin_amdgcn_mfma_f32_16x16x32_bf16(Bt[n][k], At[m][k], acc[ai][bj][m][n], 0, 0, 0); __builtin_amdgcn_s_setprio(0); } while (0)
#define PG8_WAIT_V(n) asm volatile("s_waitcnt vmcnt(" #n ")" ::: "memory")
#define PG8_WAIT_L(n) asm volatile("s_waitcnt lgkmcnt(" #n ")" ::: "memory")
#define PG8_BAR __builtin_amdgcn_s_barrier()
#define PG8_SCHED __builtin_amdgcn_sched_barrier(0)
    Unit cur, nxt; int ui = 0;
    if (!S.next(0, cur)) return;
    f32x4 acc[2][2][4][2];
#pragma unroll
    for (int a = 0; a < 2; ++a)
#pragma unroll
        for (int b = 0; b < 2; ++b)
#pragma unroll
            for (int m = 0; m < 4; ++m)
#pragma unroll
                for (int n = 0; n < 2; ++n) acc[a][b][m][n] = (f32x4){0.f, 0.f, 0.f, 0.f};
    bf16x8 At[4][2], B0[2][2], B1[2][2];
    const char* cA = (const char*)g.A + (size_t)cur.pm * tstep; const char* cB = (const char*)g.Bt + (size_t)cur.pn * tstep;
    S.a_ready(cur);
    if constexpr (SP2) {
        PG8_STAGE(PG8_SB(0, 0), cB, voffB); PG8_STAGE(PG8_SB(0, 1), cB + hstep, voffB); PG8_STAGE(PG8_SA(0, 0), cA, voffA); PG8_STAGE(PG8_SA(0, 1), cA + hstep, voffA);
        if (wr == 1) PG8_BAR;
        PG8_WAIT_V(2); PG8_BAR;
        PG8_STAGE(PG8_SB(1, 0), cB + kstep, voffB); PG8_STAGE(PG8_SA(1, 0), cA + kstep, voffA); PG8_STAGE(PG8_SB(1, 1), cB + hstep + kstep, voffB);
        PG8_WAIT_V(6); PG8_BAR;
    } else {
        PG8_STAGE(PG8_SB(0, 0), cB, voffB); PG8_STAGE(PG8_SA(0, 0), cA, voffA); PG8_STAGE(PG8_SB(0, 1), cB + hstep, voffB); PG8_STAGE(PG8_SA(0, 1), cA + hstep, voffA);
        if (wr == 1) PG8_BAR;
        PG8_WAIT_V(4); PG8_BAR;
        PG8_STAGE(PG8_SB(1, 0), cB + kstep, voffB); PG8_STAGE(PG8_SA(1, 0), cA + kstep, voffA); PG8_STAGE(PG8_SB(1, 1), cB + hstep + kstep, voffB);
        PG8_WAIT_V(6); PG8_BAR;
    }
    for (;;) {
        const bool has_next = S.next(ui + 1, nxt);
        const char* nA = has_next ? (const char*)g.A + (size_t)nxt.pm * tstep : cA; const char* nB = has_next ? (const char*)g.Bt + (size_t)nxt.pn * tstep : cB;
        for (int t = 0; t < nt; t += 2) {
            const bool last = (t == nt - 2);
            const char* a1 = cA + (size_t)(t + 1) * kstep;
            const char* a2 = last ? nA : cA + (size_t)(t + 2) * kstep; const char* b2 = last ? nB : cB + (size_t)(t + 2) * kstep;
            const char* a3 = a2 + kstep; const char* b3 = b2 + kstep;
            if (last && has_next) S.a_ready(nxt);
            if constexpr (SP2) {
            PG8_LDB(B0, 0, 0); PG8_LDB(B1, 0, 1); PG8_SCHED; PG8_LDA(At, 0, 0); PG8_STAGE(PG8_SA(1, 1), a1 + hstep, voffA);
            PG8_WAIT_V(8); PG8_WAIT_L(0); PG8_BAR; PG8_MMA(0, 0, At, B0); PG8_MMA(0, 1, At, B1); PG8_BAR; PG8_SCHED;
            PG8_LDA(At, 0, 1); PG8_STAGE(PG8_SB(0, 0), b2, voffB); PG8_STAGE(PG8_SB(0, 1), b2 + hstep, voffB); PG8_STAGE(PG8_SA(0, 0), a2, voffA);
            PG8_WAIT_V(8); PG8_WAIT_L(0); PG8_BAR; PG8_MMA(1, 0, At, B0); PG8_MMA(1, 1, At, B1); PG8_BAR; PG8_SCHED;
            PG8_LDB(B0, 1, 0); PG8_LDB(B1, 1, 1); PG8_SCHED; PG8_LDA(At, 1, 0); PG8_STAGE(PG8_SA(0, 1), a2 + hstep, voffA);
            PG8_WAIT_V(8); PG8_WAIT_L(0); PG8_BAR; PG8_MMA(0, 0, At, B0); PG8_MMA(0, 1, At, B1); PG8_BAR; PG8_SCHED;
            PG8_LDA(At, 1, 1); PG8_STAGE(PG8_SB(1, 0), b3, voffB); PG8_STAGE(PG8_SB(1, 1), b3 + hstep, voffB); PG8_STAGE(PG8_SA(1, 0), a3, voffA);
            PG8_WAIT_V(8); PG8_WAIT_L(0); PG8_BAR; PG8_MMA(1, 0, At, B0); PG8_MMA(1, 1, At, B1); PG8_BAR; PG8_SCHED;
            } else {
            PG8_LDB(B0, 0, 0); PG8_SCHED; PG8_LDA(At, 0, 0); PG8_STAGE(PG8_SA(1, 1), a1 + hstep, voffA);
            PG8_WAIT_L(8); PG8_BAR; PG8_WAIT_L(0); PG8_MMA(0, 0, At, B0); PG8_BAR; PG8_SCHED;
            PG8_LDB(B1, 0, 1); PG8_STAGE(PG8_SB(0, 0), b2, voffB);
            PG8_BAR; PG8_WAIT_L(0); PG8_MMA(0, 1, At, B1); PG8_BAR;
            PG8_LDA(At, 0, 1); PG8_STAGE(PG8_SA(0, 0), a2, voffA);
            PG8_BAR; PG8_WAIT_L(0); PG8_MMA(1, 0, At, B0); PG8_BAR; PG8_SCHED;
            PG8_STAGE(PG8_SB(0, 1), b2 + hstep, voffB);
            PG8_WAIT_V(6); PG8_BAR; PG8_MMA(1, 1, At, B1); PG8_BAR;
            PG8_LDB(B0, 1, 0); PG8_SCHED; PG8_LDA(At, 1, 0); PG8_STAGE(PG8_SA(0, 1), a2 + hstep, voffA);
            PG8_WAIT_L(8); PG8_BAR; PG8_WAIT_L(0); PG8_MMA(0, 0, At, B0); PG8_BAR; PG8_SCHED;
            PG8_LDB(B1, 1, 1); PG8_STAGE(PG8_SB(1, 0), b3, voffB);
            PG8_BAR; PG8_WAIT_L(0); PG8_MMA(0, 1, At, B1); PG8_BAR;
            PG8_LDA(At, 1, 1); PG8_STAGE(PG8_SA(1, 0), a3, voffA);
            PG8_BAR; PG8_WAIT_L(0); PG8_MMA(1, 0, At, B0); PG8_BAR; PG8_SCHED;
            PG8_STAGE(PG8_SB(1, 1), b3 + hstep, voffB);
            PG8_WAIT_V(6); PG8_BAR; PG8_MMA(1, 1, At, B1); PG8_BAR;
            }
        }
        if constexpr (ALIGN_EPI) { if (wr == 0) PG8_BAR; }
#if MK_PROBE >= 31
        const unsigned long long ge_t0 = __builtin_amdgcn_s_memrealtime();
#endif
        if constexpr (!Epi::AFTER_DRAIN) { E(acc, cur, wr, wc, fr, fq); S.done(cur); }
#if MK_PROBE >= 31
        asm volatile("s_waitcnt vmcnt(0)" ::: "memory");
        if (Epi::PROBE_ID == MK_PROBE && blockIdx.x == 0 && tid == 0) g_probe_acc += (float)(__builtin_amdgcn_s_memrealtime() - ge_t0);
#endif
        if (!has_next) break;
#pragma unroll
        for (int a = 0; a < 2; ++a)
#pragma unroll
            for (int b = 0; b < 2; ++b)
#pragma unroll
                for (int m = 0; m < 4; ++m)
#pragma unroll
                    for (int n = 0; n < 2; ++n) acc[a][b][m][n] = (f32x4){0.f, 0.f, 0.f, 0.f};
        cur = nxt; cA = nA; cB = nB; ++ui;
        if constexpr (ALIGN_EPI) { if (wr == 1) PG8_BAR; }
    }
    PG8_WAIT_V(0);
    if constexpr (!ALIGN_EPI) { if (wr == 0) PG8_BAR; }
    PG8_BAR;
    if constexpr (Epi::AFTER_DRAIN) { E.fused(acc, cur, wr, wc, fr, fq, lds, wid, lane); S.done(cur); }
#undef PG8_SA
#undef PG8_SB
#undef PG8_STAGE
#undef PG8_LDA
#undef PG8_LDB
#undef PG8_MMA
#undef PG8_WAIT_V
#undef PG8_WAIT_L
#undef PG8_BAR
#undef PG8_SCHED
}
}

constexpr int BATCH = 8, SEQ = 2048, DM = 1024, M = BATCH * SEQ, FF = 2816, PLE = 256;
constexpr int NH = 16, HD = 64;
constexpr int N_IN0 = 3072, N_IN1 = 2608, N_IN1P = 2816, N_GU = 2 * FF;
constexpr float RMS_EPS = 1e-6f;
constexpr float LOG2E = 1.4426950408889634f;
constexpr float C2 = 0.125f * LOG2E;
constexpr int TABN = 2048;

constexpr size_t MiB = 1u << 20, KiB = 1u << 10;
constexpr size_t WS_CTL = 0, CTL_ZERO_BYTES = 2 * MiB;
constexpr size_t WS_SS = 256 * KiB;
constexpr size_t WS_KMEAN = 1280 * KiB;
constexpr size_t WS_W = 2 * MiB;
constexpr size_t WS_WIN0 = WS_W, WS_WOUT0 = WS_WIN0 + 6 * MiB, WS_WGU0 = WS_WOUT0 + 2 * MiB, WS_WD0 = WS_WGU0 + 11 * MiB,
                 WS_WPG0 = WS_WD0 + 5632 * KiB, WS_WPP0 = WS_WPG0 + 2 * MiB,
                 WS_WIN1 = WS_WPP0 + 512 * KiB, WS_WOUT1 = WS_WIN1 + 5632 * KiB, WS_WGU1 = WS_WOUT1 + 2 * MiB, WS_WD1 = WS_WGU1 + 11 * MiB,
                 WS_WPG1 = WS_WD1 + 5632 * KiB, WS_WPP1 = WS_WPG1 + 2 * MiB,
                 WS_CW1K = WS_WPP1 + 512 * KiB, WS_CW1V = WS_CW1K + 512 * KiB, WS_CW2K = WS_CW1V + 512 * KiB, WS_CW2V = WS_CW2K + 16 * KiB,
                 WS_WEND = WS_CW2V + 16 * KiB;
static_assert(WS_WEND <= 58 * MiB, "weights");
constexpr size_t WS_MISC = 58 * MiB;
constexpr size_t WS_BIASD = WS_MISC;
constexpr size_t WS_CB1 = WS_MISC + 128 * KiB;
constexpr size_t WS_GN = WS_MISC + 192 * KiB;
constexpr size_t WS_KC = WS_MISC + 256 * KiB, WS_VC = WS_KC + 512 * KiB;
constexpr size_t WS_HB = 60 * MiB;
constexpr size_t WS_PP = 92 * MiB;
constexpr size_t WS_O = 124 * MiB;
constexpr size_t WS_QKV = 156 * MiB;
constexpr size_t WS_Q = WS_QKV, WS_K0 = WS_QKV + 32 * MiB, WS_V0 = WS_QKV + 64 * MiB;
constexpr size_t WS_KV1 = WS_QKV + 32 * MiB;
constexpr size_t WS_HID = WS_QKV;
constexpr size_t WS_PB1 = WS_QKV + 88 * MiB;
constexpr size_t WS_PB0 = WS_O;
constexpr size_t WS_GATES = 252 * MiB;
constexpr size_t WS_END = 256 * MiB;
static_assert(WS_QKV + 96 * MiB <= WS_GATES && WS_GATES + 3 * MiB <= WS_END, "ws map");

constexpr int CW_BAR = 4096;

constexpr int WAVE_LDS = 16384;
constexpr int TAB0_OFF = 131072;
constexpr int KM_OFF = TAB0_OFF + 21760;
constexpr int TAB1_OFF = 100608;
constexpr int MISC_OFF = 154880;
constexpr int LDS_BYTES = MISC_OFF + 512;
static_assert(LDS_BYTES <= 163840 && KM_OFF + 2048 <= MISC_OFF && TAB1_OFF + (4 * 2112 + 4 * 704) * 4 <= MISC_OFF, "LDS map");

#define GAS __attribute__((address_space(1)))
#define LAS __attribute__((address_space(3)))
typedef unsigned short bf16;
typedef float f32x4 __attribute__((ext_vector_type(4)));
typedef float f32x16 __attribute__((ext_vector_type(16)));
typedef short bf16x8 __attribute__((ext_vector_type(8)));
typedef unsigned u32x4 __attribute__((ext_vector_type(4)));
typedef unsigned u32x2 __attribute__((ext_vector_type(2)));
typedef GAS unsigned gu32;

__device__ __forceinline__ unsigned f2bf(float f) { unsigned u = __builtin_bit_cast(unsigned, f); return (u + 0x7fffu + ((u >> 16) & 1u)) >> 16; }
__device__ __forceinline__ unsigned pk2(float lo, float hi) { return f2bf(lo) | (f2bf(hi) << 16); }
__device__ __forceinline__ float bf2f(unsigned short h) { return __builtin_bit_cast(float, (unsigned)h << 16); }
typedef float f32x2_t __attribute__((ext_vector_type(2))); typedef __bf16 bf16x2_t __attribute__((ext_vector_type(2)));
__device__ __forceinline__ unsigned cvtpk(float lo, float hi) { f32x2_t v = {lo, hi}; bf16x2_t b = __builtin_convertvector(v, bf16x2_t); return __builtin_bit_cast(unsigned, b); }
__device__ __forceinline__ float fast_exp2(float x) { return __builtin_amdgcn_exp2f(x); }
__device__ __forceinline__ float fast_rcp(float x) { return __builtin_amdgcn_rcpf(x); }
__device__ __forceinline__ float sigmoidf_(float x) { return fast_rcp(1.0f + fast_exp2(-x * LOG2E)); }


__device__ __forceinline__ float x32_other(float v) { const auto r = __builtin_amdgcn_permlane32_swap(__builtin_bit_cast(unsigned, v), __builtin_bit_cast(unsigned, v), false, false);
    return (threadIdx.x & 32) ? __builtin_bit_cast(float, r[0]) : __builtin_bit_cast(float, r[1]); }
__device__ __forceinline__ float sum_x32(float v) { return v + __shfl_xor(v, 32); }
__device__ __forceinline__ float max_x32(float v) { const auto r = __builtin_amdgcn_permlane32_swap(__builtin_bit_cast(unsigned, v), __builtin_bit_cast(unsigned, v), false, false);
    return fmaxf(__builtin_bit_cast(float, r[0]), __builtin_bit_cast(float, r[1])); }
__device__ __forceinline__ float sum_x16(float v) { return v + __shfl_xor(v, 16); }
template <int CTRL> __device__ __forceinline__ float dppf(float v) { return __builtin_bit_cast(float, __builtin_amdgcn_update_dpp(0, __builtin_bit_cast(int, v), CTRL, 0xF, 0xF, true)); }
__device__ __forceinline__ float sum_row16(float v) { v += dppf<0xB1>(v); v += dppf<0x4E>(v); v += dppf<0x141>(v); v += dppf<0x140>(v); return v; }

using pg8::Unit;
typedef float accf4 __attribute__((ext_vector_type(4)));
#define EPI_ARGS const accf4 (&acc)[2][2][4][2], const Unit& u, int wr, int wc, int fr_in, int fq_in
#define EPI_OPAQUE int fr = fr_in, fq = fq_in; asm volatile("" : "+v"(fr), "+v"(fq));
typedef unsigned long long ss_t;
constexpr float SS_SCALE = 16777216.0f;
__device__ __forceinline__ float rstd_row(const ss_t* ss, int row) { return rsqrtf((float)ss[row] * (1.0f / (SS_SCALE * DM)) + RMS_EPS); }

struct EpiStoreBf16 {
    static constexpr bool PERM = true, AFTER_DRAIN = false; static constexpr int PROBE_ID = 30;
    bf16* O; int ldc;
    __device__ __forceinline__ void operator()(EPI_ARGS) const {
        EPI_OPAQUE
        const int row0 = u.pm * 256 + wr * 64 + fr, col0 = u.pn * 256 + wc * 32 + 8 * fq;
#pragma unroll
        for (int ai = 0; ai < 2; ++ai)
#pragma unroll
            for (int m = 0; m < 4; ++m) { bf16* rowp = O + (size_t)(row0 + ai * 128 + m * 16) * ldc + col0;
#pragma unroll
                for (int bj = 0; bj < 2; ++bj) { const accf4 v0 = acc[ai][bj][m][0], v1 = acc[ai][bj][m][1];
                    u32x4 w; w.x = cvtpk(v0[0], v0[1]); w.y = cvtpk(v0[2], v0[3]); w.z = cvtpk(v1[0], v1[1]); w.w = cvtpk(v1[2], v1[3]);
                    *(u32x4*)(rowp + bj * 128) = w; } }
    }
};

__device__ __forceinline__ void bf8_to_f(const u32x4 w, float (&f)[8]) {
    f[0] = __builtin_bit_cast(float, w.x << 16); f[1] = __builtin_bit_cast(float, w.x & 0xffff0000u); f[2] = __builtin_bit_cast(float, w.y << 16); f[3] = __builtin_bit_cast(float, w.y & 0xffff0000u);
    f[4] = __builtin_bit_cast(float, w.z << 16); f[5] = __builtin_bit_cast(float, w.z & 0xffff0000u); f[6] = __builtin_bit_cast(float, w.w << 16); f[7] = __builtin_bit_cast(float, w.w & 0xffff0000u);
}
template <int MODE> struct EpiResid {
    static constexpr bool PERM = true, AFTER_DRAIN = false; static constexpr int PROBE_ID = 32 + MODE;
    const bf16* base; bf16* outb; float* outf; ss_t* ss_out; const ss_t* ss_in; const bf16* pp;
    __device__ __forceinline__ void operator()(EPI_ARGS) const {
        EPI_OPAQUE
        const int row0 = u.pm * 256 + wr * 64 + fr, col0 = u.pn * 256 + wc * 32 + 8 * fq;
        float rsv[8];
#pragma unroll
        for (int g8 = 0; g8 < 8; ++g8) rsv[g8] = (MODE == 1) ? rstd_row(ss_in, row0 + (g8 >> 2) * 128 + (g8 & 3) * 16) : 1.f;
        float sqv[8];
#pragma unroll
        for (int ai = 0; ai < 2; ++ai) {
            u32x4 bw[4][2];
#pragma unroll
            for (int m = 0; m < 4; ++m) { const size_t off = (size_t)(row0 + ai * 128 + m * 16) * DM + col0;
                bw[m][0] = *(const u32x4*)(base + off); bw[m][1] = *(const u32x4*)(base + off + 128); }
#pragma unroll
            for (int m = 0; m < 4; ++m) {
                const int g8 = ai * 4 + m; const int row = row0 + ai * 128 + m * 16; const size_t off = (size_t)row * DM + col0;
                const float rs = rsv[g8];
                float sq = 0.f;
#pragma unroll
                for (int bj = 0; bj < 2; ++bj) {
                    const accf4 v0 = acc[ai][bj][m][0], v1 = acc[ai][bj][m][1];
                    float v[8] = {v0[0], v0[1], v0[2], v0[3], v1[0], v1[1], v1[2], v1[3]};
                    float bs[8]; bf8_to_f(bw[m][bj], bs);
                    if (MODE == 1) { float p[8]; bf8_to_f(*(const u32x4*)(pp + off + bj * 128), p);
                        const float nrl = -rs * LOG2E;
#pragma unroll
                        for (int i = 0; i < 4; ++i) { const f32x2_t t = (f32x2_t){v[2 * i], v[2 * i + 1]} * nrl;
                            f32x2_t e = (f32x2_t){fast_exp2(t.x), fast_exp2(t.y)}; e = e + 1.0f; e = (f32x2_t){fast_rcp(e.x), fast_rcp(e.y)};
                            const f32x2_t o = e * (f32x2_t){p[2 * i], p[2 * i + 1]}; v[2 * i] = o.x; v[2 * i + 1] = o.y; } }
                    float hh[8];
#pragma unroll
                    for (int i = 0; i < 8; ++i) { hh[i] = bs[i] + v[i]; sq += hh[i] * hh[i]; }
                    if (outf) { __builtin_nontemporal_store((f32x4){hh[0], hh[1], hh[2], hh[3]}, (f32x4*)(outf + off + bj * 128)); __builtin_nontemporal_store((f32x4){hh[4], hh[5], hh[6], hh[7]}, (f32x4*)(outf + off + bj * 128 + 4)); }
                    else { u32x4 w; w.x = cvtpk(hh[0], hh[1]); w.y = cvtpk(hh[2], hh[3]); w.z = cvtpk(hh[4], hh[5]); w.w = cvtpk(hh[6], hh[7]); *(u32x4*)(outb + off + bj * 128) = w; }
                }
                sqv[g8] = sq;
            }
        }
        if (ss_out) {
#pragma unroll
            for (int g8 = 0; g8 < 8; ++g8) sqv[g8] = sum_x16(sqv[g8]);
#pragma unroll
            for (int g8 = 0; g8 < 8; ++g8) sqv[g8] = sum_x32(sqv[g8]);
            if (fq == 0) {
#pragma unroll
                for (int g8 = 0; g8 < 8; ++g8) atomicAdd(ss_out + row0 + (g8 >> 2) * 128 + (g8 & 3) * 16, (ss_t)(sqv[g8] * SS_SCALE)); }
        }
    }
};

struct EpiSwiglu {
    static constexpr bool PERM = true, AFTER_DRAIN = false; static constexpr int PROBE_ID = 31;
    bf16* hid; const ss_t* ss_in; int ghost;
    __device__ __forceinline__ void operator()(EPI_ARGS) const {
#if MK_GHOST >= 30
        if (ghost) return;
#endif
        EPI_OPAQUE
        const int row0 = u.pm * 256 + wr * 64 + fr, col0 = u.pn * 128 + wc * 32 + 8 * fq;
        float rsv[8];
#pragma unroll
        for (int g8 = 0; g8 < 8; ++g8) rsv[g8] = rstd_row(ss_in, row0 + (g8 >> 2) * 128 + (g8 & 3) * 16);
#pragma unroll
        for (int ai = 0; ai < 2; ++ai)
#pragma unroll
            for (int m = 0; m < 4; ++m) {
                const int row = row0 + ai * 128 + m * 16; const float rs = rsv[ai * 4 + m];
                const float nrl = -rs * LOG2E, rs2 = rs * rs;
                f32x2_t a[4], b[4], e[4]; float r[8];
#pragma unroll
                for (int n = 0; n < 2; ++n)
#pragma unroll
                    for (int i = 0; i < 2; ++i) { a[2 * n + i] = (f32x2_t){acc[ai][0][m][n][2 * i], acc[ai][0][m][n][2 * i + 1]}; b[2 * n + i] = (f32x2_t){acc[ai][1][m][n][2 * i], acc[ai][1][m][n][2 * i + 1]}; }
#pragma unroll
                for (int i = 0; i < 4; ++i) { const f32x2_t t = a[i] * nrl; e[i] = (f32x2_t){fast_exp2(t.x), fast_exp2(t.y)}; }
#pragma unroll
                for (int i = 0; i < 4; ++i) { e[i] = e[i] + 1.0f; b[i] = a[i] * b[i]; }
#pragma unroll
                for (int i = 0; i < 4; ++i) e[i] = (f32x2_t){fast_rcp(e[i].x), fast_rcp(e[i].y)};
#pragma unroll
                for (int i = 0; i < 4; ++i) { const f32x2_t o = b[i] * (e[i] * rs2); r[2 * i] = o.x; r[2 * i + 1] = o.y; }
                u32x4 w; w.x = cvtpk(r[0], r[1]); w.y = cvtpk(r[2], r[3]); w.z = cvtpk(r[4], r[5]); w.w = cvtpk(r[6], r[7]);
                *(u32x4*)(hid + (size_t)row * FF + col0) = w;
            }
    }
};

template <int LAYER> struct EpiInProj {
    static constexpr bool PERM = true, AFTER_DRAIN = false; static constexpr int PROBE_ID = 34 + LAYER;
    const ss_t* ss_in; bf16* Q;
    const float* gains;
    float* kmean; float* gates;
    __device__ __forceinline__ void operator()(EPI_ARGS) const {
        EPI_OPAQUE
        const int pn = u.pn;
        const float* gain = gains; bool has_gain = false; bf16* dst = Q; int head, nheads; bool do_km = false;
        if (LAYER == 0) {
            const int t6 = pn >> 1, type = t6 % 3, grp = t6 / 3;
            head = grp * 8 + (pn & 1) * 4 + wc; nheads = 16;
            dst = Q + (size_t)type * ((size_t)M * DM);
            has_gain = type < 2; gain = gains + 64 * (grp * 2 + (type & 1)); do_km = (type == 1 && grp == 0);
        } else {
            if (pn < 4) { head = pn * 4 + wc; nheads = 16; has_gain = true; gain = gains + 64 * 4; }
            else { head = wc; nheads = 4; dst = Q + (size_t)M * DM + (size_t)(pn - 4) * ((size_t)BATCH * 4 * SEQ * HD); has_gain = (pn == 6) || (pn == 8); gain = gains + 64 * (pn == 6 ? 5 : 6); }
        }
        const int row0 = u.pm * 256 + wr * 64 + fr;
        if (LAYER == 1 && pn == 10) {
            if (wc == 0) {
#pragma unroll
                for (int ai = 0; ai < 2; ++ai)
#pragma unroll
                    for (int m = 0; m < 4; ++m) { const int row = row0 + ai * 128 + m * 16; const float rs = rstd_row(ss_in, row);
#pragma unroll
                        for (int bj = 0; bj < 2; ++bj) { const int j0 = 32 * bj + 8 * fq;
                            if (j0 < 48) { const accf4 v0 = acc[ai][bj][m][0], v1 = acc[ai][bj][m][1];
                                f32x4 g0, g1;
#pragma unroll
                                for (int i = 0; i < 4; ++i) { g0[i] = sigmoidf_(v0[i] * rs); g1[i] = sigmoidf_(v1[i] * rs); }
                                *(f32x4*)(gates + (size_t)row * 48 + j0) = g0; *(f32x4*)(gates + (size_t)row * 48 + j0 + 4) = g1; } } }
            }
            return;
        }
        float ksum[2][2][4];
#pragma unroll
        for (int bj = 0; bj < 2; ++bj)
#pragma unroll
            for (int n = 0; n < 2; ++n)
#pragma unroll
                for (int i = 0; i < 4; ++i) ksum[bj][n][i] = 0.f;
        float rsv[8], r2v[8];
#pragma unroll
        for (int g8 = 0; g8 < 8; ++g8) { const int ai = g8 >> 2, m = g8 & 3; rsv[g8] = rstd_row(ss_in, row0 + ai * 128 + m * 16); }
        if (has_gain) {
#pragma unroll
            for (int g8 = 0; g8 < 8; ++g8) { const int ai = g8 >> 2, m = g8 & 3; float sq = 0.f;
#pragma unroll
                for (int bj = 0; bj < 2; ++bj)
#pragma unroll
                    for (int n = 0; n < 2; ++n)
#pragma unroll
                        for (int i = 0; i < 4; ++i) { const float x = acc[ai][bj][m][n][i] * rsv[g8]; sq += x * x; }
                r2v[g8] = sq; }
#pragma unroll
            for (int g8 = 0; g8 < 8; ++g8) r2v[g8] = sum_x16(r2v[g8]);
#pragma unroll
            for (int g8 = 0; g8 < 8; ++g8) r2v[g8] = sum_x32(r2v[g8]);
#pragma unroll
            for (int g8 = 0; g8 < 8; ++g8) r2v[g8] = rsqrtf(r2v[g8] * (1.0f / HD) + RMS_EPS) * rsv[g8];
        } else {
#pragma unroll
            for (int g8 = 0; g8 < 8; ++g8) r2v[g8] = rsv[g8];
        }
        f32x4 gq[2][2];
#pragma unroll
        for (int bj = 0; bj < 2; ++bj)
#pragma unroll
            for (int n = 0; n < 2; ++n) gq[bj][n] = has_gain ? *(const f32x4*)(gain + 32 * bj + 8 * fq + 4 * n) : (f32x4){1.f, 1.f, 1.f, 1.f};
#pragma unroll
        for (int ai = 0; ai < 2; ++ai)
#pragma unroll
            for (int m = 0; m < 4; ++m) {
                const int row = row0 + ai * 128 + m * 16, b = row >> 11, s = row & (SEQ - 1); const float sc = r2v[ai * 4 + m];
                float v[2][2][4];
#pragma unroll
                for (int bj = 0; bj < 2; ++bj)
#pragma unroll
                    for (int n = 0; n < 2; ++n)
#pragma unroll
                        for (int i = 0; i < 4; ++i) v[bj][n][i] = acc[ai][bj][m][n][i] * sc * gq[bj][n][i];
                if (LAYER == 0 && do_km) {
#pragma unroll
                    for (int bj = 0; bj < 2; ++bj)
#pragma unroll
                        for (int n = 0; n < 2; ++n)
#pragma unroll
                            for (int i = 0; i < 4; ++i) ksum[bj][n][i] += v[bj][n][i];
                }
                bf16* rowp = dst + ((size_t)(b * nheads + head) * SEQ + s) * HD + 8 * fq;
#pragma unroll
                for (int bj = 0; bj < 2; ++bj) { u32x4 w; w.x = cvtpk(v[bj][0][0], v[bj][0][1]); w.y = cvtpk(v[bj][0][2], v[bj][0][3]); w.z = cvtpk(v[bj][1][0], v[bj][1][1]); w.w = cvtpk(v[bj][1][2], v[bj][1][3]);
                    *(u32x4*)(rowp + 32 * bj) = w; }
            }
        if (LAYER == 0 && do_km) {
            const int b = u.pm >> 3, blk = u.pm & 7;
            float* kp = kmean + ((size_t)((b * 8 + head) * 8 + blk)) * HD + 8 * fq;
#pragma unroll
            for (int bj = 0; bj < 2; ++bj)
#pragma unroll
                for (int n = 0; n < 2; ++n)
#pragma unroll
                    for (int i = 0; i < 4; ++i) { float s = ksum[bj][n][i];
                        s = sum_row16(s);
                        if (fr == 0) atomicAdd(kp + 32 * bj + 4 * n + i, s); }
        }
    }
};
#define XB_TMO      128
#define XB_XCNT(j)  (256  + 64 * (j))
#define XB_XSUB(j)  (1280 + 64 * (j))
#define XB_XGEN(j)  (2304 + 64 * (j))
#define XB_TOP      3328
#define XB_TOPGEN   3392
#define XCD_BAR_WORDS 3456
#define XB_SPIN_CAP (1u << 18)
#ifndef MK_NOMEMSET
#define MK_NOMEMSET 1
#endif
#ifndef MK_FLATREL
#define MK_FLATREL 2
#endif
#ifndef MK_EARLYINV
#define MK_EARLYINV 1
#endif
#define XB_EXIT     XCD_BAR_WORDS
#if MK_NOMEMSET
__device__ unsigned g_xbar[XCD_BAR_WORDS + 64];
#endif

__device__ __forceinline__ unsigned xb_ld(unsigned* p)              { return __hip_atomic_load(p, __ATOMIC_RELAXED, __HIP_MEMORY_SCOPE_AGENT); }
__device__ __forceinline__ unsigned xb_add(unsigned* p, unsigned v) { return __hip_atomic_fetch_add(p, v, __ATOMIC_RELAXED, __HIP_MEMORY_SCOPE_AGENT); }
__device__ __forceinline__ void xb_st0(unsigned* p)                { __hip_atomic_store(p, 0u, __ATOMIC_RELAXED, __HIP_MEMORY_SCOPE_AGENT); }
__device__ __forceinline__ unsigned xb_xcc_id() { return (unsigned)__builtin_amdgcn_s_getreg((3 << 11) | 20) & 0xFu; }
#define XB_SPIN(cond, bar) do { unsigned _sp = 0; while (cond) { __builtin_amdgcn_s_sleep(1); \
    if ((++_sp & 255u) == 0u) { if (xb_ld(&(bar)[XB_TMO])) break; if (_sp > XB_SPIN_CAP) { atomicAdd(&(bar)[XB_TMO], 1u); break; } } } } while (0)

struct XcdBarrier {
    unsigned* bar; unsigned x;
    volatile LAS unsigned* st;
};

__device__ __forceinline__ XcdBarrier xcd_barrier_post(unsigned* bar, volatile LAS unsigned* st) {
    XcdBarrier b; b.bar = bar; b.x = xb_xcc_id(); b.st = st;
    if (threadIdx.x == 0) (void)xb_add(&bar[XB_XCNT(b.x)], 1u);
    return b;
}
__device__ __forceinline__ void xcd_barrier_complete(unsigned* bar, unsigned x, unsigned& nloc, unsigned& nx) {
    const unsigned G = gridDim.x * gridDim.y * gridDim.z;
    unsigned sum, cnt, mine, sp = 0u;
    for (;;) {
        sum = 0u; cnt = 0u; mine = 0u;
#pragma unroll
        for (unsigned j = 0; j < 16; ++j) { const unsigned c = xb_ld(&bar[XB_XCNT(j)]); sum += c; cnt += (c > 0u) ? 1u : 0u; mine = (j == x) ? c : mine; }
        if (sum == G) break;
        __builtin_amdgcn_s_sleep(1);
        if ((++sp & 255u) == 0u) { if (xb_ld(&bar[XB_TMO])) break; if (sp > XB_SPIN_CAP) { atomicAdd(&bar[XB_TMO], 1u); break; } }
    }
    nloc = mine > 0u ? mine : 1u; nx = cnt > 0u ? cnt : 1u;
}

struct XbNoShadow { __device__ __forceinline__ void operator()() const {} };
template <class F = XbNoShadow> __device__ __forceinline__ void xcd_barrier(const XcdBarrier& b, F shadow = F()) {
    asm volatile("s_waitcnt vmcnt(0)" ::: "memory");
    __syncthreads();
    if (threadIdx.x == 0) {
        unsigned* bar = b.bar;
        __builtin_amdgcn_s_waitcnt(0);
        unsigned nloc = b.st[0], nx = b.st[1];
        if (nloc == 0u) { xcd_barrier_complete(bar, b.x, nloc, nx); b.st[0] = nloc; b.st[1] = nx; }
        const unsigned old = xb_add(&bar[XB_XSUB(b.x)], 1u);
        const unsigned gen = old / nloc;
        if (old + 1u == (gen + 1u) * nloc) {
            __builtin_amdgcn_fence(__ATOMIC_RELEASE, "agent");
            asm volatile("s_waitcnt vmcnt(0)" ::: "memory");
#if MK_FLATREL >= 2
            (void)xb_add(&bar[XB_TOP], 1u);
#if MK_EARLYINV
            asm volatile("buffer_inv sc1" ::: "memory");
#endif
            XB_SPIN(xb_ld(&bar[XB_TOP]) < (gen + 1u) * nx, bar);
#else
            const unsigned og = xb_add(&bar[XB_TOP], 1u);
            const unsigned tg = og / nx;
            if (og + 1u == (tg + 1u) * nx) xb_add(&bar[XB_TOPGEN], 1u);
            else XB_SPIN(xb_ld(&bar[XB_TOPGEN]) == tg, bar);
#endif
#if !MK_EARLYINV
            __builtin_amdgcn_fence(__ATOMIC_ACQUIRE, "agent");
#endif
#if !MK_FLATREL
            xb_add(&bar[XB_XGEN(b.x)], 1u);
#endif
            asm volatile("s_waitcnt vmcnt(0)" ::: "memory");
        } else {
#if MK_EARLYINV
            asm volatile("buffer_inv sc1" ::: "memory");
#endif
#if MK_FLATREL >= 2
            XB_SPIN(xb_ld(&bar[XB_TOP]) < (gen + 1u) * nx, bar);
#elif MK_FLATREL
            XB_SPIN(xb_ld(&bar[XB_TOPGEN]) == gen, bar);
#else
            XB_SPIN(xb_ld(&bar[XB_XGEN(b.x)]) == gen, bar);
#endif
#if !MK_EARLYINV
            __builtin_amdgcn_fence(__ATOMIC_ACQUIRE, "agent");
#endif
            asm volatile("s_waitcnt vmcnt(0)" ::: "memory");
        }
    }
    if (threadIdx.x >= 64) shadow();
    __syncthreads();
}

__device__ __forceinline__ int crow(int r, int hi) { return (r & 3) + 8 * (r >> 2) + 4 * hi; }
__device__ __forceinline__ void glds16(const void* gsrc, unsigned lds_dst) { unsigned keep;
    asm volatile("s_mov_b32 %0, m0\n\ts_mov_b32 m0, %2\n\ts_nop 0\n\tglobal_load_lds_dwordx4 %1, off\n\ts_mov_b32 m0, %0" : "=&s"(keep) : "v"(gsrc), "s"(lds_dst) : "memory"); }
__device__ __forceinline__ void glds16_nt(const void* gsrc, unsigned lds_dst) { unsigned keep;
    asm volatile("s_mov_b32 %0, m0\n\ts_mov_b32 m0, %2\n\ts_nop 0\n\tglobal_load_lds_dwordx4 %1, off nt\n\ts_mov_b32 m0, %0" : "=&s"(keep) : "v"(gsrc), "s"(lds_dst) : "memory"); }
typedef short v4i16_t __attribute__((ext_vector_type(4)));
typedef LAS const char* lds_cptr;
__device__ __forceinline__ v4i16_t vtr(lds_cptr p) { return __builtin_amdgcn_ds_read_tr16_b64_v4i16((LAS v4i16_t*)p); }
constexpr int TILE_B = 16384;
constexpr float THR = 8.0f;
__device__ __forceinline__ int clampi(int v, int lo, int hi) { return v < lo ? lo : (v > hi ? hi : v); }

struct WCtx { int lane, r32, hi; unsigned lds0; lds_cptr ldsp; unsigned koff, voff; bf16x8 lsel; };
__device__ __forceinline__ WCtx make_ctx(LAS unsigned char* L) {
    int lane = threadIdx.x & 63; asm volatile("" : "+v"(lane));
    WCtx c; c.lane = lane; c.r32 = lane & 31; c.hi = lane >> 5; c.ldsp = (lds_cptr)L; c.lds0 = (unsigned)(uintptr_t)((unsigned char*)L);
    c.koff = c.r32 * 128 + (((c.r32 & 7) ^ c.hi) << 4);
    const int q = (lane & 15) >> 2, p = lane & 3, g1 = (lane >> 4) & 1;
    c.voff = 8192 + (4 * c.hi + q) * 128 + ((((g1 << 1) | (p >> 1)) ^ ((q >> 1) << 2)) << 4) + (p & 1) * 8;
    { const bool on = ((lane & 15) == 0 && ((lane >> 4) & 1) == 0) || ((lane & 15) == 1 && ((lane >> 4) & 1) == 1); const short v = on ? (short)0x3F80 : (short)0;
      c.lsel = (bf16x8){v, v, v, v, v, v, v, v}; }
    return c;
}
__device__ __forceinline__ void issue_piece(const WCtx& c, const bf16* Kb, const bf16* Vb, unsigned rowidx, unsigned tile_lds, int pc) {
    const unsigned cch = c.lane & 7, rl = c.lane >> 3;
    unsigned ko = rowidx * 128u + ((cch ^ rl) << 4); asm volatile("" : "+v"(ko));
    unsigned vo = rowidx * 128u + ((cch ^ (((rl >> 1) & 1) << 2)) << 4); asm volatile("" : "+v"(vo));
    glds16((const char*)Kb + ko, (unsigned)__builtin_amdgcn_readfirstlane(tile_lds + pc * 1024));
    glds16((const char*)Vb + vo, (unsigned)__builtin_amdgcn_readfirstlane(tile_lds + 8192 + pc * 1024));
}
__device__ __forceinline__ void issue_k_piece(const WCtx& c, const bf16* Kb, unsigned rowidx, unsigned tile_lds, int pc) {
    const unsigned cch = c.lane & 7, rl = c.lane >> 3;
    unsigned ko = rowidx * 128u + ((cch ^ rl) << 4); asm volatile("" : "+v"(ko));
    glds16((const char*)Kb + ko, (unsigned)__builtin_amdgcn_readfirstlane(tile_lds + pc * 1024));
}
__device__ __forceinline__ void issue_v_piece(const WCtx& c, const bf16* Vb, unsigned rowidx, unsigned tile_lds, int pc) {
    const unsigned cch = c.lane & 7, rl = c.lane >> 3;
    unsigned vo = rowidx * 128u + ((cch ^ (((rl >> 1) & 1) << 2)) << 4); asm volatile("" : "+v"(vo));
    glds16((const char*)Vb + vo, (unsigned)__builtin_amdgcn_readfirstlane(tile_lds + 8192 + pc * 1024));
}
__device__ __forceinline__ void vm_wait8() { asm volatile("s_waitcnt vmcnt(8)" ::: "memory"); }
__device__ __forceinline__ void vm_wait0() { asm volatile("s_waitcnt vmcnt(0)" ::: "memory"); }
__device__ __forceinline__ void lgkm_wait0() { asm volatile("s_waitcnt lgkmcnt(0)" ::: "memory"); }

__device__ __forceinline__ void tile_qk(const WCtx& c, lds_cptr kt, const bf16x8 (&qr)[4], f32x16& p0, f32x16& p1) {
#pragma unroll
    for (int d0 = 0; d0 < 4; ++d0) {
        const unsigned off = c.koff ^ (d0 << 5);
        const bf16x8 b0 = *(LAS const bf16x8*)(kt + off), b1 = *(LAS const bf16x8*)(kt + off + 4096);
        p0 = __builtin_amdgcn_mfma_f32_32x32x16_bf16(b0, qr[d0], p0, 0, 0, 0);
        p1 = __builtin_amdgcn_mfma_f32_32x32x16_bf16(b1, qr[d0], p1, 0, 0, 0);
    }
}
#ifndef MK_LSUM
#define MK_LSUM 1
#endif
#ifndef MK_BIGL
#define MK_BIGL 0x1p40f
#endif
constexpr float BIGL = MK_BIGL;
#ifndef MK_NOPK
#define MK_NOPK 1
#endif
#ifndef MK_DIL_PF
#define MK_DIL_PF 0
#endif
#ifndef MK_MOBA_PF
#define MK_MOBA_PF 1
#endif
#ifndef MK_NSA_EV
#define MK_NSA_EV 1
#endif
#ifndef MK_MOBA_EV
#define MK_MOBA_EV 0
#endif
#ifndef MK_PIPE
#define MK_PIPE 0
#endif
#ifndef MK_QKSPLIT
#define MK_QKSPLIT 0
#endif
#ifndef MK_PRIO
#define MK_PRIO 2
#endif
struct VFr { bf16x8 v0[4], v1[4]; };
__device__ __forceinline__ void vfr_load(const WCtx& c, lds_cptr vt, VFr& f) {
    lds_cptr v0p = vt + c.voff, v1p = vt + (c.voff ^ 64u);
#pragma unroll
    for (int ks = 0; ks < 4; ++ks) {
        const v4i16_t l0 = vtr(v0p + ks * 2048), h0 = vtr(v0p + ks * 2048 + 1024), l1 = vtr(v1p + ks * 2048), h1 = vtr(v1p + ks * 2048 + 1024);
        f.v0[ks] = (bf16x8){l0[0], l0[1], l0[2], l0[3], h0[0], h0[1], h0[2], h0[3]};
        f.v1[ks] = (bf16x8){l1[0], l1[1], l1[2], l1[3], h1[0], h1[1], h1[2], h1[3]};
    }
}
template <bool LS = false> __device__ __forceinline__ void tile_pv(const WCtx& c, lds_cptr vt, f32x16& o0, f32x16& o1, const f32x16& p0, const f32x16& p1, f32x4* ls = nullptr, const VFr* pre = nullptr) {
    u32x4 pw[4];
#pragma unroll
    for (int k = 0; k < 2; ++k) {
        pw[k]     = (u32x4){cvtpk(p0[8 * k], p0[8 * k + 1]), cvtpk(p0[8 * k + 2], p0[8 * k + 3]), cvtpk(p0[8 * k + 4], p0[8 * k + 5]), cvtpk(p0[8 * k + 6], p0[8 * k + 7])};
        pw[2 + k] = (u32x4){cvtpk(p1[8 * k], p1[8 * k + 1]), cvtpk(p1[8 * k + 2], p1[8 * k + 3]), cvtpk(p1[8 * k + 4], p1[8 * k + 5]), cvtpk(p1[8 * k + 6], p1[8 * k + 7])};
    }
    lds_cptr v0p = vt + c.voff, v1p = vt + (c.voff ^ 64u);
#pragma unroll
    for (int ks = 0; ks < 4; ++ks) {
        bf16x8 v0, v1;
        if (pre) { v0 = pre->v0[ks]; v1 = pre->v1[ks]; }
        else { const v4i16_t l0 = vtr(v0p + ks * 2048), h0 = vtr(v0p + ks * 2048 + 1024), l1 = vtr(v1p + ks * 2048), h1 = vtr(v1p + ks * 2048 + 1024);
            v0 = (bf16x8){l0[0], l0[1], l0[2], l0[3], h0[0], h0[1], h0[2], h0[3]};
            v1 = (bf16x8){l1[0], l1[1], l1[2], l1[3], h1[0], h1[1], h1[2], h1[3]}; }
        const bf16x8 pf = __builtin_bit_cast(bf16x8, pw[ks]);
#if MK_PRIO >= 2
        if (LS) __builtin_amdgcn_s_setprio(1);
#endif
        if (LS) *ls = __builtin_amdgcn_mfma_f32_16x16x32_bf16(c.lsel, pf, *ls, 0, 0, 0);
        o0 = __builtin_amdgcn_mfma_f32_32x32x16_bf16(v0, pf, o0, 0, 0, 0);
        o1 = __builtin_amdgcn_mfma_f32_32x32x16_bf16(v1, pf, o1, 0, 0, 0);
#if MK_PRIO >= 2
        if (LS) __builtin_amdgcn_s_setprio(0);
#endif
    }
}
#if MK_LSUM
struct AState { f32x16 o0, o1; f32x4 ls; float mhat; bool sh; };
__device__ __forceinline__ void astate_init(AState& s) {
#pragma unroll
    for (int r = 0; r < 16; ++r) { s.o0[r] = 0.f; s.o1[r] = 0.f; }
    s.ls = (f32x4){0.f, 0.f, 0.f, 0.f}; s.mhat = 0.f; s.sh = false;
}
#else
struct AState { f32x16 o0, o1, nv; float mhat, l; };
__device__ __forceinline__ void astate_init(AState& s) {
#pragma unroll
    for (int r = 0; r < 16; ++r) { s.o0[r] = 0.f; s.o1[r] = 0.f; s.nv[r] = 0.f; }
    s.mhat = 0.f; s.l = 0.f;
}
#endif
#if MK_LSUM
__device__ __forceinline__ float astate_l(const AState& st, const WCtx& c) {
    const float a = __shfl(st.ls[0], c.r32 & 15), b = __shfl(st.ls[1], c.r32 & 15); return (c.r32 & 16) ? b : a;
}
__device__ __forceinline__ void astate_recheck(AState& st, const WCtx& c) {
    if (__any(fmaxf(st.ls[0], st.ls[1]) > BIGL)) {
        asm volatile("" ::: "memory");
        const float d0 = st.ls[0] > BIGL ? __builtin_log2f(st.ls[0]) : 0.f, d1 = st.ls[1] > BIGL ? __builtin_log2f(st.ls[1]) : 0.f;
        const float a = __shfl(d0, c.r32 & 15), b = __shfl(d1, c.r32 & 15); const float dl = (c.r32 & 16) ? b : a;
        st.mhat += dl; st.sh = true;
        const float f = fast_exp2(-dl);
#pragma unroll
        for (int r = 0; r < 16; ++r) { st.o0[r] *= f; st.o1[r] *= f; }
        st.ls[0] *= fast_exp2(-d0); st.ls[1] *= fast_exp2(-d1);
    }
}
__device__ __forceinline__ void astate_shift(const AState& st, f32x16& p0, f32x16& p1) {
    if (st.sh) {
        asm volatile("" ::: "memory");
#pragma unroll
        for (int r = 0; r < 16; ++r) { p0[r] -= st.mhat; p1[r] -= st.mhat; }
    }
}
#endif
struct NoHook { __device__ __forceinline__ void operator()() const {} };
template <class BiasF, class H1 = NoHook, class H2 = NoHook, class H3 = NoHook>
__device__ __forceinline__ void tile_step(const WCtx& c, unsigned tile, AState& st, const bf16x8 (&qr)[4], BiasF biasf, H1 h1 = H1(), H2 h2 = H2(), H3 h3 = H3()) {
#if MK_LSUM
    astate_recheck(st, c);
    f32x16 p0, p1;
#pragma unroll
    for (int r = 0; r < 16; ++r) { p0[r] = biasf(r, 0); p1[r] = biasf(r, 1); }
    tile_qk(c, c.ldsp + tile, qr, p0, p1);
    h1();
    astate_shift(st, p0, p1);
#pragma unroll
    for (int r = 0; r < 16; ++r) { p0[r] = fast_exp2(p0[r]); p1[r] = fast_exp2(p1[r]); }
    h2();
    tile_pv<true>(c, c.ldsp + tile, st.o0, st.o1, p0, p1, &st.ls);
    h3();
#else
    f32x16 p0 = st.nv, p1 = st.nv;
    tile_qk(c, c.ldsp + tile, qr, p0, p1);
    h1();
    float rm = -INFINITY;
#pragma unroll
    for (int r = 0; r < 16; ++r) { p0[r] = __builtin_fmaf(p0[r], C2, biasf(r, 0)); rm = fmaxf(rm, p0[r]); }
#pragma unroll
    for (int r = 0; r < 16; ++r) { p1[r] = __builtin_fmaf(p1[r], C2, biasf(r, 1)); rm = fmaxf(rm, p1[r]); }
    float sum = 0.f;
#pragma unroll
    for (int r = 0; r < 16; ++r) { p0[r] = fast_exp2(p0[r]); p1[r] = fast_exp2(p1[r]); sum += p0[r] + p1[r]; }
    st.l += sum;
    h2();
    tile_pv(c, c.ldsp + tile, st.o0, st.o1, p0, p1);
    h3();
    rm = max_x32(rm);
    if (__any(rm > THR)) {
        asm volatile("" ::: "memory");
        const float dl = fmaxf(rm, 0.f);
        st.mhat += dl; const float ng = -st.mhat * (1.0f / C2);
        const float f = fast_exp2(-dl);
        st.l *= f;
#pragma unroll
        for (int r = 0; r < 16; ++r) { st.o0[r] *= f; st.o1[r] *= f; st.nv[r] = ng; }
    }
#endif
}
__device__ __forceinline__ void bias_ld(LAS const float* P0_, f32x16& p0, f32x16& p1) {
    unsigned pa = (unsigned)(size_t)P0_; asm volatile("" : "+v"(pa)); LAS const float* P0 = (LAS const float*)(size_t)pa;
#pragma unroll
    for (int r = 0; r < 16; ++r) { p0[r] = P0[(r & 3) + 8 * (r >> 2)]; p1[r] = P0[32 + (r & 3) + 8 * (r >> 2)]; }
}
template <int G = 0, class H1 = NoHook, class H2 = NoHook, class H3 = NoHook, bool EV = false>
__device__ __forceinline__ void tile_step_fast(const WCtx& c, unsigned tile, AState& st, const bf16x8 (&qr)[4], f32x16 p0, f32x16 p1, H1 h1 = H1(), H2 h2 = H2(), H3 h3 = H3()) {
    if (G == 6) { return; }
#if MK_LSUM
    astate_recheck(st, c);
#endif
    lds_cptr kt = c.ldsp + tile;
    bf16x8 kf[8];
#pragma unroll
    for (int d0 = 0; d0 < 4; ++d0) { const unsigned off = c.koff ^ (d0 << 5); kf[2 * d0] = *(LAS const bf16x8*)(kt + off); kf[2 * d0 + 1] = *(LAS const bf16x8*)(kt + off + 4096); }
#if MK_LSUM
    VFr vf;
    if (EV) vfr_load(c, c.ldsp + tile, vf);
    __builtin_amdgcn_sched_barrier(0);
#if MK_PRIO
    __builtin_amdgcn_s_setprio(1);
#endif
#if MK_QKSPLIT
#pragma unroll
    for (int d0 = 0; d0 < 4; ++d0) p0 = __builtin_amdgcn_mfma_f32_32x32x16_bf16(kf[2 * d0], qr[d0], p0, 0, 0, 0);
#pragma unroll
    for (int d0 = 0; d0 < 4; ++d0) p1 = __builtin_amdgcn_mfma_f32_32x32x16_bf16(kf[2 * d0 + 1], qr[d0], p1, 0, 0, 0);
#else
#pragma unroll
    for (int d0 = 0; d0 < 4; ++d0) {
        p0 = __builtin_amdgcn_mfma_f32_32x32x16_bf16(kf[2 * d0], qr[d0], p0, 0, 0, 0);
        p1 = __builtin_amdgcn_mfma_f32_32x32x16_bf16(kf[2 * d0 + 1], qr[d0], p1, 0, 0, 0);
    }
#endif
#if MK_PRIO
    __builtin_amdgcn_s_setprio(0);
    __builtin_amdgcn_sched_barrier(0);
#endif
#else
    float bv0[16], bv1[16];
#pragma unroll
    for (int r = 0; r < 16; ++r) { bv0[r] = P0[63 - ((r & 3) + 8 * (r >> 2))]; bv1[r] = P0[31 - ((r & 3) + 8 * (r >> 2))]; }
    __builtin_amdgcn_sched_barrier(0);
    f32x16 p0 = __builtin_amdgcn_mfma_f32_32x32x16_bf16(kf[0], qr[0], st.nv, 0, 0, 0);
    f32x16 p1 = __builtin_amdgcn_mfma_f32_32x32x16_bf16(kf[1], qr[0], st.nv, 0, 0, 0);
#pragma unroll
    for (int d0 = 1; d0 < 4; ++d0) {
        p0 = __builtin_amdgcn_mfma_f32_32x32x16_bf16(kf[2 * d0], qr[d0], p0, 0, 0, 0);
        p1 = __builtin_amdgcn_mfma_f32_32x32x16_bf16(kf[2 * d0 + 1], qr[d0], p1, 0, 0, 0);
    }
#endif
    h1();
#if MK_LSUM
    astate_shift(st, p0, p1);
#pragma unroll
    for (int r = 0; r < 16; ++r) { p0[r] = fast_exp2(p0[r]); p1[r] = fast_exp2(p1[r]); }
    h2();
    tile_pv<true>(c, c.ldsp + tile, st.o0, st.o1, p0, p1, &st.ls, EV ? &vf : nullptr);
    h3();
#else
    float rm = -INFINITY;
#pragma unroll
    for (int r = 0; r < 16; ++r) { p0[r] = __builtin_fmaf(p0[r], C2, bv0[r]); rm = fmaxf(rm, p0[r]); }
#pragma unroll
    for (int r = 0; r < 16; ++r) { p1[r] = __builtin_fmaf(p1[r], C2, bv1[r]); rm = fmaxf(rm, p1[r]); }
    float sum = 0.f;
#pragma unroll
    for (int r = 0; r < 16; ++r) { p0[r] = fast_exp2(p0[r]); p1[r] = fast_exp2(p1[r]); sum += p0[r] + p1[r]; }
    st.l += sum;
    h2();
    tile_pv(c, c.ldsp + tile, st.o0, st.o1, p0, p1);
    h3();
    rm = max_x32(rm);
    if (__any(rm > THR)) {
        asm volatile("" ::: "memory");
        const float dl = fmaxf(rm, 0.f);
        st.mhat += dl; const float ng = -st.mhat * (1.0f / C2);
        const float f = fast_exp2(-dl);
        st.l *= f;
#pragma unroll
        for (int r = 0; r < 16; ++r) { st.o0[r] *= f; st.o1[r] *= f; st.nv[r] = ng; }
    }
#endif
}
__device__ __forceinline__ void qk_issue(const WCtx& c, unsigned ktile, const bf16x8 (&qr)[4], f32x16& p0, f32x16& p1) {
    lds_cptr kt = c.ldsp + ktile;
    bf16x8 kf[8];
#pragma unroll
    for (int d0 = 0; d0 < 4; ++d0) { const unsigned off = c.koff ^ (d0 << 5); kf[2 * d0] = *(LAS const bf16x8*)(kt + off); kf[2 * d0 + 1] = *(LAS const bf16x8*)(kt + off + 4096); }
    __builtin_amdgcn_sched_barrier(0);
    __builtin_amdgcn_s_setprio(1);
#pragma unroll
    for (int d0 = 0; d0 < 4; ++d0) {
        p0 = __builtin_amdgcn_mfma_f32_32x32x16_bf16(kf[2 * d0], qr[d0], p0, 0, 0, 0);
        p1 = __builtin_amdgcn_mfma_f32_32x32x16_bf16(kf[2 * d0 + 1], qr[d0], p1, 0, 0, 0);
    }
    __builtin_amdgcn_s_setprio(0);
}
__device__ __forceinline__ void sm_pv(const WCtx& c, unsigned vtile, AState& st, f32x16 p0, f32x16 p1) {
    astate_recheck(st, c);
    astate_shift(st, p0, p1);
#pragma unroll
    for (int r = 0; r < 16; ++r) { p0[r] = fast_exp2(p0[r]); p1[r] = fast_exp2(p1[r]); }
    tile_pv<true>(c, c.ldsp + vtile, st.o0, st.o1, p0, p1, &st.ls);
}
__device__ __forceinline__ void issue_piece_kv(const WCtx& c, const bf16* Kb, const bf16* Vb, unsigned rowidx, unsigned kt_off, unsigned vt_off, int pc) {
    issue_k_piece(c, Kb, rowidx, c.lds0 + kt_off, pc); issue_v_piece(c, Vb, rowidx, c.lds0 + vt_off, pc);
}
__device__ __forceinline__ void astate_fold(const AState& st, const WCtx& c, float w, f32x16& a0, f32x16& a1) {
#if MK_LSUM
    const float lt = astate_l(st, c);
#else
    const float lt = sum_x32(st.l);
#endif
    const float sc = lt > 0.f ? w / lt : 0.f;
#pragma unroll
    for (int r = 0; r < 16; ++r) { a0[r] += st.o0[r] * sc; a1[r] += st.o1[r] * sc; }
}
__device__ __forceinline__ void store_o(const WCtx& c, bf16* orow, const f32x16& a0, const f32x16& a1) {
#pragma unroll
    for (int g = 0; g < 4; ++g) {
        u32x2 w0, w1; w0.x = cvtpk(a0[4 * g], a0[4 * g + 1]); w0.y = cvtpk(a0[4 * g + 2], a0[4 * g + 3]); w1.x = cvtpk(a1[4 * g], a1[4 * g + 1]); w1.y = cvtpk(a1[4 * g + 2], a1[4 * g + 3]);
        *(u32x2*)(orow + 8 * g + 4 * c.hi) = w0; *(u32x2*)(orow + 32 + 8 * g + 4 * c.hi) = w1;
    }
}
__device__ __forceinline__ void load_q(bf16x8 (&qr)[4], const bf16* qrow, int hi) {
#pragma unroll
    for (int d0 = 0; d0 < 4; ++d0) qr[d0] = *(const bf16x8*)(qrow + d0 * 16 + hi * 8);
}
__device__ __forceinline__ void lds_or(LAS unsigned* p, unsigned v) { __hip_atomic_fetch_or(p, v, __ATOMIC_RELAXED, __HIP_MEMORY_SCOPE_WORKGROUP); }
template <int N, int S = 512> __device__ __forceinline__ void build_tab_ld(float (&v)[(N + S - 1) / S], const float* biasd_h, int maxd, int tid) {
    asm volatile("" : "+v"(tid));
#pragma unroll
    for (int j = 0; j < (N + S - 1) / S; ++j) { const int d = tid + S * j - 64; v[j] = biasd_h[clampi(d, 0, maxd)]; }
}
template <int N, int S = 512> __device__ __forceinline__ void build_tab_st(LAS float* tab, const float (&v)[(N + S - 1) / S], int maxd, int tid) {
    asm volatile("" : "+v"(tid));
#pragma unroll
    for (int j = 0; j < (N + S - 1) / S; ++j) { const int i = tid + S * j, d = i - 64; if (i < N) tab[N - 1 - i] = (d < 0 || d > maxd) ? -INFINITY : v[j]; }
}
template <int N, int S = 512> __device__ __forceinline__ void build_tab(LAS float* tab, const float* biasd_h, int maxd, int tid) {
    float v[(N + S - 1) / S]; build_tab_ld<N, S>(v, biasd_h, maxd, tid); build_tab_st<N, S>(tab, v, maxd, tid);
}

constexpr int UW_OFF = 32768, TABF = 2112, TABWN = 704, MOBA_BUF1 = 49152, MOBA_SLOT2 = 34816;
#ifndef MK_RING3
#define MK_RING3 0
#endif
#ifndef MK_TWO
#define MK_TWO 0
#endif
struct NoBg { int pend = 0; __device__ __forceinline__ void tick(int) {} };
template <int GH = 0, class BG = NoBg> __device__ __forceinline__ void moba_unit(LAS unsigned char* L_, int wid, int b, int h, int j, const bf16* Q, const bf16* K, const bf16* V, bf16* O, LAS const float* tab, LAS const float* km, BG& bg, float* probe_out = nullptr) {
    const WCtx c = make_ctx(L_);
#if MK_PROBE >= 11
    const unsigned long long mp_t0 = __builtin_amdgcn_s_memrealtime(); unsigned long long mp_acc = 0; unsigned mp_n = 0;
#endif
    const size_t hb = (size_t)(b * NH + h) * SEQ;
    const bf16* Kb = K + hb * HD; const bf16* Vb = V + hb * HD;
    const int t0 = 256 * j + 32 * wid, tq = t0 + c.r32;
    const bf16* qrow = Q + (hb + tq) * HD;
    if (GH != 1) issue_piece(c, Kb, Vb, (unsigned)(256 * j + 8 * wid + (c.lane >> 3)), c.lds0, wid);
#if MK_TWO
    issue_piece(c, Kb, Vb, (unsigned)(256 * j + 64 + 8 * wid + (c.lane >> 3)), c.lds0 + TILE_B, wid);
#endif
    bf16x8 qr[4]; load_q(qr, qrow, c.hi);
    unsigned sel = 0u;
    if (j > 0) {
        float g4[4] = {0.f, 0.f, 0.f, 0.f};
#pragma unroll
        for (int ch = 0; ch < 8; ++ch) {
            const u32x4 qq = *(const u32x4*)(qrow + 8 * ch);
            const float qf[8] = {__builtin_bit_cast(float, qq.x << 16), __builtin_bit_cast(float, qq.x & 0xffff0000u), __builtin_bit_cast(float, qq.y << 16), __builtin_bit_cast(float, qq.y & 0xffff0000u),
                                 __builtin_bit_cast(float, qq.z << 16), __builtin_bit_cast(float, qq.z & 0xffff0000u), __builtin_bit_cast(float, qq.w << 16), __builtin_bit_cast(float, qq.w & 0xffff0000u)};
#pragma unroll
            for (int k = 0; k < 4; ++k) { LAS const float* kr = km + (2 * k + c.hi) * 64 + 8 * ch;
                const f32x4 a = *(LAS const f32x4*)kr, bq = *(LAS const f32x4*)(kr + 4);
                g4[k] += (qf[0] * a[0] + qf[1] * a[1]) + (qf[2] * a[2] + qf[3] * a[3]) + (qf[4] * bq[0] + qf[5] * bq[1]) + (qf[6] * bq[2] + qf[7] * bq[3]); }
        }
        float ga[8];
#pragma unroll
        for (int k = 0; k < 4; ++k) { const float ot = __shfl_xor(g4[k], 32); ga[2 * k] = c.hi ? ot : g4[k]; ga[2 * k + 1] = c.hi ? g4[k] : ot; }
#pragma unroll
        for (int n = 0; n < 8; ++n) if (n >= j) ga[n] = -INFINITY;
#pragma unroll
        for (int n = 0; n < 8; ++n) { int rank = 0;
#pragma unroll
            for (int n2 = 0; n2 < 8; ++n2) if (n2 != n) rank += (n2 < n) ? (ga[n2] >= ga[n] ? 1 : 0) : (ga[n2] > ga[n] ? 1 : 0);
            if (rank < 3 && n < j) sel |= 1u << n; }
    }
    LAS unsigned* UW = (LAS unsigned*)(L_ + UW_OFF);
    if (j > 0) { lds_or(UW, sel); lds_or(UW + 1 + wid, sel); }
    vm_wait0(); __syncthreads();
    const unsigned U = __builtin_amdgcn_readfirstlane(UW[0]), wsel = __builtin_amdgcn_readfirstlane(UW[1 + wid]);
    AState st; astate_init(st);
    const int ntile = 4 + 4 * __builtin_popcount(U);
    int blk = j, kt = 0; unsigned rest = U; int slot = 0;
#if MK_RING3
    auto slot_off = [](int s) -> unsigned { return s == 2 ? (unsigned)MOBA_SLOT2 : (unsigned)s * TILE_B; };
    int pblk = j, pkt = 1, pslot = 1; unsigned prest = U; int pend1 = 0, pend2 = 0;
    issue_piece(c, Kb, Vb, (unsigned)(256 * pblk + 64 * pkt + 8 * wid + (c.lane >> 3)), c.lds0 + slot_off(pslot), wid);
    pkt = 2; pslot = 2;
#endif
#if MK_TWO
    int pblk = j; unsigned prest = U;
#endif
#if MK_PROBE >= 11
    const unsigned long long mp_t1 = __builtin_amdgcn_s_memrealtime();
#endif
#if MK_PIPE
    {
        constexpr unsigned TV2 = 32768;
        auto tv_off = [](int s) -> unsigned { return s == 2 ? TV2 : (unsigned)s * TILE_B; };
        auto is_active = [&](int bk, int k) { return (bk == j) ? (k <= (wid >> 1)) : (((wsel >> bk) & 1u) != 0u); };
        auto bias_ptr = [&](int bk, int k) { const bool mn = (bk == j) ? true : (((sel >> bk) & 1u) != 0u); return tab + (TABF - 64 - (mn ? (tq - (256 * bk + 64 * k) + 1 - 4 * c.hi) : 0)); };
        int b1 = j, k1 = 1, b2 = j, k2 = 2; unsigned r2 = U;
        issue_piece_kv(c, Kb, Vb, (unsigned)(256 * b1 + 64 * k1 + 8 * wid + (c.lane >> 3)), TILE_B, tv_off(1), wid);
        f32x16 p0, p1, n0, n1;
        bias_ld(bias_ptr(j, 0), p0, p1);
        qk_issue(c, 0u, qr, p0, p1);
        if (is_active(b1, k1)) bias_ld(bias_ptr(b1, k1), n0, n1);
        int vs = 0;
        for (int it = 0; it < ntile; ++it) {
            if (it + 1 < ntile) { vm_wait0(); __syncthreads(); }
            if (it + 2 < ntile) issue_piece_kv(c, Kb, Vb, (unsigned)(256 * b2 + 64 * k2 + 8 * wid + (c.lane >> 3)), (unsigned)(it & 1) * TILE_B, tv_off(vs == 0 ? 2 : vs - 1), wid);
            const bool act = is_active(blk, kt), actn = (it + 1 < ntile) && is_active(b1, k1);
            if (actn) qk_issue(c, (unsigned)((it + 1) & 1) * TILE_B, qr, n0, n1);
            if (act) sm_pv(c, tv_off(vs), st, p0, p1);
            p0 = n0; p1 = n1;
            if (it + 2 < ntile && is_active(b2, k2)) bias_ld(bias_ptr(b2, k2), n0, n1);
            blk = b1; kt = k1; b1 = b2; k1 = k2;
            if (++k2 == 4) { k2 = 0; b2 = __builtin_ctz(r2 | 0x80000000u); r2 &= r2 - 1; }
            vs = vs == 2 ? 0 : vs + 1;
        }
    }
#else
    f32x16 bb0, bb1;
#if MK_MOBA_PF
    bias_ld(tab + (TABF - 64 - (tq - 256 * j + 1 - 4 * c.hi)), bb0, bb1);
#endif
    for (int it = 0; it < ntile; ++it) {
#if MK_PROBE >= 15
        const unsigned long long mp_b = __builtin_amdgcn_s_memrealtime();
#endif
        int nblk = blk, nkt = kt + 1; unsigned nrest = rest;
        if (nkt == 4) { nkt = 0; nblk = __builtin_ctz(nrest | 0x80000000u); nrest &= nrest - 1; }
#if MK_TWO
        if ((it & 1) == 0) {
            if (it) { vm_wait0(); __syncthreads(); }
            if (it + 2 < ntile) {
                if (((it + 2) & 3) == 0) { pblk = __builtin_ctz(prest | 0x80000000u); prest &= prest - 1; }
                const unsigned nb_off = (((it >> 1) + 1) & 1) ? (unsigned)MOBA_BUF1 : 0u; const int pk = (it + 2) & 3;
                issue_piece(c, Kb, Vb, (unsigned)(256 * pblk + 64 * pk + 8 * wid + (c.lane >> 3)), c.lds0 + nb_off, wid);
                issue_piece(c, Kb, Vb, (unsigned)(256 * pblk + 64 * (pk + 1) + 8 * wid + (c.lane >> 3)), c.lds0 + nb_off + TILE_B, wid);
            }
        }
        const unsigned tile_off = (((it >> 1) & 1) ? (unsigned)MOBA_BUF1 : 0u) + (unsigned)(it & 1) * TILE_B;
#else
#if MK_RING3
        if (it) {
            const int nfl = pend2 + ((it + 1 < ntile) ? 2 : 0) + pend1;
            switch (nfl) {
                case 0: asm volatile("s_waitcnt vmcnt(0) lgkmcnt(0)\n\ts_barrier" ::: "memory"); break;
                case 2: asm volatile("s_waitcnt vmcnt(2) lgkmcnt(0)\n\ts_barrier" ::: "memory"); break;
                case 4: asm volatile("s_waitcnt vmcnt(4) lgkmcnt(0)\n\ts_barrier" ::: "memory"); break;
                case 6: asm volatile("s_waitcnt vmcnt(6) lgkmcnt(0)\n\ts_barrier" ::: "memory"); break;
                case 8: asm volatile("s_waitcnt vmcnt(8) lgkmcnt(0)\n\ts_barrier" ::: "memory"); break;
                case 9: asm volatile("s_waitcnt vmcnt(9) lgkmcnt(0)\n\ts_barrier" ::: "memory"); break;
                case 10: asm volatile("s_waitcnt vmcnt(10) lgkmcnt(0)\n\ts_barrier" ::: "memory"); break;
                case 11: asm volatile("s_waitcnt vmcnt(11) lgkmcnt(0)\n\ts_barrier" ::: "memory"); break;
                case 12: asm volatile("s_waitcnt vmcnt(12) lgkmcnt(0)\n\ts_barrier" ::: "memory"); break;
                case 13: asm volatile("s_waitcnt vmcnt(13) lgkmcnt(0)\n\ts_barrier" ::: "memory"); break;
                case 14: asm volatile("s_waitcnt vmcnt(14) lgkmcnt(0)\n\ts_barrier" ::: "memory"); break;
                case 15: asm volatile("s_waitcnt vmcnt(15) lgkmcnt(0)\n\ts_barrier" ::: "memory"); break;
                default: asm volatile("s_waitcnt vmcnt(0) lgkmcnt(0)\n\ts_barrier" ::: "memory"); break;
            } }
        if (it + 2 < ntile) {
            issue_piece(c, Kb, Vb, (unsigned)(256 * pblk + 64 * pkt + 8 * wid + (c.lane >> 3)), c.lds0 + slot_off(pslot), wid);
            if (++pkt == 4) { pkt = 0; pblk = __builtin_ctz(prest | 0x80000000u); prest &= prest - 1; }
            pslot = pslot == 2 ? 0 : pslot + 1; }
        const unsigned tile_off = slot_off(slot);
#else
        if (it) {
            if (bg.pend == 9) asm volatile("s_waitcnt vmcnt(9) lgkmcnt(0)\n\ts_barrier" ::: "memory");
            else if (bg.pend == 8) asm volatile("s_waitcnt vmcnt(8) lgkmcnt(0)\n\ts_barrier" ::: "memory");
            else if (bg.pend == 4) asm volatile("s_waitcnt vmcnt(4) lgkmcnt(0)\n\ts_barrier" ::: "memory");
            else if (bg.pend == 2) asm volatile("s_waitcnt vmcnt(2) lgkmcnt(0)\n\ts_barrier" ::: "memory");
            else asm volatile("s_waitcnt vmcnt(0) lgkmcnt(0)\n\ts_barrier" ::: "memory"); }
        if (GH != 1 && it + 1 < ntile) issue_piece(c, Kb, Vb, (unsigned)(256 * nblk + 64 * nkt + 8 * wid + (c.lane >> 3)), c.lds0 + (slot ^ 1) * TILE_B, wid);
        const unsigned tile_off = (unsigned)slot * TILE_B;
#endif
#endif
        const int k0 = 256 * blk + 64 * kt;
        const bool own = (blk == j);
        const bool mine = own ? true : ((sel >> blk) & 1u);
        const bool active = own ? (kt <= (wid >> 1)) : ((wsel >> blk) & 1u);
#if MK_PROBE == 15
        mp_acc += __builtin_amdgcn_s_memrealtime() - mp_b; ++mp_n;
#endif
        if (active) {
            if (MK_STAGGER && wid >= 4) __builtin_amdgcn_s_sleep(MK_STAGGER);
#if MK_PROBE >= 11 && MK_PROBE < 15
            const unsigned long long mp_a = __builtin_amdgcn_s_memrealtime();
#endif
#if !MK_MOBA_PF
            bias_ld(tab + (TABF - 64 - (mine ? (tq - k0 + 1 - 4 * c.hi) : 0)), bb0, bb1);
#endif
            tile_step_fast<0, NoHook, NoHook, NoHook, MK_MOBA_EV != 0>(c, tile_off, st, qr, bb0, bb1);
#if MK_PROBE >= 11 && MK_PROBE < 15
            asm volatile("s_nop 0" :: "v"(st.o0[0]), "v"(st.o1[15])); mp_acc += __builtin_amdgcn_s_memrealtime() - mp_a; ++mp_n;
#endif
        }
#if MK_PROBE == 16
        asm volatile("s_nop 0" :: "v"(st.o0[0]), "v"(st.o1[15])); mp_acc += __builtin_amdgcn_s_memrealtime() - mp_b; ++mp_n;
#endif
        if (MK_MOBA_PF && it + 1 < ntile) {
            const bool nown = (nblk == j);
            const bool nmine = nown ? true : ((sel >> nblk) & 1u);
            const bool nactive = nown ? (nkt <= (wid >> 1)) : ((wsel >> nblk) & 1u);
            if (nactive) bias_ld(tab + (TABF - 64 - (nmine ? (tq - (256 * nblk + 64 * nkt) + 1 - 4 * c.hi) : 0)), bb0, bb1);
        }
        bg.tick(it);
#if MK_RING3
        pend2 = pend1; pend1 = bg.pend;
        blk = nblk; kt = nkt; rest = nrest; slot = slot == 2 ? 0 : slot + 1;
#else
        blk = nblk; kt = nkt; rest = nrest; slot ^= 1;
#endif
    }
#endif
    f32x16 a0, a1;
#pragma unroll
    for (int r = 0; r < 16; ++r) { a0[r] = 0.f; a1[r] = 0.f; }
    astate_fold(st, c, 1.0f, a0, a1);
    if (GH == 0 || a0[0] == 123456.789f) store_o(c, O + ((size_t)b * SEQ + tq) * DM + h * HD, a0, a1);
#if MK_PROBE >= 11
    if (MK_PROBE < 20 && blockIdx.x == 0 && threadIdx.x == 0 && j == 7 && probe_out) { const unsigned long long mp_t2 = __builtin_amdgcn_s_memrealtime();
        probe_out[0] = (MK_PROBE == 11 || MK_PROBE >= 15) ? (float)mp_acc / (float)(mp_n ? mp_n : 1) : (MK_PROBE == 12) ? (float)(mp_t1 - mp_t0) : (MK_PROBE == 13) ? (float)(mp_t2 - mp_t0) : (float)mp_n; }
#endif
    if (threadIdx.x < 9) UW[threadIdx.x] = 0u;
    lgkm_wait0(); __syncthreads();
}

constexpr int DT_LEN = 258, DT1_OFF = 0, DT4_OFF = 16 * DT_LEN, DT16_OFF = 20 * DT_LEN, DT_TOTAL = 21 * DT_LEN;
__device__ __forceinline__ void build_dil_tabs(LAS float* tab, const float* biasd_h, int tid) {
    constexpr int IT = (DT_TOTAL + 511) / 512;
    float v[IT];
    asm volatile("" : "+v"(tid));
#pragma unroll
    for (int j = 0; j < IT; ++j) { const int i = tid + 512 * j, cp = i / DT_LEN, e = i - cp * DT_LEN, step = e - 64;
        const int r = cp < 16 ? 1 : cp < 20 ? 4 : 16, maxstep = r == 16 ? 127 : 128;
        v[j] = biasd_h[r * clampi(step, 0, maxstep)]; }
#pragma unroll
    for (int j = 0; j < IT; ++j) { const int i = tid + 512 * j, cp = i / DT_LEN, e = i - cp * DT_LEN, step = e - 64;
        const int r = cp < 16 ? 1 : cp < 20 ? 4 : 16, maxstep = r == 16 ? 127 : 128;
        if (i < DT_TOTAL) tab[cp * DT_LEN + (DT_LEN - 1 - e)] = (step < 0 || step > maxstep) ? -INFINITY : v[j]; }
}
template <int PASS> __device__ __forceinline__ void dil_wave(LAS unsigned char* L_, int wid, int b, int h, int chunk, int idx, const bf16* Q, const bf16* K, const bf16* V, bf16* O, LAS const float* tab,
                                                             bf16* SO, float* SM, float* SL) {
    const WCtx c = make_ctx(L_);
    const size_t hb = (size_t)(b * NH + h) * SEQ;
    const bf16* Kb = K + hb * HD; const bf16* Vb = V + hb * HD;
    const int t0 = 512 * chunk + (PASS == 0 ? 32 * idx : idx), tq = t0 + (PASS == 0 ? c.r32 : 16 * c.r32);
    const size_t srow = (size_t)(b * 8 + (h - 8)) * SEQ + tq;
    bf16x8 qr[4]; load_q(qr, Q + (hb + tq) * HD, c.hi);
    AState st; astate_init(st);
    if (PASS == 1) {
        const bf16* sp = SO + srow * HD + 4 * c.hi;
#pragma unroll
        for (int g = 0; g < 4; ++g) { const u32x2 w0 = __builtin_nontemporal_load((const u32x2*)(sp + 8 * g)), w1 = __builtin_nontemporal_load((const u32x2*)(sp + 32 + 8 * g));
            st.o0[4 * g] = __builtin_bit_cast(float, w0.x << 16); st.o0[4 * g + 1] = __builtin_bit_cast(float, w0.x & 0xffff0000u); st.o0[4 * g + 2] = __builtin_bit_cast(float, w0.y << 16); st.o0[4 * g + 3] = __builtin_bit_cast(float, w0.y & 0xffff0000u);
            st.o1[4 * g] = __builtin_bit_cast(float, w1.x << 16); st.o1[4 * g + 1] = __builtin_bit_cast(float, w1.x & 0xffff0000u); st.o1[4 * g + 2] = __builtin_bit_cast(float, w1.y << 16); st.o1[4 * g + 3] = __builtin_bit_cast(float, w1.y & 0xffff0000u); }
        st.mhat = __builtin_nontemporal_load(SM + srow);
        const float lt = __builtin_nontemporal_load(SL + srow);
#if MK_LSUM
        st.sh = __any(st.mhat != 0.f);
        { const float lo = __shfl(lt, (c.lane & 15) + 16); st.ls[0] = c.lane < 16 ? lt : 0.f; st.ls[1] = c.lane < 16 ? lo : 0.f; }
#else
        { const float ng = -st.mhat * (1.0f / C2);
#pragma unroll
            for (int r = 0; r < 16; ++r) st.nv[r] = ng; }
        st.l = c.hi ? 0.f : lt;
#endif
    }
    const unsigned tile = wid * TILE_B, tile_lds = c.lds0 + tile;
    auto k0_of = [&](int br, int kt) { const int sh = 2 * br; return t0 - (128 << sh) + ((64 * kt) << sh); };
    auto advance = [&](int& br, int& kt) { for (;;) { ++kt; if (kt == (br == 0 ? 3 : br == 1 ? 4 : 3)) { kt = 0; ++br; if (PASS == 0) br = 3; } if (br >= 3) return; if (k0_of(br, kt) + (63 << (2 * br)) >= 0) return; } };
    auto issue_k = [&](int br, int kt) { const int sh = 2 * br, k0 = k0_of(br, kt);
#pragma unroll
        for (int pc = 0; pc < 8; ++pc) issue_k_piece(c, Kb, (unsigned)clampi(k0 + ((8 * pc + (c.lane >> 3)) << sh), 0, SEQ - 1), tile_lds, pc); };
    auto issue_v = [&](int br, int kt) { const int sh = 2 * br, k0 = k0_of(br, kt);
#pragma unroll
        for (int pc = 0; pc < 8; ++pc) issue_v_piece(c, Vb, (unsigned)clampi(k0 + ((8 * pc + (c.lane >> 3)) << sh), 0, SEQ - 1), tile_lds, pc); };
    int br = (PASS == 0) ? 0 : 1, kt = -1; advance(br, kt);
    lgkm_wait0();
    if (br < 3) { issue_k(br, kt); issue_v(br, kt); }
#pragma unroll 1
    while (br < 3) {
        int nbr = br, nkt = kt; advance(nbr, nkt);
        const bool has_next = nbr < 3;
        const int sh = 2 * br, k0 = k0_of(br, kt);
        LAS const float* tb = tab + (br == 0 ? DT1_OFF : br == 1 ? DT4_OFF : DT16_OFF);
        LAS const float* tcopy = tb + (br == 0 ? 0 : br == 1 ? ((c.r32 >> 3) & 3) : 0) * DT_LEN;
        const int sb = (tq - k0) >> sh;
        const bool fastp = k0 >= 0, inr = (sb >= -1) && (sb <= 128 + 63);
        f32x16 bb0, bb1;
#if MK_DIL_PF
        if (fastp) bias_ld(inr ? tcopy + (DT_LEN - 64 - (sb + 1 - 4 * c.hi)) : tb + (DT_LEN - 64), bb0, bb1);
#endif
        vm_wait8();
#if !MK_DIL_PF
        if (fastp) bias_ld(inr ? tcopy + (DT_LEN - 64 - (sb + 1 - 4 * c.hi)) : tb + (DT_LEN - 64), bb0, bb1);
#endif
        auto h1 = [&]() { lgkm_wait0(); if (has_next) issue_k(nbr, nkt); };
        auto h2 = [&]() { if (has_next) vm_wait8(); else vm_wait0(); };
        auto h3 = [&]() { lgkm_wait0(); if (has_next) issue_v(nbr, nkt); };
        if (fastp) {
            tile_step_fast<0>(c, tile, st, qr, bb0, bb1, h1, h2, h3);
        } else {
            const int lim = tq >> sh;
            tile_step(c, tile, st, qr, [&](int rr, int half) { const int s = sb - ((rr & 3) + 8 * (rr >> 2) + 4 * c.hi + 32 * half);
                return tb[DT_LEN - 1 - ((s > lim) ? 0 : clampi(s + 64, 0, DT_LEN - 1))]; }, h1, h2, h3);
        }
        br = nbr; kt = nkt;
    }
    if (PASS == 0) {
        store_o(c, SO + srow * HD, st.o0, st.o1);
#if MK_LSUM
        const float lt = astate_l(st, c);
#else
        const float lt = sum_x32(st.l);
#endif
        if (c.hi == 0) { SM[srow] = st.mhat; SL[srow] = lt; }
    } else {
        f32x16 a0, a1;
#pragma unroll
        for (int r = 0; r < 16; ++r) { a0[r] = 0.f; a1[r] = 0.f; }
        astate_fold(st, c, 1.0f, a0, a1);
        store_o(c, O + ((size_t)b * SEQ + tq) * DM + h * HD, a0, a1);
    }
    lgkm_wait0();
}

constexpr int IMP_OFF = 33024, SELW_OFF = 145664;
template <int GHOST> __device__ __forceinline__ void nsa_unit(int wid, LAS unsigned char* lds, int b, int g, int chunk, const bf16* Q, const bf16* KV1, const bf16* KC, const bf16* VC,
                                         const float* gates, bf16* O, LAS const float* tabs, float* probe_out = nullptr) {
    const WCtx c = make_ctx(lds);
#if MK_PROBE >= 3
    const unsigned long long pu_t0 = __builtin_amdgcn_s_memrealtime();
#endif
    const int hh = wid & 3, qt = wid >> 2, h = 4 * g + hh;
    LAS const float* tab = tabs + hh * TABF; LAS const float* tabw = tabs + 4 * TABF + hh * TABWN;
    const int t0 = 64 * chunk + 32 * qt, tq = t0 + c.r32, cur = chunk;
    const bool late = cur >= 16;
    const size_t qb = (size_t)(b * NH + h) * SEQ, gb = (size_t)(b * 4 + g) * SEQ, TS = (size_t)BATCH * 4 * SEQ * HD;
    const bf16* KCb = KC + (size_t)(b * 4 + g) * 128 * HD; const bf16* VCb = VC + (size_t)(b * 4 + g) * 128 * HD;
    issue_piece(c, KCb, VCb, (unsigned)(8 * wid + (c.lane >> 3)), c.lds0, wid);
    if (late) issue_piece(c, KCb, VCb, (unsigned)(64 + 8 * wid + (c.lane >> 3)), c.lds0 + TILE_B, wid);
    bf16x8 qr[4]; load_q(qr, Q + (qb + tq) * HD, c.hi);
    const float* grow = gates + ((size_t)b * SEQ + tq) * 48 + 3 * h;
    const float g0 = grow[0], g1 = grow[1], g2 = grow[2];
    f32x16 a0, a1;
#pragma unroll
    for (int r = 0; r < 16; ++r) { a0[r] = 0.f; a1[r] = 0.f; }
    vm_wait0(); __syncthreads();
#if MK_PROBE >= 3
    const unsigned long long pu_ta = __builtin_amdgcn_s_memrealtime();
#endif
    LAS float* IA = (LAS float*)(lds + IMP_OFF + wid * 8448); LAS float* IB = IA + 32 * 33;
    {
        f32x16 p[4];
        const int db = tq - 31 + 64 - 64 * c.hi;
#pragma unroll
        for (int T = 0; T < 4; ++T)
#pragma unroll
            for (int r = 0; r < 16; ++r) { const int idx = db - 16 * (32 * T + (r & 3) + 8 * (r >> 2)); p[T][r] = (T < 2 || late) ? tab[TABF - 1 - clampi(idx, 0, TABF - 1)] : 0.f; }
        tile_qk(c, c.ldsp, qr, p[0], p[1]);
        if (late) tile_qk(c, c.ldsp + TILE_B, qr, p[2], p[3]);
        float rm = -INFINITY;
#pragma unroll
        for (int T = 0; T < 4; ++T) { if (T < 2 || late) {
#pragma unroll
            for (int r = 0; r < 16; ++r) rm = fmaxf(rm, p[T][r]); } }
        rm = max_x32(rm);
        const float mu = fmaxf(rm, -1e30f);
        float lsum = 0.f;
#pragma unroll
        for (int T = 0; T < 4; ++T) { if (T < 2 || late) {
#pragma unroll
            for (int r = 0; r < 16; ++r) { p[T][r] = fast_exp2(p[T][r] - mu); lsum += p[T][r]; } } }
        lsum = sum_x32(lsum);
        const float linv = lsum > 0.f ? 1.0f / lsum : 0.f;
#pragma unroll
        for (int T = 0; T < 4; ++T)
#pragma unroll
            for (int r = 0; r < 16; ++r) p[T][r] *= linv;
        tile_pv(c, c.ldsp, a0, a1, p[0], p[1]);
        if (late) tile_pv(c, c.ldsp + TILE_B, a0, a1, p[2], p[3]);
#pragma unroll
        for (int r = 0; r < 16; ++r) { a0[r] *= g0; a1[r] *= g0; }
        if (late) {
#pragma unroll
            for (int T = 0; T < 4; ++T)
#pragma unroll
                for (int gq = 0; gq < 4; ++gq) { const int n = 8 * T + 2 * gq + c.hi; const float b3 = 16.f * p[T][4 * gq + 3];
                    IA[c.r32 * 33 + n] = 32.f * (p[T][4 * gq] + p[T][4 * gq + 1] + p[T][4 * gq + 2]) + b3; IB[c.r32 * 33 + n] = b3; }
        }
    }
    lgkm_wait0(); __syncthreads();
    const bf16* Ks = KV1 + 2 * TS + gb * HD; const bf16* Vs = KV1 + 3 * TS + gb * HD;
    const bf16* Kw = KV1 + 4 * TS + gb * HD; const bf16* Vw = KV1 + 5 * TS + gb * HD;
    if (GHOST != 1) issue_piece(c, Ks, Vs, (unsigned)(8 * wid + (c.lane >> 3)), c.lds0, wid);
    unsigned selm = (cur >= 31) ? 0xffffffffu : ((2u << cur) - 1u);
    LAS unsigned* UW = (LAS unsigned*)(lds + UW_OFF);
    if (late) {
        float imp[16];
#pragma unroll
        for (int k = 0; k < 16; ++k) imp[k] = 0.f;
#pragma unroll
        for (int w4 = 0; w4 < 4; ++w4) { LAS const float* A = (LAS const float*)(lds + IMP_OFF + (w4 + 4 * qt) * 8448) + c.r32 * 33; LAS const float* Bq = A + 32 * 33;
#pragma unroll
            for (int k = 0; k < 16; ++k) { const int n = 16 * c.hi + k; imp[k] += A[n] + (n > 0 ? Bq[n - 1] : 0.f); } }
        int mine[16], oth[16];
#pragma unroll
        for (int k = 0; k < 16; ++k) { const int n = 16 * c.hi + k; const bool valid = n <= cur, forced = (n == 0) || (n == cur) || (n == cur - 1);
            mine[k] = !valid ? -2 : forced ? 0x7f000000 : __builtin_bit_cast(int, imp[k]);
            oth[k] = __shfl_xor(mine[k], 32); }
        unsigned sm = 0u;
#pragma unroll
        for (int k = 0; k < 16; ++k) { if ((k >> 2) == hh) { const int me = mine[k], me1 = mine[k] - 1, meo = mine[k] - c.hi;
            unsigned acc = 0u;
#pragma unroll
            for (int k2 = 0; k2 < 16; ++k2) { if (k2 < k) acc = __builtin_amdgcn_alignbit(acc, (unsigned)(me1 - mine[k2]), 31); else if (k2 > k) acc = __builtin_amdgcn_alignbit(acc, (unsigned)(me - mine[k2]), 31);
                acc = __builtin_amdgcn_alignbit(acc, (unsigned)(meo - oth[k2]), 31); }
            if (__builtin_popcount(acc) < 16) sm |= 1u << k; } }
        sm <<= 16 * c.hi;
        LAS unsigned* SELW = (LAS unsigned*)(lds + SELW_OFF) + 32 * qt + c.r32;
        lds_or(SELW, sm);
        lgkm_wait0(); __syncthreads();
        selm &= *SELW;
        lds_or(UW, selm); lds_or(UW + 1 + wid, selm);
        lgkm_wait0(); __syncthreads();
    }
    const unsigned U = late ? __builtin_amdgcn_readfirstlane(UW[0]) : ((cur >= 31) ? 0xffffffffu : ((2u << cur) - 1u)), wsel = late ? __builtin_amdgcn_readfirstlane(UW[1 + wid]) : U;
    LAS float* stash = (LAS float*)(lds + IMP_OFF + wid * 8448);
#pragma unroll
    for (int r = 0; r < 16; ++r) { stash[r * 64 + c.lane] = a0[r]; stash[(16 + r) * 64 + c.lane] = a1[r]; }
    const int nsel = __builtin_popcount(U);
    int wlo = 64 * chunk - 511; wlo = wlo < 0 ? 0 : wlo; const int w0 = wlo >> 6, nwin = chunk - w0 + 1;
    const int ntile = nsel + nwin;
    AState st; astate_init(st);
    unsigned rest = U & (U - 1); int slot = 0; int tn = 0;
    auto tile_bias = [&](int itx, int tnx, f32x16& b0, f32x16& b1) { const int k0x = 64 * tnx;
        if (itx < nsel) { if ((wsel >> tnx) & 1u) { const bool mn = (selm >> tnx) & 1u; bias_ld(tab + (TABF - 64 - (mn ? (tq - k0x + 1 - 4 * c.hi) : 0)), b0, b1); } }
        else if (k0x + 63 >= t0 - 511) bias_ld(tabw + (TABWN - 64 - (tq - k0x + 1 - 4 * c.hi)), b0, b1); };
    f32x16 bb0, bb1; tile_bias(0, 0, bb0, bb1);
#if MK_PROBE
    unsigned long long pr_acc = 0; unsigned pr_n = 0;
#endif
#if MK_PROBE >= 3
    const unsigned long long pu_t1 = __builtin_amdgcn_s_memrealtime();
#endif
    for (int it = 0; it < ntile; ++it) {
        const bool is_win = it >= nsel;
        const int nit = it + 1; const bool n_win = nit >= nsel;
        int ntn; unsigned nrest = rest;
        if (n_win) ntn = w0 + (nit - nsel); else { ntn = __builtin_ctz(nrest | 0x80000000u); nrest &= nrest - 1; }
#if MK_PROBE == 8 || MK_PROBE == 9
        const unsigned long long pw_t0 = __builtin_amdgcn_s_memrealtime();
        vm_wait0();
        const unsigned long long pw_t1 = __builtin_amdgcn_s_memrealtime();
        __syncthreads();
        const unsigned long long pw_t2 = __builtin_amdgcn_s_memrealtime();
        pr_acc += (MK_PROBE == 8) ? (pw_t1 - pw_t0) : (pw_t2 - pw_t1); ++pr_n;
#else
        vm_wait0(); if (GHOST != 2) __syncthreads();
#endif
        if (GHOST != 1 && nit < ntile) issue_piece(c, n_win ? Kw : Ks, n_win ? Vw : Vs, (unsigned)(64 * ntn + 8 * wid + (c.lane >> 3)), c.lds0 + (slot ^ 1) * TILE_B, wid);
        if (it == nsel) {
#pragma unroll
            for (int r = 0; r < 16; ++r) { a0[r] = stash[r * 64 + c.lane]; a1[r] = stash[(16 + r) * 64 + c.lane]; }
            astate_fold(st, c, g1, a0, a1); astate_init(st);
#pragma unroll
            for (int r = 0; r < 16; ++r) { stash[r * 64 + c.lane] = a0[r]; stash[(16 + r) * 64 + c.lane] = a1[r]; } }
        const int k0 = 64 * tn;
        if (!is_win) {
            if ((wsel >> tn) & 1u) {
#if MK_PROBE == 1 || MK_PROBE == 2
                const unsigned long long pr_t0 = (MK_PROBE == 1) ? __builtin_amdgcn_s_memtime() : __builtin_amdgcn_s_memrealtime();
#endif
                tile_step_fast<GHOST, NoHook, NoHook, NoHook, MK_NSA_EV != 0>(c, slot * TILE_B, st, qr, bb0, bb1);
#if MK_PROBE == 1 || MK_PROBE == 2
                asm volatile("s_nop 0" :: "v"(st.o0[0]), "v"(st.o1[15]));
                pr_acc += ((MK_PROBE == 1) ? __builtin_amdgcn_s_memtime() : __builtin_amdgcn_s_memrealtime()) - pr_t0; ++pr_n;
#endif
            }
        } else {
            if (k0 + 63 >= t0 - 511) {
                if (MK_STAGGER && wid >= 4) __builtin_amdgcn_s_sleep(MK_STAGGER);
                tile_step_fast<GHOST, NoHook, NoHook, NoHook, MK_NSA_EV != 0>(c, slot * TILE_B, st, qr, bb0, bb1); }
        }
        if (nit < ntile) tile_bias(nit, ntn, bb0, bb1);
        tn = ntn; rest = nrest; slot ^= 1;
    }
#pragma unroll
    for (int r = 0; r < 16; ++r) { a0[r] = stash[r * 64 + c.lane]; a1[r] = stash[(16 + r) * 64 + c.lane]; }
    astate_fold(st, c, g2, a0, a1);
    if (GHOST == 0 || a0[0] == 123456.789f) store_o(c, O + ((size_t)b * SEQ + tq) * DM + h * HD, a0, a1);
    if (threadIdx.x < 9) UW[threadIdx.x] = 0u;
    if (late && threadIdx.x < 64) ((LAS unsigned*)(lds + SELW_OFF))[threadIdx.x] = 0u;
#if MK_PROBE
#if MK_PROBE >= 3 && MK_PROBE <= 6
    { const unsigned long long pu_t2 = __builtin_amdgcn_s_memrealtime(); pr_acc = (MK_PROBE == 3) ? (pu_t1 - pu_t0) : (MK_PROBE == 4) ? (pu_t2 - pu_t0) : (MK_PROBE == 6) ? (pu_ta - pu_t0) : (pu_t2 - pu_t1); pr_n = 1; }
#endif
    if (MK_PROBE < 11 && blockIdx.x == 0 && threadIdx.x == 0) { const float pv_ = (float)pr_acc / (float)(pr_n ? pr_n : 1); probe_out[0] = (MK_PROBE >= 3 && MK_PROBE <= 6 && chunk != 0) ? probe_out[0] + pv_ : pv_; }
#endif
    lgkm_wait0(); __syncthreads();
}

#define LDS_WAIT() asm volatile("s_waitcnt lgkmcnt(0)" ::: "memory")
#define VM_WAIT() asm volatile("s_waitcnt vmcnt(0)" ::: "memory")
constexpr int NWAVES = 8;
__device__ __forceinline__ float wave_sum(float v) {
#pragma unroll
    for (int o = 1; o < 64; o <<= 1) v += __shfl_xor(v, o);
    return v;
}

struct Args { const float* in[33]; float* out; unsigned char* ws; int ph_lo, ph_hi; };

__device__ __forceinline__ void tr_item(const float* src, int Nsrc, int srccol0, const float* gain, bf16* dst, int Kdst, int dstrow0, int k0, LAS float* scr, int lane) {
    const int col = srccol0 + (lane & 31); const bool ok = col < Nsrc;
#pragma unroll 8
    for (int i = 0; i < 32; ++i) { const int kk = 2 * i + (lane >> 5); float v = ok ? src[(size_t)(k0 + kk) * Nsrc + col] : 0.f; if (gain) v *= gain[k0 + kk]; scr[kk * 33 + (lane & 31)] = v; }
    LDS_WAIT(); asm volatile("" ::: "memory");
    const int c = lane & 7;
#pragma unroll
    for (int j = 0; j < 4; ++j) { const int n = (lane >> 3) + 8 * j; const LAS float* s = scr + (8 * c) * 33 + n;
        u32x4 o; o.x = pk2(s[0 * 33], s[1 * 33]); o.y = pk2(s[2 * 33], s[3 * 33]); o.z = pk2(s[4 * 33], s[5 * 33]); o.w = pk2(s[6 * 33], s[7 * 33]);
        *(GAS u32x4*)(dst + (size_t)(dstrow0 + n) * Kdst + k0 + 8 * c) = o; }
    LDS_WAIT(); asm volatile("" ::: "memory");
}
__device__ __forceinline__ void tr_matrix(int item, const float* src, const float* src2, int Ksrc, int Nsrc, int Ndst, int map, const float* gain, bf16* dst, LAS float* scr, int lane) {
    const int nblk = Ndst / 32, kb = item / nblk, nb = item % nblk;
    int srccol0 = 32 * nb; const float* s = src;
    if (map == 1) { const int pn = nb >> 3, pb = nb & 7, half = pb >> 2, hh = pb & 3; srccol0 = 256 * pn + 64 * hh + 32 * half; }
    else if (map == 2) { const int pn = nb >> 3, pb = nb & 7; srccol0 = 128 * pn + 32 * (pb & 3); s = (pb < 4) ? src : src2; }
    tr_item(s, Nsrc, srccol0, gain, dst, Ksrc, 32 * nb, 64 * kb, scr, lane);
}

__device__ __forceinline__ void tr_wg_load(f32x4 (&v)[8], const float* src, const float* src2, int Nsrc, int map, const float* gain, int kb, int nb, int tid) {
    const int c4 = tid & 63;
    const float* s = src; int col;
    if (map == 2) { s = (c4 < 32) ? src : src2; col = 128 * nb + 4 * (c4 & 31); } else col = 256 * nb + 4 * c4;
    const bool ok = col < Nsrc;
#pragma unroll
    for (int i = 0; i < 8; ++i) { const int k = 64 * kb + (tid >> 6) + 8 * i;
        f32x4 x = ok ? __builtin_nontemporal_load((const GAS f32x4*)(s + (size_t)k * Nsrc + col)) : (f32x4){0.f, 0.f, 0.f, 0.f};
        if (gain) x = x * gain[k];
        v[i] = x; }
}
__device__ __forceinline__ void tr_wg_store(const f32x4 (&v)[8], LAS float* T, int map, bf16* dst, int Kdst, int kb, int nb, int tid) {
    const int c4 = tid & 63;
    __syncthreads();
#pragma unroll
    for (int i = 0; i < 8; ++i) *(LAS f32x4*)(T + ((tid >> 6) + 8 * i) * 260 + 4 * c4) = v[i];
    __syncthreads();
    const int ch = tid & 7;
#pragma unroll
    for (int j = 0; j < 4; ++j) { const int n = (tid >> 3) + 64 * j;
        const int lc = (map == 1) ? (64 * ((n >> 5) & 3) + 32 * (n >> 7) + (n & 31)) : n;
        const LAS float* s = T + (8 * ch) * 260 + lc;
        u32x4 o; o.x = cvtpk(s[0 * 260], s[1 * 260]); o.y = cvtpk(s[2 * 260], s[3 * 260]); o.z = cvtpk(s[4 * 260], s[5 * 260]); o.w = cvtpk(s[6 * 260], s[7 * 260]);
        *(GAS u32x4*)(dst + (size_t)(256 * nb + n) * Kdst + 64 * kb + 8 * ch) = o; }
}
struct TrDesc { const float* src; const float* src2; int Nsrc, Kdst, map; const float* gain; bf16* dst; int kb, nb; };

__device__ __forceinline__ int rel_bucket(int d) {
    if (d < 16) return d;
    int b = 16;
    b += d >= 22; b += d >= 30; b += d >= 40; b += d >= 54; b += d >= 73; b += d >= 99; b += d >= 134; b += d >= 182;
    b += d >= 246; b += d >= 332; b += d >= 450; b += d >= 609; b += d >= 825; b += d >= 1117; b += d >= 1513;
    return b;
}

constexpr int TW_IN0 = 16 * (N_IN0 / 256), TW_IN1 = 16 * (N_IN1P / 256), TW_OUT = 16 * 4, TW_GU = 16 * (N_GU / 256), TW_D = (FF / 64) * 4, TW_PG = 16 * 4, TW_PP = 4 * 4;
constexpr int TR_NWI = TW_IN0 + TW_IN1 + 2 * TW_OUT + 2 * TW_GU + 2 * TW_D + 2 * TW_PG + 2 * TW_PP;
__device__ __forceinline__ TrDesc tr_desc(const Args& args, unsigned char* ws, int it) {
    const float* nmix = args.in[3]; const float* nffn = args.in[4]; const float* nple = args.in[5];
    TrDesc d; int r = it; int nbn;
    if (r < TW_IN0) { d = TrDesc{args.in[11], nullptr, N_IN0, DM, 1, nmix, (bf16*)(ws + WS_WIN0), 0, 0}; nbn = N_IN0 / 256; }
    else if ((r -= TW_IN0) < TW_IN1) { d = TrDesc{args.in[17], nullptr, N_IN1, DM, 1, nmix + DM, (bf16*)(ws + WS_WIN1), 0, 0}; nbn = N_IN1P / 256; }
    else if ((r -= TW_IN1) < TW_OUT) { d = TrDesc{args.in[12], nullptr, DM, DM, 0, nullptr, (bf16*)(ws + WS_WOUT0), 0, 0}; nbn = 4; }
    else if ((r -= TW_OUT) < TW_OUT) { d = TrDesc{args.in[18], nullptr, DM, DM, 0, nullptr, (bf16*)(ws + WS_WOUT1), 0, 0}; nbn = 4; }
    else if ((r -= TW_OUT) < TW_GU) { d = TrDesc{args.in[6], args.in[7], FF, DM, 2, nffn, (bf16*)(ws + WS_WGU0), 0, 0}; nbn = N_GU / 256; }
    else if ((r -= TW_GU) < TW_GU) { d = TrDesc{args.in[6] + (size_t)DM * FF, args.in[7] + (size_t)DM * FF, FF, DM, 2, nffn + DM, (bf16*)(ws + WS_WGU1), 0, 0}; nbn = N_GU / 256; }
    else if ((r -= TW_GU) < TW_D) { d = TrDesc{args.in[8], nullptr, DM, FF, 0, nullptr, (bf16*)(ws + WS_WD0), 0, 0}; nbn = 4; }
    else if ((r -= TW_D) < TW_D) { d = TrDesc{args.in[8] + (size_t)FF * DM, nullptr, DM, FF, 0, nullptr, (bf16*)(ws + WS_WD1), 0, 0}; nbn = 4; }
    else if ((r -= TW_D) < TW_PG) { d = TrDesc{args.in[10], nullptr, DM, DM, 0, nple, (bf16*)(ws + WS_WPG0), 0, 0}; nbn = 4; }
    else if ((r -= TW_PG) < TW_PG) { d = TrDesc{args.in[10] + (size_t)DM * DM, nullptr, DM, DM, 0, nple + DM, (bf16*)(ws + WS_WPG1), 0, 0}; nbn = 4; }
    else if ((r -= TW_PG) < TW_PP) { d = TrDesc{args.in[9], nullptr, DM, PLE, 0, nullptr, (bf16*)(ws + WS_WPP0), 0, 0}; nbn = 4; }
    else { r -= TW_PP; d = TrDesc{args.in[9] + (size_t)PLE * DM, nullptr, DM, PLE, 0, nullptr, (bf16*)(ws + WS_WPP1), 0, 0}; nbn = 4; }
    d.kb = r / nbn; d.nb = r % nbn; return d;
}
constexpr int TRBG_P = 6;
constexpr int TRBG_T_OFF = 51200, TRBG_G_OFF = TRBG_T_OFF + 64 * 260 * 4 + 128;
struct TrBg {
    const Args& args; unsigned char* ws; LAS unsigned char* L;
    int next, end, stride, inlds, pend, git;
    __device__ __forceinline__ void tick(int) {
        int tid = threadIdx.x; asm volatile("" : "+v"(tid));
        const int lane = tid & 63, wv = __builtin_amdgcn_readfirstlane(tid >> 6);
        LAS float* T = (LAS float*)(L + TRBG_T_OFF); LAS float* Gv = (LAS float*)(L + TRBG_G_OFF);
        const int ph = git % TRBG_P; ++git;
        pend = 0;
        if (ph == 0) {
            if (inlds >= 0) {
                const TrDesc d = tr_desc(args, ws, inlds);
                const int ch = tid & 7;
                const f32x4 g0 = *(LAS const f32x4*)(Gv + 8 * ch), g1 = *(LAS const f32x4*)(Gv + 8 * ch + 4);
#pragma unroll
                for (int j = 0; j < 4; ++j) { const int n = (tid >> 3) + 64 * j;
                    const int lc = (d.map == 1) ? (64 * ((n >> 5) & 3) + 32 * (n >> 7) + (n & 31)) : n;
                    const LAS float* s = T + (8 * ch) * 260 + 4 * ch + lc;
                    u32x4 o; o.x = cvtpk(s[0 * 260] * g0.x, s[1 * 260] * g0.y); o.y = cvtpk(s[2 * 260] * g0.z, s[3 * 260] * g0.w); o.z = cvtpk(s[4 * 260] * g1.x, s[5 * 260] * g1.y); o.w = cvtpk(s[6 * 260] * g1.z, s[7 * 260] * g1.w);
                    if (d.map != 2 && 256 * d.nb + lc >= d.Nsrc) o = (u32x4){0u, 0u, 0u, 0u};
                    __builtin_nontemporal_store(o, (GAS u32x4*)(d.dst + (size_t)(256 * d.nb + n) * d.Kdst + 64 * d.kb + 8 * ch)); }
                pend = 4; inlds = -1;
            }
        } else if (ph == 1) {
            if (next < end) {
                const TrDesc d = tr_desc(args, ws, next);
                const float* s = d.src; int col;
                if (d.map == 2) { s = (lane < 32) ? d.src : d.src2; col = 128 * d.nb + 4 * (lane & 31); } else col = 256 * d.nb + 4 * lane;
                col = col < d.Nsrc ? col : 0;
                const unsigned tl = (unsigned)(uintptr_t)((unsigned char*)L) + TRBG_T_OFF;
#pragma unroll
                for (int i = 0; i < 8; ++i) { const int r = wv + 8 * i;
                    glds16_nt(s + (size_t)(64 * d.kb + r) * d.Nsrc + col, (unsigned)__builtin_amdgcn_readfirstlane(tl + r * 1040 + 16 * (r >> 3))); }
                pend = 8;
                if (d.gain) { if (lane < 16) glds16(d.gain + 64 * d.kb + 4 * lane, (unsigned)__builtin_amdgcn_readfirstlane(tl + 64 * 1040 + 128)); pend = 9; }
                else if (tid < 64) Gv[tid] = 1.0f;
                inlds = next; next += stride;
            }
        }
    }
    __device__ __forceinline__ bool busy() const { return inlds >= 0 || next < end; }
};

__device__ __forceinline__ bool in_phase(int k, int lo, int hi) { asm volatile("" : "+s"(lo), "+s"(hi)); return lo <= k && k < hi; }
__global__ void __launch_bounds__(NWAVES * 64, 2) fwd_kernel(Args args) {
    extern __shared__ __attribute__((aligned(16))) unsigned char lds[];
    LAS unsigned char* L = (LAS unsigned char*)lds;
    volatile LAS unsigned* MISC = (volatile LAS unsigned*)(L + MISC_OFF);
    const int tid = threadIdx.x, lane = tid & 63, wave = __builtin_amdgcn_readfirstlane(tid >> 6);
    const int G = gridDim.x; const int bx = blockIdx.x; const int vcu = (G % 8 == 0) ? (bx % 8) * (G / 8) + bx / 8 : bx;
    unsigned char* ws = args.ws;
    gu32* ctl = (gu32*)(ws + WS_CTL);
    for (int u = tid; u < 128; u += NWAVES * 64) ((LAS unsigned*)(L + MISC_OFF))[u] = 0u;
    __syncthreads();
#if MK_NOMEMSET
    XcdBarrier bar = xcd_barrier_post(g_xbar, MISC + 8); (void)ctl;
#else
    XcdBarrier bar = xcd_barrier_post((unsigned*)(ctl + CW_BAR), MISC + 8);
#endif
    const int lo = args.ph_lo, hi = args.ph_hi;
#if MK_PROBE >= 31
    if (blockIdx.x == 0 && threadIdx.x == 0) g_probe_acc = 0.f;
#endif
#define IN(k) (((MK_MASK >> (k)) & 1) && in_phase((k), lo, hi))
#define PHASE_IDS int tid_o = threadIdx.x; asm volatile("" : "+v"(tid_o)); const int tid = tid_o, lane = tid_o & 63; (void)tid; (void)lane;
#define PHASE_WS unsigned char* ws_o = args.ws; asm volatile("" : "+s"(ws_o)); unsigned char* const ws = ws_o; (void)ws; int bx_o = blockIdx.x; asm volatile("" : "+s"(bx_o)); const int bx = bx_o; (void)bx;
#define REPN(k) (1 + ((MK_REP >> (k)) & 1))
#define INR(k) in_phase((k), lo, hi)
#define SEAM(k) do { if (INR(k) && INR((k) + 1)) xcd_barrier(bar); } while (0)
#ifndef MK_SHADOW
#define MK_SHADOW 5
#endif
#define SHADOWED(k, bit) (((MK_SHADOW >> (bit)) & 1) && gridDim.x == 256 && INR(k) && INR((k) + 1))
#define VCU256 ((int)((blockIdx.x & 7u) * 32u + (blockIdx.x >> 3)))

#define ssb ((ss_t*)(ws + WS_SS))
#define kmean ((float*)(ws + WS_KMEAN))
#define biasd ((float*)(ws + WS_BIASD))
#define cb1 ((float*)(ws + WS_CB1))
#define HB ((bf16*)(ws + WS_HB))
#define PP ((bf16*)(ws + WS_PP))
#define OB ((bf16*)(ws + WS_O))
#define QB ((bf16*)(ws + WS_Q))
#define K0 ((bf16*)(ws + WS_K0))
#define V0 ((bf16*)(ws + WS_V0))
#define KV1 ((bf16*)(ws + WS_KV1))
#define HID ((bf16*)(ws + WS_HID))
#define PB0 ((bf16*)(ws + WS_PB0))
#define PB1 ((bf16*)(ws + WS_PB1))
#define KC ((bf16*)(ws + WS_KC))
#define VC ((bf16*)(ws + WS_VC))
#define GATES ((float*)(ws + WS_GATES))
    const int gw = vcu * NWAVES + wave, NGW = G * NWAVES;

for (int rep_ = 0; rep_ < REPN(0); ++rep_) { if (rep_) xcd_barrier(bar);
    if (IN(0)) {
        PHASE_IDS
#if MK_PROBE >= 21
        const unsigned long long pp_t0 = __builtin_amdgcn_s_memrealtime();
#define PP_MARK(k) if (MK_PROBE == (k) && blockIdx.x == MK_PROBE_BLK && threadIdx.x == 0) ((float*)(ws + WS_CB1 + 4096))[0] = (float)(__builtin_amdgcn_s_memrealtime() - pp_t0);
#else
#define PP_MARK(k)
#endif
        LAS float* scr = (LAS float*)(L + wave * WAVE_LDS);
        const float* nmix = args.in[3]; const float* nffn = args.in[4]; const float* nple = args.in[5];
        {
            constexpr int W_IN0 = 16 * (N_IN0 / 256), W_IN1 = 16 * (N_IN1P / 256), W_OUT = 16 * 4, W_GU = 16 * (N_GU / 256), W_D = (FF / 64) * 4, W_PG = 16 * 4, W_PP = 4 * 4;
            constexpr int NWI = W_IN0 + W_IN1 + 2 * W_OUT + 2 * W_GU + 2 * W_D + 2 * W_PG + 2 * W_PP;
            LAS float* T = (LAS float*)L;
            auto desc = [&](int it) { TrDesc d; int r = it; int nbn;
                if (r < W_IN0) { d = TrDesc{args.in[11], nullptr, N_IN0, DM, 1, nmix, (bf16*)(ws + WS_WIN0), 0, 0}; nbn = N_IN0 / 256; }
                else if ((r -= W_IN0) < W_IN1) { d = TrDesc{args.in[17], nullptr, N_IN1, DM, 1, nmix + DM, (bf16*)(ws + WS_WIN1), 0, 0}; nbn = N_IN1P / 256; }
                else if ((r -= W_IN1) < W_OUT) { d = TrDesc{args.in[12], nullptr, DM, DM, 0, nullptr, (bf16*)(ws + WS_WOUT0), 0, 0}; nbn = 4; }
                else if ((r -= W_OUT) < W_OUT) { d = TrDesc{args.in[18], nullptr, DM, DM, 0, nullptr, (bf16*)(ws + WS_WOUT1), 0, 0}; nbn = 4; }
                else if ((r -= W_OUT) < W_GU) { d = TrDesc{args.in[6], args.in[7], FF, DM, 2, nffn, (bf16*)(ws + WS_WGU0), 0, 0}; nbn = N_GU / 256; }
                else if ((r -= W_GU) < W_GU) { d = TrDesc{args.in[6] + (size_t)DM * FF, args.in[7] + (size_t)DM * FF, FF, DM, 2, nffn + DM, (bf16*)(ws + WS_WGU1), 0, 0}; nbn = N_GU / 256; }
                else if ((r -= W_GU) < W_D) { d = TrDesc{args.in[8], nullptr, DM, FF, 0, nullptr, (bf16*)(ws + WS_WD0), 0, 0}; nbn = 4; }
                else if ((r -= W_D) < W_D) { d = TrDesc{args.in[8] + (size_t)FF * DM, nullptr, DM, FF, 0, nullptr, (bf16*)(ws + WS_WD1), 0, 0}; nbn = 4; }
                else if ((r -= W_D) < W_PG) { d = TrDesc{args.in[10], nullptr, DM, DM, 0, nple, (bf16*)(ws + WS_WPG0), 0, 0}; nbn = 4; }
                else if ((r -= W_PG) < W_PG) { d = TrDesc{args.in[10] + (size_t)DM * DM, nullptr, DM, DM, 0, nple + DM, (bf16*)(ws + WS_WPG1), 0, 0}; nbn = 4; }
                else if ((r -= W_PG) < W_PP) { d = TrDesc{args.in[9], nullptr, DM, PLE, 0, nullptr, (bf16*)(ws + WS_WPP0), 0, 0}; nbn = 4; }
                else { r -= W_PP; d = TrDesc{args.in[9] + (size_t)PLE * DM, nullptr, DM, PLE, 0, nullptr, (bf16*)(ws + WS_WPP1), 0, 0}; nbn = 4; }
                d.kb = r / nbn; d.nb = r % nbn; return d; };
            f32x4 v[8];
            const int NWI_P0 = (MK_BG && G == 256) ? (MK_P0DMA ? 0 : W_IN0) : NWI;
            int it = vcu;
            if (it < NWI_P0) { const TrDesc d = desc(it); tr_wg_load(v, d.src, d.src2, d.Nsrc, d.map, d.gain, d.kb, d.nb, tid); }
#pragma unroll 1
            for (; it < NWI_P0; it += G) {
                const TrDesc d = desc(it);
                f32x4 w[8];
#pragma unroll
                for (int i = 0; i < 8; ++i) w[i] = v[i];
                if (it + G < NWI_P0) { const TrDesc dn = desc(it + G); tr_wg_load(v, dn.src, dn.src2, dn.Nsrc, dn.map, dn.gain, dn.kb, dn.nb, tid); }
                tr_wg_store(w, T, d.map, d.dst, d.Kdst, d.kb, d.nb, tid);
            }
            __syncthreads();
        }
        PP_MARK(21)
        constexpr int I_C1 = 32 * 4, I_C2 = 2 * 2, NIT = 2 * I_C1 + 2 * I_C2;
        for (int it = gw; it < NIT; it += NGW) {
            int r = it;
            if (r < I_C1) { tr_matrix(r, args.in[24], nullptr, 2048, 128, 128, 0, nullptr, (bf16*)(ws + WS_CW1K), scr, lane); continue; } r -= I_C1;
            if (r < I_C1) { tr_matrix(r, args.in[29], nullptr, 2048, 128, 128, 0, nullptr, (bf16*)(ws + WS_CW1V), scr, lane); continue; } r -= I_C1;
            if (r < I_C2) { tr_matrix(r, args.in[26], nullptr, 128, 64, 64, 0, nullptr, (bf16*)(ws + WS_CW2K), scr, lane); continue; } r -= I_C2;
            tr_matrix(r, args.in[31], nullptr, 128, 64, 64, 0, nullptr, (bf16*)(ws + WS_CW2V), scr, lane);
        }
        PP_MARK(22)
#if MK_BG && MK_P0DMA
        TrBg b0{args, ws, L}; b0.next = (G == 256) ? vcu : TW_IN0; b0.end = TW_IN0; b0.stride = G; b0.inlds = -1; b0.pend = 0; b0.git = 1;
        __syncthreads();
        b0.tick(0);
#endif
        const float* x = args.in[0];
        for (int m = 2 * gw; m < M; m += 2 * NGW) {
            const GAS f32x4* xr = (const GAS f32x4*)(x + (size_t)m * DM) + lane; f32x4 v[8]; float s0 = 0.f, s1 = 0.f;
#pragma unroll
            for (int j = 0; j < 8; ++j) v[j] = __builtin_nontemporal_load(xr + 64 * j);
#pragma unroll
            for (int j = 0; j < 4; ++j) { s0 += (v[j].x * v[j].x + v[j].y * v[j].y) + (v[j].z * v[j].z + v[j].w * v[j].w); s1 += (v[4 + j].x * v[4 + j].x + v[4 + j].y * v[4 + j].y) + (v[4 + j].z * v[4 + j].z + v[4 + j].w * v[4 + j].w); }
            s0 = wave_sum(s0); s1 = wave_sum(s1);
            GAS unsigned long long* o8 = (GAS unsigned long long*)(HB + (size_t)m * DM) + lane;
#pragma unroll
            for (int j = 0; j < 8; ++j) o8[64 * j] = (unsigned long long)cvtpk(v[j].x, v[j].y) | ((unsigned long long)cvtpk(v[j].z, v[j].w) << 32);
            if (lane == 0) { ssb[m] = (ss_t)(s0 * SS_SCALE); ssb[m + 1] = (ss_t)(s1 * SS_SCALE); }
        }
        PP_MARK(23)
#if MK_BG && MK_P0DMA
        asm volatile("s_waitcnt vmcnt(0) lgkmcnt(0)" ::: "memory"); __syncthreads();
        b0.git = 0; b0.tick(0);
#endif
        const float* relb = args.in[2];
        for (int i = bx * 512 + tid; i < NH * TABN; i += G * 512) { const int h = i / TABN, d = i % TABN; biasd[i] = relb[rel_bucket(d) * NH + h] * LOG2E; }
        for (int o = vcu; o < 256; o += G) { const int kv = o >> 7, col = o & 127; const float* pos = args.in[kv ? 28 : 23]; const float* w1 = args.in[kv ? 29 : 24]; const float* b1 = args.in[kv ? 30 : 25];
            float s = 0.f;
#pragma unroll
            for (int i = 0; i < 4; ++i) { const int k = tid + 512 * i; s += pos[k] * w1[(size_t)k * 128 + col]; }
            s = wave_sum(s);
            LAS float* red = (LAS float*)(L + 8 * WAVE_LDS);
            __syncthreads(); if (lane == 0) red[wave] = s; __syncthreads();
            if (tid == 0) cb1[o] = ((red[0] + red[1]) + (red[2] + red[3])) + ((red[4] + red[5]) + (red[6] + red[7])) + b1[col]; }
        if (bx == 0) { const int gi = tid >> 6; const int src_idx = gi < 4 ? 13 + gi : gi == 4 ? 19 : gi == 5 ? 21 : gi == 6 ? 22 : 20; ((float*)(ws + WS_GN))[tid] = args.in[src_idx][tid & 63] * ((gi == 0 || gi == 2 || gi == 4) ? C2 : 1.0f); }
        for (int i = bx * 512 + tid; i < 2 * 32 * 32; i += G * 512) { const int kv = i >> 10, bg = (i >> 5) & 31, w = i & 31; ((unsigned*)((kv ? VC : KC) + ((size_t)bg * 128 + 127) * HD))[w] = 0u; }
    }
}
#if MK_NOMEMSET
    if (INR(0)) {
        for (int i = bx * 512 + tid; i < 6 * M; i += G * 512) { if (i < 5 * M) (ssb + M)[i] = 0ull; else ((unsigned long long*)kmean)[i - 5 * M] = 0ull; } }
#endif
    SEAM(0);
    using namespace pg8;
    if (IN(2)) { PHASE_WS  Gemm g{HB, (const bf16*)(ws + WS_WIN0), M, N_IN0, DM}; StaticOrder S; S.init(M, N_IN0, G, bx, MK_WGM12);
        EpiInProj<0> E{ssb, QB, (const float*)(ws + WS_GN), kmean, nullptr};
        gemm_phase<EpiInProj<0>, StaticOrder, true, true>(L, g, S, E); }
    if (SHADOWED(2, 0)) { const float* bsrc = biasd + ((VCU256 >> 2) & 7) * TABN;
        xcd_barrier(bar, [&] { int t = (int)threadIdx.x - 64; asm volatile("" : "+v"(t)); build_tab<2112, 448>((LAS float*)(L + TAB0_OFF), bsrc, 2047, t); }); }
    else SEAM(2);
for (int rep_ = 0; rep_ < REPN(3); ++rep_) { if (rep_) xcd_barrier(bar);
    if (IN(3)) { PHASE_WS
        PHASE_IDS
        LAS float* tab = (LAS float*)(L + TAB0_OFF); LAS float* km = (LAS float*)(L + KM_OFF);
#if MK_PROBE >= 61 && MK_PROBE <= 63
        const unsigned long long p3_t0 = __builtin_amdgcn_s_memrealtime(); unsigned long long p3_t1 = p3_t0;
#endif
        for (int v = vcu; v < 256; v += G) {
            const int bh = v >> 2, b = bh >> 3, h = bh & 7, sub = v & 3;
            const bool dil_first = MK_MIX && ((bh & 1) != 0);
#pragma unroll 1
            for (int stg = 0; stg < 2; ++stg) {
            if ((stg == 0) != dil_first) {
            __syncthreads();
            if (tid < 9) ((LAS unsigned*)(L + UW_OFF))[tid] = 0u;
            if (!(SHADOWED(2, 0) && rep_ == 0 && !MK_MIX)) build_tab<2112>(tab, biasd + h * TABN, 2047, tid);
            km[tid] = kmean[(size_t)(b * 8 + h) * 512 + tid] * (1.0f / 256.0f);
            __syncthreads();
#ifndef NO_MOBA
            if (!(rep_ && MK_P3SKIP == 2))
            {
#if MK_BG
                TrBg bg{args, ws, L}; bg.next = TW_IN0 + ((G == 256) ? vcu : TR_NWI); bg.end = TR_NWI; bg.stride = G; bg.inlds = -1; bg.pend = 0; bg.git = 0;
                if (rep_) bg.next = TR_NWI;
#else
                NoBg bg;
#endif
#pragma unroll 1
                for (int uu = 0; uu < 2; ++uu) moba_unit<0>(L, wave, b, h, uu ? 7 - sub : sub, QB, K0, V0, OB, tab, km, bg, (float*)(ws + WS_CB1 + 4096));
#if MK_BG
#pragma unroll 1
                for (int it = 0; bg.busy(); ++it) { bg.tick(it); asm volatile("s_waitcnt vmcnt(0) lgkmcnt(0)" ::: "memory"); __syncthreads(); }
#endif
            }
#endif
#if MK_PROBE >= 61 && MK_PROBE <= 63
            p3_t1 = __builtin_amdgcn_s_memrealtime();
#endif
            } else {
            __syncthreads();
            build_dil_tabs(tab, biasd + (8 + h) * TABN, tid);
            __syncthreads();
#ifndef NO_DIL
            if (!(rep_ && MK_P3SKIP == 1)) {
                bf16* SO = (bf16*)(ws + WS_PP); float* SM = (float*)(ws + WS_PP + 16 * MiB); float* SL = SM + (size_t)BATCH * 8 * SEQ;
#pragma unroll 1
                for (int uu = 0; uu < 2; ++uu) dil_wave<0>(L, wave, b, 8 + h, sub, 8 * uu + wave, QB, K0, V0, OB, tab, SO, SM, SL);
                asm volatile("s_waitcnt vmcnt(0)" ::: "memory"); __syncthreads();
#pragma unroll 1
                for (int uu = 0; uu < 2; ++uu) dil_wave<1>(L, wave, b, 8 + h, sub, 8 * uu + wave, QB, K0, V0, OB, tab, SO, SM, SL);
            }
#endif
            }
            }
        }
#if MK_PROBE >= 61 && MK_PROBE <= 63
        if (threadIdx.x == 0) ((float*)(ws + WS_CB1 + 8192))[blockIdx.x] = (float)((MK_PROBE == 62 ? p3_t1 : __builtin_amdgcn_s_memrealtime()) - (MK_PROBE == 63 ? p3_t1 : p3_t0));
#endif
    }
}
    SEAM(3);
#pragma unroll 1
    for (int layer = 0; layer < 2; ++layer) {
        const int pb = layer ? 12 : 4;
#define Wout ((const bf16*)(ws + (layer ? WS_WOUT1 : WS_WOUT0)))
#define Wgu ((const bf16*)(ws + (layer ? WS_WGU1 : WS_WGU0)))
#define Wd ((const bf16*)(ws + (layer ? WS_WD1 : WS_WD0)))
#define Wpg ((const bf16*)(ws + (layer ? WS_WPG1 : WS_WPG0)))
#define HCUR (layer ? OB : HB)
#define OCUR (layer ? HB : OB)
#define ss_ffn (ssb + (size_t)(3 * layer + 1) * M)
#define ss_ple (ssb + (size_t)(3 * layer + 2) * M)
#define ss_next (layer ? (ss_t*)nullptr : ssb + (size_t)3 * M)
        if (layer == 1) {
for (int rep_ = 0; rep_ < REPN(9); ++rep_) { if (rep_) xcd_barrier(bar);
            if (IN(9)) { PHASE_WS  Gemm g{OB, (const bf16*)(ws + WS_WIN1), M, N_IN1P, DM}; StaticOrder S; S.init(M, N_IN1P, G, bx, MK_WGM12);
                EpiInProj<1> E{ssb + (size_t)3 * M, QB, (const float*)(ws + WS_GN), nullptr, GATES};
                gemm_phase<EpiInProj<1>, StaticOrder, true, true>(L, g, S, E); }
}
            SEAM(9);
for (int rep_ = 0; rep_ < REPN(10); ++rep_) { if (rep_) xcd_barrier(bar);
            if (IN(10)) { PHASE_WS
                PHASE_IDS
                for (int task = vcu; task < 256; task += G) {
                    const int kv = task >> 7, bg = (task >> 2) & 31, rt = task & 3, i0 = 32 * rt;
                    const bf16* T = KV1 + (size_t)kv * ((size_t)BATCH * 4 * SEQ * HD) + (size_t)bg * SEQ * HD;
                    const bf16* W1 = (const bf16*)(ws + (kv ? WS_CW1V : WS_CW1K)); const bf16* W2 = (const bf16*)(ws + (kv ? WS_CW2V : WS_CW2K));
                    const int r32 = lane & 31, hi5 = lane >> 5;
                    f32x16 acc4[4];
#pragma unroll
                    for (int nb = 0; nb < 4; ++nb)
#pragma unroll
                        for (int r = 0; r < 16; ++r) acc4[nb][r] = 0.f;
                    int arow = i0 + r32; arow = arow > 126 ? 126 : arow;
                    const bf16* ap = T + (size_t)arow * 16 * HD + 256 * wave + 8 * hi5;
                    const bf16* bp = W1 + (size_t)r32 * 2048 + 256 * wave + 8 * hi5;
                    bf16x8 af[16];
#pragma unroll
                    for (int s = 0; s < 16; ++s) af[s] = *(const bf16x8*)(ap + 16 * s);
#pragma unroll
                    for (int s = 0; s < 16; ++s) {
#pragma unroll
                        for (int nb = 0; nb < 4; ++nb) { const bf16x8 bb = *(const bf16x8*)(bp + (size_t)nb * 32 * 2048 + 16 * s);
                            acc4[nb] = __builtin_amdgcn_mfma_f32_32x32x16_bf16(af[s], bb, acc4[nb], 0, 0, 0); } }
                    __syncthreads();
                    LAS float* part = (LAS float*)L;
#pragma unroll
                    for (int nb = 0; nb < 4; ++nb)
#pragma unroll
                        for (int r = 0; r < 16; ++r) part[(wave * 32 + crow(r, hi5)) * 129 + 32 * nb + r32] = acc4[nb][r];
                    __syncthreads();
                    LAS bf16* H1 = (LAS bf16*)(L + 135168);
                    const float cbv = cb1[kv * 128 + (tid & 127)];
                    for (int e = tid; e < 32 * 128; e += 512) { const int row = e >> 7, col = e & 127;
                        float v = cbv;
#pragma unroll
                        for (int w8 = 0; w8 < 8; ++w8) v += part[(w8 * 32 + row) * 129 + col];
                        const float u2 = 0.7978845608028654f * (v + 0.044715f * v * v * v);
                        const float th = 1.0f - 2.0f * fast_rcp(1.0f + fast_exp2(2.0f * u2 * LOG2E));
                        H1[row * 136 + col] = (bf16)f2bf(0.5f * v * (1.0f + th)); }
                    __syncthreads();
                    LAS float* OUT = (LAS float*)(L + 144384);
                    if (wave < 2) {
                        f32x16 a2;
#pragma unroll
                        for (int r = 0; r < 16; ++r) a2[r] = 0.f;
#pragma unroll
                        for (int s = 0; s < 8; ++s) { const bf16x8 a = *(LAS const bf16x8*)(H1 + r32 * 136 + 16 * s + 8 * hi5);
                            const bf16x8 bb = *(const bf16x8*)(W2 + (size_t)(32 * wave + r32) * 128 + 16 * s + 8 * hi5);
                            a2 = __builtin_amdgcn_mfma_f32_32x32x16_bf16(a, bb, a2, 0, 0, 0); }
                        const float* b2 = args.in[kv ? 32 : 27];
#pragma unroll
                        for (int r = 0; r < 16; ++r) OUT[crow(r, hi5) * 65 + 32 * wave + r32] = a2[r] + b2[32 * wave + r32];
                    }
                    __syncthreads();
                    if (tid < 256) { const int row = tid >> 3, c8 = (tid & 7) * 8; float v[8]; float sq = 0.f;
#pragma unroll
                        for (int i = 0; i < 8; ++i) { v[i] = OUT[row * 65 + c8 + i]; sq += v[i] * v[i]; }
                        sq += __shfl_xor(sq, 1); sq += __shfl_xor(sq, 2); sq += __shfl_xor(sq, 4);
                        if (kv == 0) { const float r2 = rsqrtf(sq * (1.0f / HD) + RMS_EPS); const float* kn = (const float*)(ws + WS_GN) + 7 * 64;
#pragma unroll
                            for (int i = 0; i < 8; ++i) v[i] = v[i] * r2 * kn[c8 + i]; }
                        if (i0 + row < 127) { u32x4 w; w.x = pk2(v[0], v[1]); w.y = pk2(v[2], v[3]); w.z = pk2(v[4], v[5]); w.w = pk2(v[6], v[7]);
                            *(u32x4*)((kv ? VC : KC) + ((size_t)bg * 128 + i0 + row) * HD + c8) = w; } }
                    __syncthreads();
                }
            }
}
            if (SHADOWED(10, 1)) { const float* bsrc = biasd + 4 * ((VCU256 >> 3) & 3) * TABN;
                xcd_barrier(bar, [&] { int t = (int)threadIdx.x - 64; asm volatile("" : "+v"(t)); LAS float* tabs = (LAS float*)(L + TAB1_OFF);
                    float vf[4][(TABF + 447) / 448], vw[4][(TABWN + 447) / 448];
#pragma unroll
                    for (int hh = 0; hh < 4; ++hh) { build_tab_ld<TABF, 448>(vf[hh], bsrc + hh * TABN, 2047, t); build_tab_ld<TABWN, 448>(vw[hh], bsrc + hh * TABN, 511, t); }
#pragma unroll
                    for (int hh = 0; hh < 4; ++hh) { build_tab_st<TABF, 448>(tabs + hh * TABF, vf[hh], 2047, t); build_tab_st<TABWN, 448>(tabs + 4 * TABF + hh * TABWN, vw[hh], 511, t); } }); }
            else SEAM(10);
for (int rep_ = 0; rep_ < REPN(11); ++rep_) { if (rep_) xcd_barrier(bar);
            if (IN(11)) { PHASE_WS
                PHASE_IDS
#if MK_PROBE >= 51
                const unsigned long long p11_t0 = __builtin_amdgcn_s_memrealtime();
#endif
                LAS float* tabs = (LAS float*)(L + TAB1_OFF);
                for (int v = vcu; v < 256; v += G) {
                    const int bg = v >> 3, b = bg >> 2, g = bg & 3, sub = v & 7;
                    __syncthreads();
                    if (tid < 9) ((LAS unsigned*)(L + UW_OFF))[tid] = 0u;
                    if (tid < 64) ((LAS unsigned*)(L + SELW_OFF))[tid] = 0u;
                    if (!(SHADOWED(10, 1) && rep_ == 0)) { float vf[4][(TABF + 511) / 512], vw[4][(TABWN + 511) / 512];
#pragma unroll
                        for (int hh = 0; hh < 4; ++hh) { build_tab_ld<TABF>(vf[hh], biasd + (4 * g + hh) * TABN, 2047, tid); build_tab_ld<TABWN>(vw[hh], biasd + (4 * g + hh) * TABN, 511, tid); }
#pragma unroll
                        for (int hh = 0; hh < 4; ++hh) { build_tab_st<TABF>(tabs + hh * TABF, vf[hh], 2047, tid); build_tab_st<TABWN>(tabs + 4 * TABF + hh * TABWN, vw[hh], 511, tid); } }
                    __syncthreads();
#if MK_PROBE == 56
                    if (threadIdx.x == 0) ((float*)(ws + WS_CB1 + 8192))[blockIdx.x] = (float)(__builtin_amdgcn_s_memrealtime() - p11_t0);
#endif
                    const unsigned cw4 = sub == 0 ? 0x06081419u : sub == 1 ? 0x01051e1fu : sub == 2 ? 0x0a0f1011u : sub == 3 ? 0x040e121au : sub == 4 ? 0x000b1b1cu : sub == 5 ? 0x020c151du : sub == 6 ? 0x030d1618u : 0x07091317u;
#pragma unroll 1
                    for (int k = 0; k < 4; ++k) { const int chunk = (int)((cw4 >> (8 * k)) & 0xffu);
#if MK_GHOST && MK_GHOST < 30
                        if (rep_) nsa_unit<MK_GHOST>(wave, L, b, g, chunk, QB, KV1, KC, VC, GATES, HB, tabs); else
#endif
                        nsa_unit<0>(wave, L, b, g, chunk, QB, KV1, KC, VC, GATES, HB, tabs, (float*)(ws + WS_CB1 + 4096)); }
                }
#if MK_PROBE >= 51 && MK_PROBE <= 55
                if (threadIdx.x == 0) ((float*)(ws + WS_CB1 + 8192))[blockIdx.x] = (float)(__builtin_amdgcn_s_memrealtime() - p11_t0);
#endif
            }
}
            if (SHADOWED(11, 2)) { const float* p1 = args.in[1] + (size_t)M * PLE; bf16* pb1 = PB1;
                xcd_barrier(bar, [&] { int t = (int)threadIdx.x - 64; asm volatile("" : "+v"(t)); const int ln = t & 63, w = t >> 6, r0 = (int)blockIdx.x * 64;
                    f32x4 v[10];
#pragma unroll
                    for (int j = 0; j < 10; ++j) { const int r = w + 7 * j; v[j] = __builtin_nontemporal_load((const GAS f32x4*)(p1 + (size_t)(r0 + (r < 64 ? r : 63)) * PLE) + ln); }
#pragma unroll
                    for (int j = 0; j < 10; ++j) { const int r = w + 7 * j;
                        if (r < 64) ((GAS unsigned long long*)(pb1 + (size_t)(r0 + r) * PLE))[ln] = (unsigned long long)pk2(v[j].x, v[j].y) | ((unsigned long long)pk2(v[j].z, v[j].w) << 32); } }); }
            else SEAM(11);
        }
        if (IN(pb)) { PHASE_WS
            if (!(layer == 1 && SHADOWED(11, 2))) {
                PHASE_IDS
                const float* p1 = args.in[1] + (size_t)layer * M * PLE;
                for (int m0 = gw; m0 < M; m0 += 8 * NGW) {
                    f32x4 v[8];
#pragma unroll
                    for (int j = 0; j < 8; ++j) { const int m = m0 + j * NGW; v[j] = __builtin_nontemporal_load((const GAS f32x4*)(p1 + (size_t)(m < M ? m : M - 1) * PLE) + lane); }
#pragma unroll
                    for (int j = 0; j < 8; ++j) { const int m = m0 + j * NGW;
                        if (m < M) ((GAS unsigned long long*)(PB1 + (size_t)m * PLE))[lane] = (unsigned long long)pk2(v[j].x, v[j].y) | ((unsigned long long)pk2(v[j].z, v[j].w) << 32); } }
            }
            Gemm g{OCUR, Wout, M, DM, DM}; StaticOrder S; S.init(M, DM, G, bx, MK_WGM4);
            EpiResid<0> E{HCUR, HCUR, nullptr, ss_ffn, nullptr, nullptr};
            gemm_phase<EpiResid<0>, StaticOrder, true, true>(L, g, S, E); }
        SEAM(pb);
for (int rep_ = 0; rep_ < REPN(pb + 1); ++rep_) { if (rep_) xcd_barrier(bar);
        if (IN(pb + 1)) { PHASE_WS  Gemm g{HCUR, Wgu, M, N_GU, DM}; StaticOrder S; S.init(M, N_GU, G, bx, MK_WGM22); EpiSwiglu E{HID, ss_ffn, 0};
#if MK_GHOST >= 30
            if (rep_) { E.ghost = 1; S.flat = (MK_GHOST == 31); }
#endif
            gemm_phase<EpiSwiglu, StaticOrder, true, true>(L, g, S, E);
            if (G == 256 ? bx >= 128 : true) {
                int kk = PLE; asm volatile("" : "+s"(kk)); Gemm g2{PB1, (const bf16*)(ws + (layer ? WS_WPP1 : WS_WPP0)), M, DM, kk}; StaticOrder S2;
                if (G == 256) S2.init(M, DM, 128, bx - 128); else S2.init(M, DM, G, bx);
                EpiStoreBf16 E2{PP, DM};
                gemm_phase<EpiStoreBf16, StaticOrder, true, true>(L, g2, S2, E2); } }
}
        SEAM(pb + 1);
        if (IN(pb + 2)) { PHASE_WS  Gemm g{HID, Wd, M, DM, FF}; StaticOrder S; S.init(M, DM, G, bx, MK_WGM4);
            EpiResid<0> E{HCUR, HCUR, nullptr, ss_ple, nullptr, nullptr};
            gemm_phase<EpiResid<0>, StaticOrder, true, true>(L, g, S, E); }
        SEAM(pb + 2);
        if (IN(pb + 3)) { PHASE_WS  Gemm g{HCUR, Wpg, M, DM, DM}; StaticOrder S; S.init(M, DM, G, bx, MK_WGM4);
            EpiResid<1> E{HCUR, layer ? (bf16*)nullptr : OB, layer ? args.out : (float*)nullptr, ss_next, ss_ple, PP};
            gemm_phase<EpiResid<1>, StaticOrder, true, true>(L, g, S, E); }
        if (layer == 0) SEAM(7);
    }
#if MK_PROBE
#if MK_PROBE < 31
    float g_probe_acc = 0.f;
#endif
    xcd_barrier(bar);
    if (blockIdx.x == 0 && threadIdx.x == 0) { unsigned char* ws = args.ws; float pv_ = ((MK_PROBE >= 31) ? g_probe_acc : ((float*)(ws + WS_CB1 + 4096))[0]) * (1.0f / MK_PROBE_DIV);
#if MK_PROBE >= 51
        { const float* a = (const float*)(ws + WS_CB1 + 8192); float mx = 0.f, mn = 1e30f, sm = 0.f; int am = 0;
          for (int i = 0; i < 256; ++i) { const float t = a[i]; if (t > mx) { mx = t; am = i; } mn = t < mn ? t : mn; sm += t; }
          pv_ = ((MK_PROBE == 51 || MK_PROBE >= 61) ? mx : MK_PROBE == 52 ? mn : MK_PROBE == 53 ? (float)am * MK_PROBE_DIV : (MK_PROBE == 55 || MK_PROBE == 56) ? a[MK_PROBE_BLK] : sm * (1.0f / 256.0f)) * (1.0f / MK_PROBE_DIV) - (float)MK_PROBE_OFF; if (pv_ < 0.f) pv_ = 0.f; }
#endif
 float q_ = 1.f; while (pv_ >= 20.f) { pv_ *= 0.5f; q_ *= 2.f; } args.out[0] += floorf(pv_ * 0.5f) * 2.f * q_; }
#endif
#if MK_DBG
    if (lo == 99) {
        const bf16* src = (const bf16*)(ws + (size_t)MK_DBG_OFF);
        for (size_t i = (size_t)bx * 512 + threadIdx.x; i < (size_t)M * DM; i += (size_t)G * 512) args.out[i] = i < (size_t)MK_DBG_CNT ? bf2f(src[i]) : 0.f;
    }
#endif
#ifndef MK_XBPROBE
#define MK_XBPROBE 0
#endif
#if MK_XBPROBE
#pragma unroll 1
    for (int i_ = 0; i_ < MK_XBPROBE; ++i_) xcd_barrier(bar);
#endif
#if MK_NOMEMSET
    if (threadIdx.x == 0) {
        const unsigned old = xb_add(&g_xbar[XB_EXIT], 1u);
        if (old + 1u == gridDim.x) {
#pragma unroll
            for (int j = 0; j < 16; ++j) { xb_st0(&g_xbar[XB_XCNT(j)]); xb_st0(&g_xbar[XB_XSUB(j)]); xb_st0(&g_xbar[XB_XGEN(j)]); }
            xb_st0(&g_xbar[XB_TOP]); xb_st0(&g_xbar[XB_TOPGEN]); xb_st0(&g_xbar[XB_TMO]); xb_st0(&g_xbar[XB_EXIT]);
        }
    }
#endif
#undef IN
#undef SEAM
}

extern "C" void kernel_launch(void* const* d_in, const int* in_sizes, int n_in, void* d_out, int out_size, void* d_ws, size_t ws_size, hipStream_t stream) {
    static int grid = 0;
    if (grid == 0) {
        if (n_in != 33 || out_size != M * DM || ws_size < WS_END) { fprintf(stderr, "kernel_launch: unexpected problem (n_in %d out %d ws %zu)\n", n_in, out_size, ws_size); grid = -1; return; }
        int dev = 0, cus = 0, per_cu = 0;
        if (hipGetDevice(&dev) != hipSuccess || hipDeviceGetAttribute(&cus, hipDeviceAttributeMultiprocessorCount, dev) != hipSuccess) { grid = -1; return; }
        if (hipFuncSetAttribute((const void*)fwd_kernel, hipFuncAttributeMaxDynamicSharedMemorySize, LDS_BYTES) != hipSuccess) { fprintf(stderr, "kernel_launch: hipFuncSetAttribute failed\n"); grid = -1; return; }
        if (hipOccupancyMaxActiveBlocksPerMultiprocessor(&per_cu, (const void*)fwd_kernel, NWAVES * 64, LDS_BYTES) != hipSuccess || per_cu < 1) { fprintf(stderr, "kernel_launch: occupancy query says %d\n", per_cu); }
        (void)hipGetLastError();
        grid = cus < 256 ? cus : 256;
    }
    if (grid < 0) return;
#if !MK_NOMEMSET
    if (hipMemsetAsync((char*)d_ws + WS_CTL, 0, CTL_ZERO_BYTES, stream) != hipSuccess) return;
#endif
    Args a{};
    for (int i = 0; i < 33; ++i) a.in[i] = (const float*)d_in[i];
    a.out = (float*)d_out; a.ws = (unsigned char*)d_ws;
#if MK_SPLIT
    for (int ph = 0; ph < MK_PH_END; ++ph) { a.ph_lo = ph; a.ph_hi = ph + 1; hipLaunchKernelGGL(fwd_kernel, dim3(grid), dim3(NWAVES * 64), LDS_BYTES, stream, a); }
#if MK_DBG
    a.ph_lo = 99; a.ph_hi = 100; hipLaunchKernelGGL(fwd_kernel, dim3(grid), dim3(NWAVES * 64), LDS_BYTES, stream, a);
#endif
#else
    a.ph_lo = 0; a.ph_hi = MK_PH_END;
    hipLaunchKernelGGL(fwd_kernel, dim3(grid), dim3(NWAVES * 64), LDS_BYTES, stream, a);
#endif
}
```
